# Optimizing an MI355X kernel written in HIP

```python
import jax, jax.numpy as jnp
from jax import lax
import numpy as np

D_MODEL = 2048
BATCH = 4
SEQ = 4096
DEPTH = 2

GRID_W = 64
CTX_LEN = 256
D_MIX = D_MODEL
SGU_WIDTH = D_MIX // 2
SGU_GROUPS = 8
SGU_GROUP_DIM = SGU_WIDTH // SGU_GROUPS
CHUNK = 128
ATTN_WIDTH = D_MIX - SGU_WIDTH
HEAD_DIM = 128
N_Q_HEADS = ATTN_WIDTH // HEAD_DIM
N_KV_HEADS = 2
KV_WIDTH = N_KV_HEADS * HEAD_DIM
Q_BLOCK = 128
ROPE_THETA = 10000.0
EPS = 1e-6
SPLIT_POINTS = (
    SGU_WIDTH,
    2 * SGU_WIDTH,
    3 * SGU_WIDTH,
    3 * SGU_WIDTH + ATTN_WIDTH,
    3 * SGU_WIDTH + ATTN_WIDTH + KV_WIDTH,
    3 * SGU_WIDTH + ATTN_WIDTH + 2 * KV_WIDTH,
)
KV_START = SPLIT_POINTS[3]
KV_END = SPLIT_POINTS[5]
D_IN = SPLIT_POINTS[5] + ATTN_WIDTH

kernel_name = "hybrid_sgu_gqa_prefix_dit_block"


def rms_norm(x, w):
    xf = x.astype(jnp.float32)
    y = xf * lax.rsqrt(jnp.mean(xf * xf, axis=-1, keepdims=True) + EPS)
    return (y * w.astype(jnp.float32)).astype(x.dtype)


def modulation(cond, w_mod, b_mod):
    m = jax.nn.silu(cond) @ w_mod + b_mod
    m = m.reshape(-1, 1, 3 * D_MODEL)
    return jnp.split(m, 3, axis=-1)


def axial_rope_tables(n_tokens, dtype):
    rows = n_tokens // GRID_W
    row_id = jnp.broadcast_to(jnp.arange(rows)[:, None], (rows, GRID_W)).reshape(-1)
    col_id = jnp.broadcast_to(jnp.arange(GRID_W)[None, :], (rows, GRID_W)).reshape(-1)
    axis_dim = HEAD_DIM // 2
    inv_freq = ROPE_THETA ** (-jnp.arange(0, axis_dim, 2, dtype=jnp.float32) / axis_dim)
    ang_r = row_id.astype(jnp.float32)[:, None] * inv_freq[None, :]
    ang_c = col_id.astype(jnp.float32)[:, None] * inv_freq[None, :]
    ang = jnp.concatenate([ang_r, ang_r, ang_c, ang_c], axis=-1)
    return jnp.cos(ang).astype(dtype), jnp.sin(ang).astype(dtype)


def _rotate_half(t):
    t1, t2 = jnp.split(t, 2, axis=-1)
    return jnp.concatenate([-t2, t1], axis=-1)


def apply_axial_rope(x, cos, sin):
    x_r, x_c = jnp.split(x, 2, axis=-1)
    rot = jnp.concatenate([_rotate_half(x_r), _rotate_half(x_c)], axis=-1)
    return x * cos + rot * sin


def split_heads(t, n_heads):
    b, n, _ = t.shape
    return t.reshape(b, n, n_heads, HEAD_DIM).transpose(0, 2, 1, 3)


def merge_heads(t):
    b, h, n, d = t.shape
    return t.transpose(0, 2, 1, 3).reshape(b, n, h * d)


def kv_heads(k, v, k_norm_w):
    return rms_norm(split_heads(k, N_KV_HEADS), k_norm_w), split_heads(v, N_KV_HEADS)


def blocked_gqa(q, k, v):
    b, hq, nq, d = q.shape
    rep = hq // N_KV_HEADS
    qb = q.reshape(b, N_KV_HEADS, rep, nq // Q_BLOCK, Q_BLOCK, d)
    qb = jnp.moveaxis(qb, 3, 0)
    scale = HEAD_DIM ** -0.5

    def one_block(q_blk):
        s = jnp.einsum('bgrqd,bgkd->bgrqk', q_blk, k, preferred_element_type=jnp.float32) * scale
        p = jax.nn.softmax(s, axis=-1).astype(v.dtype)
        return jnp.einsum('bgrqk,bgkd->bgrqd', p, v)

    o = lax.map(one_block, qb)
    return jnp.moveaxis(o, 0, 3).reshape(b, hq, nq, d)


def chunk_sgu(u, v, w_sgu, b_sgu, v_norm_w):
    b, n, _ = u.shape
    u = jax.nn.gelu(u)
    v = jax.nn.gelu(v).reshape(b, n // CHUNK, CHUNK, SGU_GROUPS, SGU_GROUP_DIM)
    v = rms_norm(v, v_norm_w)
    s = jnp.einsum('gpq,bcqgd->bcpgd', w_sgu, v) + b_sgu.T[:, :, None]
    return u * s.reshape(b, n, SGU_WIDTH)


def setup_inputs(seed: int = 0) -> dict:
    key = jax.random.key(seed)
    ks = jax.random.split(key, 16)
    f32 = jnp.float32
    nrm = lambda k, shape: jax.random.normal(k, shape, f32)
    return {
        "x": nrm(ks[0], (BATCH, SEQ, D_MODEL)),
        "c": nrm(ks[1], (BATCH, D_MODEL)),
        "ctx": nrm(ks[2], (BATCH, CTX_LEN, D_MODEL)),
        "c_ctx": nrm(ks[3], (D_MODEL,)),
        "norm_w": 1.0 + 0.02 * nrm(ks[4], (DEPTH, D_MODEL)),
        "w_mod": 0.5 * D_MODEL ** -0.5 * nrm(ks[5], (DEPTH, D_MODEL, 3 * D_MODEL)),
        "b_mod": 0.01 * nrm(ks[6], (DEPTH, 3 * D_MODEL)),
        "w_in": D_MODEL ** -0.5 * nrm(ks[7], (DEPTH, D_MODEL, D_IN)),
        "w_sgu": CHUNK ** -0.5 * nrm(ks[8], (DEPTH, SGU_GROUPS, CHUNK, CHUNK)),
        "b_sgu": 1.0 + 0.02 * nrm(ks[9], (DEPTH, SGU_GROUPS, CHUNK)),
        "v_norm_w": 1.0 + 0.02 * nrm(ks[10], (DEPTH, SGU_GROUPS, SGU_GROUP_DIM)),
        "q_norm_w": 1.0 + 0.02 * nrm(ks[11], (DEPTH, HEAD_DIM)),
        "k_norm_w": 1.0 + 0.02 * nrm(ks[12], (DEPTH, HEAD_DIM)),
        "w_out": D_MIX ** -0.5 * nrm(ks[13], (DEPTH, D_MIX, D_MODEL)),
    }


def reference(x, c, ctx, c_ctx, norm_w, w_mod, b_mod, w_in, w_sgu, b_sgu, v_norm_w,
              q_norm_w, k_norm_w, w_out):
    n_lat = x.shape[1]
    cos, sin = axial_rope_tables(n_lat, x.dtype)
    xc = ctx
    for layer in range(DEPTH):
        last = layer == DEPTH - 1
        shift, scale, gate = modulation(c, w_mod[layer], b_mod[layer])
        shift_c, scale_c, gate_c = modulation(c_ctx, w_mod[layer], b_mod[layer])
        h = rms_norm(x, norm_w[layer]) * (1.0 + scale) + shift
        hc = rms_norm(xc, norm_w[layer]) * (1.0 + scale_c) + shift_c

        if last:
            proj_kv_c = hc @ w_in[layer][:, KV_START:KV_END]
            k_c, v_c = jnp.split(proj_kv_c, 2, axis=-1)
            kc, vc = kv_heads(k_c, v_c, k_norm_w[layer])
        else:
            proj_c = hc @ w_in[layer]
            u_c, v_c_sgu, za_c, q_c, k_c, v_c, zb_c = jnp.split(proj_c, SPLIT_POINTS, axis=-1)
            kc, vc = kv_heads(k_c, v_c, k_norm_w[layer])
            qc = rms_norm(split_heads(q_c, N_Q_HEADS), q_norm_w[layer])
            attn_c = blocked_gqa(qc, kc, vc)
            sgu_c = chunk_sgu(u_c, v_c_sgu, w_sgu[layer], b_sgu[layer], v_norm_w[layer])
            y_c = jnp.concatenate([sgu_c * jax.nn.silu(za_c),
                                   merge_heads(attn_c) * jax.nn.silu(zb_c)], axis=-1) @ w_out[layer]

        proj = h @ w_in[layer]
        u, v_sgu, za, q, k, v, zb = jnp.split(proj, SPLIT_POINTS, axis=-1)
        q = apply_axial_rope(rms_norm(split_heads(q, N_Q_HEADS), q_norm_w[layer]), cos, sin)
        k, v = kv_heads(k, v, k_norm_w[layer])
        k = apply_axial_rope(k, cos, sin)
        k_all = jnp.concatenate([kc, k], axis=2)
        v_all = jnp.concatenate([vc, v], axis=2)
        attn = blocked_gqa(q, k_all, v_all)
        sgu = chunk_sgu(u, v_sgu, w_sgu[layer], b_sgu[layer], v_norm_w[layer])
        y = jnp.concatenate([sgu * jax.nn.silu(za),
                             merge_heads(attn) * jax.nn.silu(zb)], axis=-1) @ w_out[layer]
        x = x + gate * y
        if not last:
            xc = xc + gate_c * y_c
    return x
```

```cpp
#include <hip/hip_runtime.h>
#include <hip/hip_cooperative_groups.h>
#include <hip/hip_bf16.h>
#include <cstdio>
#include <cstdint>
namespace cg = cooperative_groups;

#ifndef MK_MULTI
#define MK_MULTI 0
#endif

constexpr int DM = 2048, NB = 4, SEQ = 4096, CTX = 256, RPB = CTX + SEQ, MROWS = NB * RPB, DIN = 5632;
constexpr int C_U = 0, C_V = 1024, C_ZA = 2048, C_Q = 3072, C_K = 4096, C_VA = 4352, C_ZB = 4608;
constexpr int TPB = RPB / 256;
constexpr float EPS = 1e-6f;
constexpr int NPHASE = 9;
constexpr size_t MiB = 1u << 20;
constexpr size_t WS_MOD = 0;
constexpr size_t WS_ROPE = 1 * MiB;
constexpr size_t WS_WSGU = 2 * MiB;
constexpr size_t WS_BAR = 3 * MiB;
constexpr size_t WS_XC1 = 4 * MiB;
constexpr size_t WS_WIN = 16 * MiB;
constexpr size_t WS_WOUT = 64 * MiB;
constexpr size_t WS_H = 80 * MiB;
constexpr size_t WS_P = 160 * MiB;
constexpr size_t WS_KC = 352 * MiB;
constexpr size_t WS_VC = 368 * MiB;
constexpr size_t WS_END = 384 * MiB;
constexpr int LDS_BYTES = 147456;
constexpr int XCH_OFF = 131072;

struct Args { const float* in[14]; float* out; unsigned char* ws; int ph_lo, ph_hi, coop, sub; };
#define LAS __attribute__((address_space(3)))
namespace pg8 {
#define PG8_LAS __attribute__((address_space(3)))
typedef unsigned short bf16_t;
typedef short bf16x8 __attribute__((ext_vector_type(8)));
typedef float f32x4 __attribute__((ext_vector_type(4)));
typedef unsigned u32x4 __attribute__((ext_vector_type(4)));
constexpr int BM = 256, BK = 64, HALF = 128, HTB = HALF * BK * 2  , STAGE_BYTES = 8 * HTB, NXCD = 8, WGM = 8;

__host__ __device__ __forceinline__ int lds_byte(int r, int c) { const int st = (r >> 4) * 2 + (c >> 5), rr = r & 15, cc = c & 31, ob = rr * 64 + cc * 2; return st * 1024 + (ob ^ (((ob >> 9) & 1) << 5)); }
__host__ __device__ __forceinline__ void stage_rc(int b, int& R, int& C) { const int st = b / 1024, sb = b % 1024, swz = sb ^ (((sb >> 9) & 1) << 5); R = (st >> 1) * 16 + swz / 64; C = (st & 1) * 32 + (swz % 64) / 2; }
__host__ __device__ __forceinline__ int perm32(int rho) { const int n = rho >> 4, i = rho & 15; return 8 * (i >> 2) + 4 * n + (i & 3); }

struct Unit { int pm, pn; };
struct Gemm { const bf16_t* A; const bf16_t* Bt; int M, N, K; };

struct StaticOrder {
    int nM, nN, nwg, G, c;
    __host__ __device__ void init(int M, int N, int G_, int c_) { nM = M / BM; nN = N / BM; nwg = nM * nN; G = G_; c = c_; }
    __host__ __device__ bool next(int i, Unit& u) const {
        const long L = (long)i * G + c; if (L >= nwg) return false;
        int wgid = (int)L; { const int q = nwg / NXCD, r = nwg % NXCD, xcd = wgid % NXCD, off = wgid / NXCD; wgid = (xcd < r ? xcd * (q + 1) : r * (q + 1) + (xcd - r) * q) + off; }
        const int nig = WGM * nN, gid = wgid / nig, fm = gid * WGM, gsz = (nM - fm) < WGM ? (nM - fm) : WGM;
        u.pm = fm + ((wgid % nig) % gsz); u.pn = (wgid % nig) / gsz; return true;
    }
    __device__ __forceinline__ void a_ready(const Unit&) const {}
    __device__ __forceinline__ void done(const Unit&) const {}
};

__device__ __forceinline__ unsigned cvt_pk_bf16(float lo, float hi) { unsigned r; asm volatile("v_cvt_pk_bf16_f32 %0, %1, %2" : "=v"(r) : "v"(lo), "v"(hi)); return r; }
typedef float f32x2 __attribute__((ext_vector_type(2)));
__device__ __forceinline__ f32x4 gelu4(f32x4 x) {
    f32x4 o;
#pragma unroll
    for (int i = 0; i < 4; ++i) { const float v = x[i], t = v * (1.f + 0.044715f * v * v); const float e = __builtin_amdgcn_exp2f(-2.3022081981f * t); o[i] = v * __builtin_amdgcn_rcpf(1.f + e); }
    return o;
}
__device__ __forceinline__ f32x4 silu4(f32x4 x) {
    f32x4 o;
#pragma unroll
    for (int i = 0; i < 4; ++i) { const float v = x[i]; const float e = __builtin_amdgcn_exp2f(-1.4426950409f * v); o[i] = v * __builtin_amdgcn_rcpf(1.f + e); }
    return o;
}
__device__ __forceinline__ void store8(bf16_t* p, f32x4 v0, f32x4 v1) {
    u32x4 w; w.x = cvt_pk_bf16(v0[0], v0[1]); w.y = cvt_pk_bf16(v0[2], v0[3]); w.z = cvt_pk_bf16(v1[0], v1[1]); w.w = cvt_pk_bf16(v1[2], v1[3]); *(u32x4*)p = w;
}
struct EpiIn {
    static constexpr bool PERM = true, AFTER_DRAIN = false;
    bf16_t* P; const float* vnw; const float* qnw; const float* knw; const float* ropec; const float* ropes; PG8_LAS float* xch; bf16_t* Kc; bf16_t* Vc;
    __device__ __forceinline__ void operator()(f32x4 (&acc)[2][2][4][2], const Unit& u, int wr, int wc, int fr, int fq) const {
        const int pn = u.pn;
        const int colw = wc * 32 + 8 * fq;
        bf16_t* base = P + (size_t)(u.pm * 256 + wr * 64 + fr) * 5632 + pn * 256 + colw;
        if (pn == 17) {
            const int b = u.pm / 17, rb = (u.pm % 17) * 256 + wr * 64 + fr;
            bf16_t* vb_ = Vc + ((size_t)(b * 2) * 4352 + rb) * 128 + colw;
#pragma unroll
            for (int ai = 0; ai < 2; ++ai)
#pragma unroll
                for (int m = 0; m < 4; ++m)
#pragma unroll
                    for (int bj = 0; bj < 2; ++bj) store8(vb_ + ((size_t)bj * 4352 + ai * 128 + m * 16) * 128, acc[ai][bj][m][0], acc[ai][bj][m][1]);
            return;
        }
        if (pn < 4 || (pn >= 8 && pn < 12) || pn >= 17) {
            const int act = pn < 4 ? 0 : (pn == 17 ? 2 : 1);
#pragma unroll
            for (int ai = 0; ai < 2; ++ai)
#pragma unroll
                for (int m = 0; m < 4; ++m) { bf16_t* rp = base + (size_t)(ai * 128 + m * 16) * 5632;
#pragma unroll
                    for (int bj = 0; bj < 2; ++bj) { f32x4 v0 = acc[ai][bj][m][0], v1 = acc[ai][bj][m][1];
                        if (act == 0) { v0 = gelu4(v0); v1 = gelu4(v1); } else if (act == 1) { v0 = silu4(v0); v1 = silu4(v1); }
                        store8(rp + bj * 128, v0, v1); } }
            return;
        }
        if (pn < 8) gn_path<true>(acc, u, wr, wc, fr, fq, base, colw); else gn_path<false>(acc, u, wr, wc, fr, fq, base, colw);
    }
    template <bool ISV>
    __device__ __forceinline__ void gn_path(const f32x4 (&acc)[2][2][4][2], const Unit& u, int wr, int wc, int fr, int fq, bf16_t* base, int colw) const {
        const int pn = u.pn;
#pragma unroll
        for (int ai = 0; ai < 2; ++ai)
#pragma unroll
            for (int m = 0; m < 4; ++m)
#pragma unroll
                for (int bj = 0; bj < 2; ++bj) { f32x4 a = acc[ai][bj][m][0], b = acc[ai][bj][m][1];
                    if (ISV) { a = gelu4(a); b = gelu4(b); }
                    float s = (a[0] * a[0] + a[1] * a[1]) + (a[2] * a[2] + a[3] * a[3]) + (b[0] * b[0] + b[1] * b[1]) + (b[2] * b[2] + b[3] * b[3]);
                    s += __shfl_xor(s, 16); s += __shfl_xor(s, 32);
                    if (fq == 0) xch[(ai * 128 + wr * 64 + m * 16 + fr) * 8 + bj * 4 + wc] = s;
                    if (ISV) __builtin_amdgcn_sched_barrier(0); }
        asm volatile("s_waitcnt lgkmcnt(0)" ::: "memory"); __builtin_amdgcn_s_barrier(); asm volatile("" ::: "memory");
        f32x4 w[2][2];
        if (ISV) {
#pragma unroll
            for (int bj = 0; bj < 2; ++bj)
#pragma unroll
                for (int n = 0; n < 2; ++n) w[bj][n] = *(const f32x4*)(vnw + ((pn - 4) * 2 + bj) * 128 + colw + 4 * n);
        } else {
            const float* nwp = pn < 16 ? qnw : knw; const int dlo = 64 * (wc >> 1) + 16 * (wc & 1) + 4 * fq;
            w[0][0] = *(const f32x4*)(nwp + dlo); w[0][1] = *(const f32x4*)(nwp + dlo + 32); w[1][0] = w[0][0]; w[1][1] = w[0][1];
        }
        const int jt = u.pm % 17;
        const bool rope = !ISV && jt != 0;
#pragma unroll
        for (int ai = 0; ai < 2; ++ai)
#pragma unroll
            for (int m = 0; m < 4; ++m) { const int rl = ai * 128 + wr * 64 + m * 16 + fr; bf16_t* rp = base + (size_t)(ai * 128 + m * 16) * 5632; size_t bjs = 128;
                if (!ISV) { if (pn == 16) { rp = Kc + ((size_t)((u.pm / 17) * 2) * 4352 + jt * 256 + rl) * 128 + colw; bjs = (size_t)4352 * 128; } }
                f32x4 cs = {1.f, 1.f, 1.f, 1.f}, sn = {0.f, 0.f, 0.f, 0.f};
                if (!ISV) { if (rope) { const int t = jt * 256 + rl - 256; const int pos = (wc >> 1) ? (t & 63) : (t >> 6); const int fi = pos * 32 + 16 * (wc & 1) + 4 * fq;
                    cs = *(const f32x4*)(ropec + fi); sn = *(const f32x4*)(ropes + fi); } }
#pragma unroll
                for (int bj = 0; bj < 2; ++bj) { const f32x4 pr = *(const PG8_LAS f32x4*)(xch + rl * 8 + bj * 4);
                    const float rstd = __builtin_amdgcn_rsqf(((pr[0] + pr[1]) + (pr[2] + pr[3])) * (1.f / 128.f) + 1e-6f);
                    f32x4 a0 = acc[ai][bj][m][0], a1 = acc[ai][bj][m][1];
                    if (ISV) { asm volatile("" : "+v"(a0), "+v"(a1));
                        a0 = gelu4(a0); a1 = gelu4(a1); }
                    a0 = a0 * rstd * w[bj][0]; a1 = a1 * rstd * w[bj][1];
                    if (!ISV) { const f32x4 o0 = a0 * cs - a1 * sn, o1 = a1 * cs + a0 * sn; a0 = o0; a1 = o1; }
                    store8(rp + bj * bjs, a0, a1); }
                asm volatile("" ::: "memory"); }
    }
};
struct EpiOut {
    static constexpr bool PERM = false, AFTER_DRAIN = false;
    const float* xsrc; const float* csrc; float* xdst; float* cdst; const float* gate;
    __device__ __forceinline__ void operator()(f32x4 (&acc)[2][2][4][2], const Unit& u, int wr, int wc, int fr, int fq) const {
        const int b = u.pm / 17, jt = u.pm % 17;
        const float* src; float* dst; int grow;
        if (jt == 0) { const size_t off = (size_t)(b * 256) * 2048; src = csrc + off; dst = cdst + off; grow = 4; }
        else { const size_t off = (size_t)(b * 4096 + (jt - 1) * 256) * 2048; src = xsrc + off; dst = xdst + off; grow = b; }
        const int col0 = u.pn * 256 + wc * 32 + 4 * fq;
        f32x4 gv[2][2];
#pragma unroll
        for (int bj = 0; bj < 2; ++bj)
#pragma unroll
            for (int n = 0; n < 2; ++n) gv[bj][n] = *(const f32x4*)(gate + grow * 6144 + col0 + bj * 128 + n * 16);
#pragma unroll
        for (int ai = 0; ai < 2; ++ai)
#pragma unroll
            for (int m = 0; m < 4; ++m) { const size_t ro = (size_t)(wr * 64 + fr + ai * 128 + m * 16) * 2048 + col0;
                f32x4 xs[2][2];
#pragma unroll
                for (int bj = 0; bj < 2; ++bj)
#pragma unroll
                    for (int n = 0; n < 2; ++n) xs[bj][n] = *(const f32x4*)(src + ro + bj * 128 + n * 16);
#pragma unroll
                for (int bj = 0; bj < 2; ++bj)
#pragma unroll
                    for (int n = 0; n < 2; ++n) *(f32x4*)(dst + ro + bj * 128 + n * 16) = xs[bj][n] + gv[bj][n] * acc[ai][bj][m][n];
                if (m & 1) asm volatile("" ::: "memory"); }
    }
};
struct SchedX {
    int nM, nN, nwg, G, c, lat, extra;
    __device__ void init(int nM_, int nN_, int G_, int c_, int lat_, int extra_) { nM = nM_; nN = nN_; nwg = nM_ * nN_; G = G_; c = c_; lat = lat_; extra = extra_; }
    __device__ bool next(int i, Unit& u) const {
        long L = (long)i * G + c;
        if (L < nwg) {
            int wgid = (int)L; { const int q = nwg / NXCD, r = nwg % NXCD, xcd = wgid % NXCD, off = wgid / NXCD; wgid = (xcd < r ? xcd * (q + 1) : r * (q + 1) + (xcd - r) * q) + off; }
            const int nig = WGM * nN, gid = wgid / nig, fm = gid * WGM, gsz = (nM - fm) < WGM ? (nM - fm) : WGM;
            const int pmq = fm + ((wgid % nig) % gsz); u.pn = (wgid % nig) / gsz;
            u.pm = lat ? (pmq / 16) * 17 + 1 + (pmq % 16) : pmq; return true;
        }
        L -= nwg; if (L < extra) { u.pm = (int)(L >> 1) * 17; u.pn = 16 + (int)(L & 1); return true; }
        return false;
    }
    __device__ __forceinline__ void a_ready(const Unit&) const {}
    __device__ __forceinline__ void done(const Unit&) const {}
};
template <class Epi, class Sched, bool ALIGN_EPI = false, bool SP2 = false>
__device__ __forceinline__ void gemm_phase(PG8_LAS unsigned char* lds, const Gemm g, const Sched& S, const Epi& E) {
    int tid_ = threadIdx.x; asm volatile("" : "+v"(tid_));
    const int tid = tid_, wid = __builtin_amdgcn_readfirstlane(tid >> 6), lane = tid & 63, wr = wid >> 2, wc = wid & 3, fr = lane & 15, fq = lane >> 4;
    const int K = g.K, nt = K / BK;
    unsigned voffA[2], voffB[2];
#pragma unroll
    for (int i = 0; i < 2; ++i) { int R, C; stage_rc(tid * 16 + i * 8192, R, C); const int Rb = Epi::PERM ? ((R & ~31) + perm32(R & 31)) : R;
        voffA[i] = (unsigned)(R * K + C) * 2u; voffB[i] = (unsigned)(Rb * K + C) * 2u; }
    const size_t kstep = (size_t)(BK * 2);
    const size_t hstep = (size_t)HALF * K * 2;
    const size_t tstep = 2 * hstep;
    const unsigned ldsw = (unsigned)wid * 1024u;
    const int aoff = lds_byte(wr * 64 + fr, fq * 8), boff = lds_byte(wc * 32 + fr, fq * 8);
#define PG8_SA(b, h) (((b) * 2 + (h)) * HTB)
#define PG8_SB(b, h) ((4 + (b) * 2 + (h)) * HTB)
#define PG8_STAGE(bufoff, gbase, voff) do { _Pragma("unroll") for (int _i = 0; _i < 2; ++_i) \
        __builtin_amdgcn_global_load_lds((const unsigned*)((const char*)(gbase) + (voff)[_i]), (PG8_LAS unsigned*)(lds + (bufoff) + ldsw + _i * 8192), 16, 0, 0); } while (0)
#define PG8_LDA(dst, b, h) do { _Pragma("unroll") for (int m = 0; m < 4; ++m) _Pragma("unroll") for (int k = 0; k < 2; ++k) dst[m][k] = *(const PG8_LAS bf16x8*)(lds + PG8_SA(b, h) + aoff + m * 2048 + k * 1024); } while (0)
#define PG8_LDB(dst, b, h) do { _Pragma("unroll") for (int n = 0; n < 2; ++n) _Pragma("unroll") for (int k = 0; k < 2; ++k) dst[n][k] = *(const PG8_LAS bf16x8*)(lds + PG8_SB(b, h) + boff + n * 2048 + k * 1024); } while (0)
#define PG8_MMA(ai, bj, At, Bt) do { __builtin_amdgcn_s_setprio(1); _Pragma("unroll") for (int m = 0; m < 4; ++m) _Pragma("unroll") for (int n = 0; n < 2; ++n) _Pragma("unroll") for (int k = 0; k < 2; ++k) \
        acc[ai][bj][m][n] = __builtin_amdgcn_mfma_f32_16x16x32_bf16(Bt[n][k], At[m][k], acc[ai][bj][m][n], 0, 0, 0); __builtin_amdgcn_s_setprio(0); } while (0)
#define PG8_WAIT_V(n) asm volatile("s_waitcnt vmcnt(" #n ")" ::: "memory")
#define PG8_WAIT_L(n) asm volatile("s_waitcnt lgkmcnt(" #n ")" ::: "memory")
#define PG8_BAR __builtin_amdgcn_s_barrier()
#define PG8_SCHED __builtin_amdgcn_sched_barrier(0)
    Unit cur, nxt; int ui = 0;
    if (!S.next(0, cur)) return;
    f32x4 acc[2][2][4][2];
#pragma unroll
    for (int a = 0; a < 2; ++a)
#pragma unroll
        for (int b = 0; b < 2; ++b)
#pragma unroll
            for (int m = 0; m < 4; ++m)
#pragma unroll
                for (int n = 0; n < 2; ++n) acc[a][b][m][n] = (f32x4){0.f, 0.f, 0.f, 0.f};
    bf16x8 At[4][2], B0[2][2], B1[2][2];
    const char* cA = (const char*)g.A + (size_t)cur.pm * tstep; const char* cB = (const char*)g.Bt + (size_t)cur.pn * tstep;
    S.a_ready(cur);
    if constexpr (SP2) {
        PG8_STAGE(PG8_SB(0, 0), cB, voffB); PG8_STAGE(PG8_SB(0, 1), cB + hstep, voffB); PG8_STAGE(PG8_SA(0, 0), cA, voffA); PG8_STAGE(PG8_SA(0, 1), cA + hstep, voffA);
        if (wr == 1) PG8_BAR;
        PG8_WAIT_V(2); PG8_BAR;
        PG8_STAGE(PG8_SB(1, 0), cB + kstep, voffB); PG8_STAGE(PG8_SA(1, 0), cA + kstep, voffA); PG8_STAGE(PG8_SB(1, 1), cB + hstep + kstep, voffB);
        PG8_WAIT_V(6); PG8_BAR;
    } else {
        PG8_STAGE(PG8_SB(0, 0), cB, voffB); PG8_STAGE(PG8_SA(0, 0), cA, voffA); PG8_STAGE(PG8_SB(0, 1), cB + hstep, voffB); PG8_STAGE(PG8_SA(0, 1), cA + hstep, voffA);
        if (wr == 1) PG8_BAR;
        PG8_WAIT_V(4); PG8_BAR;
        PG8_STAGE(PG8_SB(1, 0), cB + kstep, voffB); PG8_STAGE(PG8_SA(1, 0), cA + kstep, voffA); PG8_STAGE(PG8_SB(1, 1), cB + hstep + kstep, voffB);
        PG8_WAIT_V(6); PG8_BAR;
    }
    for (;;) {
        const bool has_next = S.next(ui + 1, nxt);
        const char* nA = has_next ? (const char*)g.A + (size_t)nxt.pm * tstep : cA; const char* nB = has_next ? (const char*)g.Bt + (size_t)nxt.pn * tstep : cB;
        for (int t = 0; t < nt; t += 2) {
            const bool last = (t == nt - 2);
            const char* a1 = cA + (size_t)(t + 1) * kstep;
            const char* a2 = last ? nA : cA + (size_t)(t + 2) * kstep; const char* b2 = last ? nB : cB + (size_t)(t + 2) * kstep;
            const char* a3 = a2 + kstep; const char* b3 = b2 + kstep;
            if (last && has_next) S.a_ready(nxt);
            if constexpr (SP2) {
            PG8_LDB(B0, 0, 0); PG8_LDB(B1, 0, 1); PG8_SCHED; PG8_LDA(At, 0, 0); PG8_STAGE(PG8_SA(1, 1), a1 + hstep, voffA);
            PG8_WAIT_V(8); PG8_WAIT_L(0); PG8_BAR; PG8_MMA(0, 0, At, B0); PG8_MMA(0, 1, At, B1); PG8_BAR; PG8_SCHED;
            PG8_LDA(At, 0, 1); PG8_STAGE(PG8_SB(0, 0), b2, voffB); PG8_STAGE(PG8_SB(0, 1), b2 + hstep, voffB); PG8_STAGE(PG8_SA(0, 0), a2, voffA);
            PG8_WAIT_V(8); PG8_WAIT_L(0); PG8_BAR; PG8_MMA(1, 0, At, B0); PG8_MMA(1, 1, At, B1); PG8_BAR; PG8_SCHED;
            PG8_LDB(B0, 1, 0); PG8_LDB(B1, 1, 1); PG8_SCHED; PG8_LDA(At, 1, 0); PG8_STAGE(PG8_SA(0, 1), a2 + hstep, voffA);
            PG8_WAIT_V(8); PG8_WAIT_L(0); PG8_BAR; PG8_MMA(0, 0, At, B0); PG8_MMA(0, 1, At, B1); PG8_BAR; PG8_SCHED;
            PG8_LDA(At, 1, 1); PG8_STAGE(PG8_SB(1, 0), b3, voffB); PG8_STAGE(PG8_SB(1, 1), b3 + hstep, voffB); PG8_STAGE(PG8_SA(1, 0), a3, voffA);
            PG8_WAIT_V(8); PG8_WAIT_L(0); PG8_BAR; PG8_MMA(1, 0, At, B0); PG8_MMA(1, 1, At, B1); PG8_BAR; PG8_SCHED;
            } else {
            PG8_LDB(B0, 0, 0); PG8_SCHED; PG8_LDA(At, 0, 0); PG8_STAGE(PG8_SA(1, 1), a1 + hstep, voffA);
            PG8_WAIT_L(8); PG8_BAR; PG8_WAIT_L(0); PG8_MMA(0, 0, At, B0); PG8_BAR; PG8_SCHED;
            PG8_LDB(B1, 0, 1); PG8_STAGE(PG8_SB(0, 0), b2, voffB);
            PG8_BAR; PG8_WAIT_L(0); PG8_MMA(0, 1, At, B1); PG8_BAR;
            PG8_LDA(At, 0, 1); PG8_STAGE(PG8_SA(0, 0), a2, voffA);
            PG8_BAR; PG8_WAIT_L(0); PG8_MMA(1, 0, At, B0); PG8_BAR; PG8_SCHED;
            PG8_STAGE(PG8_SB(0, 1), b2 + hstep, voffB);
            PG8_WAIT_V(6); PG8_BAR; PG8_MMA(1, 1, At, B1); PG8_BAR;
            PG8_LDB(B0, 1, 0); PG8_SCHED; PG8_LDA(At, 1, 0); PG8_STAGE(PG8_SA(0, 1), a2 + hstep, voffA);
            PG8_WAIT_L(8); PG8_BAR; PG8_WAIT_L(0); PG8_MMA(0, 0, At, B0); PG8_BAR; PG8_SCHED;
            PG8_LDB(B1, 1, 1); PG8_STAGE(PG8_SB(1, 0), b3, voffB);
            PG8_BAR; PG8_WAIT_L(0); PG8_MMA(0, 1, At, B1); PG8_BAR;
            PG8_LDA(At, 1, 1); PG8_STAGE(PG8_SA(1, 0), a3, voffA);
            PG8_BAR; PG8_WAIT_L(0); PG8_MMA(1, 0, At, B0); PG8_BAR; PG8_SCHED;
            PG8_STAGE(PG8_SB(1, 1), b3 + hstep, voffB);
            PG8_WAIT_V(6); PG8_BAR; PG8_MMA(1, 1, At, B1); PG8_BAR;
            }
        }
        if constexpr (ALIGN_EPI) { if (wr == 0) PG8_BAR; }
        if constexpr (!Epi::AFTER_DRAIN) { E(acc, cur, wr, wc, fr, fq); S.done(cur); }
        if (!has_next) break;
#pragma unroll
        for (int a = 0; a < 2; ++a)
#pragma unroll
            for (int b = 0; b < 2; ++b)
#pragma unroll
                for (int m = 0; m < 4; ++m)
#pragma unroll
                    for (int n = 0; n < 2; ++n) acc[a][b][m][n] = (f32x4){0.f, 0.f, 0.f, 0.f};
        cur = nxt; cA = nA; cB = nB; ++ui;
        if constexpr (ALIGN_EPI) { if (wr == 1) PG8_BAR; }
    }
    PG8_WAIT_V(0);
    if constexpr (!ALIGN_EPI) { if (wr == 0) PG8_BAR; }
    PG8_BAR;
    if constexpr (Epi::AFTER_DRAIN) { E.fused(acc, cur, wr, wc, fr, fq, lds, wid, lane); S.done(cur); }
#undef PG8_SA
#undef PG8_SB
#undef PG8_STAGE
#undef PG8_LDA
#undef PG8_LDB
#undef PG8_MMA
#undef PG8_WAIT_V
#undef PG8_WAIT_L
#undef PG8_BAR
#undef PG8_SCHED
}
}
namespace at {
using bf16 = __hip_bfloat16;
constexpr int   D = 128, NW = 8, QBLK = 32, KVBLK = 64;
constexpr float SCALE = 0.088388347648318440f;
#ifndef ATTN_THR
#define ATTN_THR 8.f
#endif
constexpr float THR = ATTN_THR;
constexpr int SDEPTH = 2;
constexpr int LDQ = 5632, LDK = 128, LDO = 2048;
constexpr size_t SHM_V = KVBLK * D * 2, SHM_K = KVBLK * D * 2, SHM_ATTN = 2 * SHM_V + 2 * SHM_K + NW * 64 * 4;
using f32x4v = __attribute__((ext_vector_type(4))) float;
using bf16x8 = __attribute__((ext_vector_type(8))) short;
using s16x4  = __attribute__((ext_vector_type(4))) short;
using f32x16 = __attribute__((ext_vector_type(16))) float;
using f32x8  = __attribute__((ext_vector_type(8))) float;
using u32x4  = __attribute__((ext_vector_type(4))) unsigned;
#define KSWZ(row, colB) ((row) * 256 + ((colB) ^ (((row) & 7) << 4)))
#define SBAR() __builtin_amdgcn_sched_barrier(0)
__device__ __forceinline__ int crow(int r, int hi) { return (r & 3) + 8 * (r >> 2) + 4 * hi; }
__device__ __forceinline__ unsigned cvtpk(float lo, float hi) {
  unsigned r; asm volatile("v_cvt_pk_bf16_f32 %0, %1, %2" : "=v"(r) : "v"(lo), "v"(hi)); return r;
}
template <typename TIn> struct Stage;
template <> struct Stage<bf16>  { using T = bf16x8;
  __device__ static __forceinline__ T ld8(const bf16* p) { return *reinterpret_cast<const bf16x8*>(p); }
  __device__ static __forceinline__ bf16x8 tobf(T x) { return x; } };
template <> struct Stage<float> { using T = f32x8;
  __device__ static __forceinline__ T ld8(const float* p) { return *reinterpret_cast<const f32x8*>(p); }
  __device__ static __forceinline__ bf16x8 tobf(T x) {
    u32x4 w = {cvtpk(x[0], x[1]), cvtpk(x[2], x[3]), cvtpk(x[4], x[5]), cvtpk(x[6], x[7])}; return *reinterpret_cast<bf16x8*>(&w); } };

__device__ __forceinline__ void partialSM(f32x16& p0, f32x16& p1, float& m_reg, float& mn, float& alpha) {
  constexpr float C = SCALE * 1.4426950408889634f;
  float pmax = p0[0]; for (int r = 1; r < 16; ++r) pmax = fmaxf(pmax, p0[r]); for (int r = 0; r < 16; ++r) pmax = fmaxf(pmax, p1[r]);
  { auto rr = __builtin_amdgcn_permlane32_swap(__float_as_uint(pmax), __float_as_uint(pmax), false, false);
    pmax = fmaxf(__uint_as_float(rr[0]), __uint_as_float(rr[1])); }
  if (__builtin_expect(__all(pmax - m_reg <= THR / SCALE), 1)) { mn = m_reg; alpha = 1.f; }
  else { mn = fmaxf(m_reg, pmax); alpha = __builtin_amdgcn_exp2f((m_reg - mn) * C); m_reg = mn; }
  float mnC = -mn * C;
  for (int r = 0; r < 16; ++r) p0[r] = fmaf(p0[r], C, mnC); for (int r = 0; r < 16; ++r) p1[r] = fmaf(p1[r], C, mnC);
  for (int r = 0; r < 16; ++r) p0[r] = __builtin_amdgcn_exp2f(p0[r]);
}
__device__ __forceinline__ void finishSM(f32x16& p0, f32x16& p1, float alpha, float& l_reg, bf16x8& pa0, bf16x8& pa1, bf16x8& pa2, bf16x8& pa3) {
  for (int r = 0; r < 16; ++r) p1[r] = __builtin_amdgcn_exp2f(p1[r]);
  float ps = 0; for (int r = 0; r < 16; ++r) ps += p0[r]; for (int r = 0; r < 16; ++r) ps += p1[r];
  { auto rr = __builtin_amdgcn_permlane32_swap(__float_as_uint(ps), __float_as_uint(ps), false, false);
    ps = __uint_as_float(rr[0]) + __uint_as_float(rr[1]); }
  l_reg = l_reg * alpha + ps;
#define PK4(P, BASE, OUT) do { unsigned a0 = cvtpk(P[BASE + 0], P[BASE + 1]), a1 = cvtpk(P[BASE + 2], P[BASE + 3]);   \
    unsigned b0 = cvtpk(P[BASE + 4], P[BASE + 5]), b1 = cvtpk(P[BASE + 6], P[BASE + 7]);                              \
    auto r0 = __builtin_amdgcn_permlane32_swap(a0, b0, false, false); auto r1 = __builtin_amdgcn_permlane32_swap(a1, b1, false, false); \
    u32x4 w = {r0[0], r1[0], r0[1], r1[1]}; OUT = *reinterpret_cast<bf16x8*>(&w); } while (0)
  PK4(p0, 0, pa0); PK4(p0, 8, pa1); PK4(p1, 0, pa2); PK4(p1, 8, pa3);
#undef PK4
}
__device__ __forceinline__ void qkt(f32x16& p0, f32x16& p1, const bf16* Ks, const bf16x8* qr, int r32, int hi) {
  p0 = f32x16{}; p1 = f32x16{};
  for (int d0 = 0; d0 < 8; ++d0) { int cb = (d0 * 16 + hi * 8) * 2;
    bf16x8 b0 = *reinterpret_cast<const bf16x8*>((const char*)Ks + KSWZ(r32, cb));
    bf16x8 b1 = *reinterpret_cast<const bf16x8*>((const char*)Ks + KSWZ(32 + r32, cb));
    p0 = __builtin_amdgcn_mfma_f32_32x32x16_bf16(b0, qr[d0], p0, 0, 0, 0);
    p1 = __builtin_amdgcn_mfma_f32_32x32x16_bf16(b1, qr[d0], p1, 0, 0, 0); }
}
__device__ __forceinline__ int v_st(int k, int c) { const int kk = (k & ~0xC) | ((k & 4) << 1) | ((k & 8) >> 1); return ((kk >> 3) * 4 + (c >> 5)) * 512 + ((kk & 7) * 32 + (c & 31)) * 2; }
__device__ __forceinline__ int v_rd_base(int lane) { return ((lane & 3) << 3) | (((lane >> 2) & 3) << 6) | (((lane >> 4) & 1) << 5) | (((lane >> 5) & 1) << 8); }
constexpr int v_rd_off(int d0, int ks, int half) { return d0 * 512 + ks * 4096 + half * 2048; }
template <int OFF> __device__ __forceinline__ s16x4 tr_read(int vb) {
  s16x4 r; asm volatile("ds_read_b64_tr_b16 %0, %1 offset:%2" : "=&v"(r) : "v"(vb), "i"(OFF) : "memory"); return r;
}
template <int D0> __device__ __forceinline__ void pv_one(f32x16& od, int vb, bf16x8 pa0, bf16x8 pa1, bf16x8 pa2, bf16x8 pa3) {
  const s16x4 l0 = tr_read<v_rd_off(D0, 0, 0)>(vb), h0 = tr_read<v_rd_off(D0, 0, 1)>(vb), l1 = tr_read<v_rd_off(D0, 1, 0)>(vb), h1 = tr_read<v_rd_off(D0, 1, 1)>(vb);
  const s16x4 l2 = tr_read<v_rd_off(D0, 2, 0)>(vb), h2 = tr_read<v_rd_off(D0, 2, 1)>(vb), l3 = tr_read<v_rd_off(D0, 3, 0)>(vb), h3 = tr_read<v_rd_off(D0, 3, 1)>(vb);
  asm volatile("s_waitcnt lgkmcnt(0)" ::: "memory"); SBAR();
#define PK(L, H) (bf16x8){L[0], L[1], L[2], L[3], H[0], H[1], H[2], H[3]}
  od = __builtin_amdgcn_mfma_f32_32x32x16_bf16(pa0, PK(l0, h0), od, 0, 0, 0);
  od = __builtin_amdgcn_mfma_f32_32x32x16_bf16(pa1, PK(l1, h1), od, 0, 0, 0);
  od = __builtin_amdgcn_mfma_f32_32x32x16_bf16(pa2, PK(l2, h2), od, 0, 0, 0);
  od = __builtin_amdgcn_mfma_f32_32x32x16_bf16(pa3, PK(l3, h3), od, 0, 0, 0);
#undef PK
}
__device__ __forceinline__ void pv_d0(f32x16* o, int vb, bf16x8 pa0, bf16x8 pa1, bf16x8 pa2, bf16x8 pa3) {
  pv_one<0>(o[0], vb, pa0, pa1, pa2, pa3); pv_one<1>(o[1], vb, pa0, pa1, pa2, pa3); pv_one<2>(o[2], vb, pa0, pa1, pa2, pa3); pv_one<3>(o[3], vb, pa0, pa1, pa2, pa3);
}

__device__ __forceinline__ void attn_dense_body(const bf16* __restrict__ Qb, const bf16* __restrict__ Kh, const bf16* __restrict__ Vh,
                                                const bf16* __restrict__ Zb, bf16* __restrict__ Ob, int seq, char* lds) {
  using TQ = bf16; using St = Stage<bf16>; using SQ = Stage<TQ>;
  int tid_ = threadIdx.x; asm volatile("" : "+v"(tid_));
  const int tid = tid_, wid = tid >> 6, lane = tid & 63, r32 = lane & 31, hi = lane >> 5;
  bf16* V_lds = (bf16*)lds; bf16* K_lds = (bf16*)(lds + 2 * SHM_V);
  float* ws = (float*)(lds + 2 * SHM_V + 2 * SHM_K) + wid * 64; float* li_l = ws; float* al_l = ws + 32;
  float m_reg = -1e30f, l_reg = 0; f32x16 o[4] = {}; bf16x8 qr[8];
  const TQ* Qw = Qb + (long)(wid * QBLK + r32) * LDQ + hi * 8;
#pragma unroll
  for (int d0 = 0; d0 < 8; ++d0) qr[d0] = SQ::tobf(SQ::ld8(Qw + d0 * 16));
  const int sr = tid >> 4, sc = (tid & 15) * 8, vst0 = v_st(sr, sc), vst1 = v_st(32 + sr, sc);
  const int vb0 = (int)(uintptr_t)V_lds + v_rd_base(lane);
  struct { typename St::T vs0, vs1, ks0, ks1; } sr_[SDEPTH];
#define SLOAD(i, k0) do { sr_[i].vs0 = St::ld8(&Vh[(long)((k0) + sr) * LDK + sc]); sr_[i].vs1 = St::ld8(&Vh[(long)((k0) + 32 + sr) * LDK + sc]); \
    sr_[i].ks0 = St::ld8(&Kh[(long)((k0) + sr) * LDK + sc]); sr_[i].ks1 = St::ld8(&Kh[(long)((k0) + 32 + sr) * LDK + sc]); } while (0)
#define SWRITE(b, i) do { *(bf16x8*)((char*)V_lds + (b) * SHM_V + vst0) = St::tobf(sr_[i].vs0);          \
    *(bf16x8*)((char*)V_lds + (b) * SHM_V + vst1) = St::tobf(sr_[i].vs1); int kc = sc * 2;               \
    *(bf16x8*)((char*)K_lds + (b) * SHM_K + KSWZ(sr, kc)) = St::tobf(sr_[i].ks0);                       \
    *(bf16x8*)((char*)K_lds + (b) * SHM_K + KSWZ(32 + sr, kc)) = St::tobf(sr_[i].ks1); } while (0)
#define SWAIT() do { if constexpr (SDEPTH == 2) asm volatile("s_waitcnt vmcnt(4)" ::: "memory"); else asm volatile("s_waitcnt vmcnt(0)" ::: "memory"); } while (0)
#define RESC(a) do { if (__any((a) < 1.f)) { if (hi == 0) al_l[r32] = (a); asm volatile("s_waitcnt lgkmcnt(0)" ::: "memory"); \
    for (int d = 0; d < 4; ++d) for (int r = 0; r < 16; ++r) o[d][r] *= al_l[crow(r, hi)]; } } while (0)
  f32x16 pA0, pA1, pB0, pB1; float mnA, mnB, alA, alB; bf16x8 pa0, pa1, pa2, pa3; const int NT = seq / KVBLK;
  constexpr int SE = 0, SO = SDEPTH - 1;
  SLOAD(SE, 0); asm volatile("s_waitcnt vmcnt(0)" ::: "memory"); SWRITE(0, SE); __syncthreads();
  qkt(pA0, pA1, K_lds, qr, r32, hi); partialSM(pA0, pA1, m_reg, mnA, alA);
  SLOAD(SO, KVBLK); if constexpr (SDEPTH == 2) { if (2 < NT) SLOAD(SE, 2 * KVBLK); }
  SWAIT(); SWRITE(1, SO); __syncthreads();
  for (int j = 1; j + 1 < NT; j += 2) {
    SBAR(); qkt(pB0, pB1, (bf16*)((char*)K_lds + SHM_K), qr, r32, hi);
    finishSM(pA0, pA1, alA, l_reg, pa0, pa1, pa2, pa3); SBAR();
    SLOAD(SO, (j + SDEPTH) * KVBLK); SBAR();
    pv_d0(o, vb0, pa0, pa1, pa2, pa3); partialSM(pB0, pB1, m_reg, mnB, alB);
    __syncthreads(); SWAIT(); SWRITE(0, SE);
    RESC(alB); __syncthreads();
    SBAR(); qkt(pA0, pA1, K_lds, qr, r32, hi);
    finishSM(pB0, pB1, alB, l_reg, pa0, pa1, pa2, pa3); SBAR();
    if (SDEPTH == 1 || j + 3 < NT) SLOAD(SE, (j + 1 + SDEPTH) * KVBLK); SBAR();
    pv_d0(o, vb0 + (int)SHM_V, pa0, pa1, pa2, pa3); partialSM(pA0, pA1, m_reg, mnA, alA);
    __syncthreads(); SWAIT(); SWRITE(1, SO);
    RESC(alA); __syncthreads();
  }
  SBAR(); qkt(pB0, pB1, (bf16*)((char*)K_lds + SHM_K), qr, r32, hi);
  finishSM(pA0, pA1, alA, l_reg, pa0, pa1, pa2, pa3); SBAR();
  pv_d0(o, vb0, pa0, pa1, pa2, pa3); partialSM(pB0, pB1, m_reg, mnB, alB);
  __syncthreads(); RESC(alB);
  finishSM(pB0, pB1, alB, l_reg, pa0, pa1, pa2, pa3); SBAR();
  pv_d0(o, vb0 + (int)SHM_V, pa0, pa1, pa2, pa3);
  if (hi == 0) li_l[r32] = l_reg; asm volatile("s_waitcnt lgkmcnt(0)" ::: "memory");
  float rli[16];
#pragma unroll
  for (int r = 0; r < 16; ++r) rli[r] = __builtin_amdgcn_rcpf(li_l[crow(r, hi)]);
  bf16* Ow = Ob + (long)(wid * QBLK) * LDO; const bf16* Zw = Zb + (long)(wid * QBLK) * LDQ;
  char* stg = lds + (2 * SHM_V + 2 * SHM_K + NW * 64 * 4) + wid * (32 * 272);
#pragma unroll
  for (int r = 0; r < 16; ++r) { const int orow = crow(r, hi);
#pragma unroll
    for (int d0 = 0; d0 < 4; ++d0) *(unsigned short*)(stg + orow * 272 + (d0 * 32 + r32) * 2) = (unsigned short)cvtpk(o[d0][r] * rli[r], 0.f); }
  asm volatile("s_waitcnt lgkmcnt(0)" ::: "memory");
  { const int c8 = (lane & 15) * 8, rq = lane >> 4;
#pragma unroll
    for (int i = 0; i < 8; ++i) { const int row = rq + 4 * i;
      const u32x4 ov = *reinterpret_cast<const u32x4*>(stg + row * 272 + c8 * 2);
      const u32x4 zv = *reinterpret_cast<const u32x4*>(Zw + (long)row * LDQ + c8);
      u32x4 w;
#define OZ(k) cvtpk(__uint_as_float(ov[k] << 16) * __uint_as_float(zv[k] << 16), __uint_as_float(ov[k] & 0xffff0000u) * __uint_as_float(zv[k] & 0xffff0000u))
      w[0] = OZ(0); w[1] = OZ(1); w[2] = OZ(2); w[3] = OZ(3);
#undef OZ
      *reinterpret_cast<u32x4*>(Ow + (long)row * LDO + c8) = w; } }
#undef SLOAD
#undef SWRITE
#undef SWAIT
#undef RESC
}
template <int D0> __device__ __forceinline__ void sgu_one(f32x16& od, int vb, bf16x8 w0, bf16x8 w1, bf16x8 w2, bf16x8 w3) {
  const s16x4 l0 = tr_read<v_rd_off(D0, 0, 0)>(vb), h0 = tr_read<v_rd_off(D0, 0, 1)>(vb), l1 = tr_read<v_rd_off(D0, 1, 0)>(vb), h1 = tr_read<v_rd_off(D0, 1, 1)>(vb);
  const s16x4 l2 = tr_read<v_rd_off(D0, 2, 0)>(vb), h2 = tr_read<v_rd_off(D0, 2, 1)>(vb), l3 = tr_read<v_rd_off(D0, 3, 0)>(vb), h3 = tr_read<v_rd_off(D0, 3, 1)>(vb);
  asm volatile("s_waitcnt lgkmcnt(0)" ::: "memory"); SBAR();
#define PK(L, H) (bf16x8){L[0], L[1], L[2], L[3], H[0], H[1], H[2], H[3]}
  od = __builtin_amdgcn_mfma_f32_32x32x16_bf16(PK(l0, h0), w0, od, 0, 0, 0);
  od = __builtin_amdgcn_mfma_f32_32x32x16_bf16(PK(l1, h1), w1, od, 0, 0, 0);
  od = __builtin_amdgcn_mfma_f32_32x32x16_bf16(PK(l2, h2), w2, od, 0, 0, 0);
  od = __builtin_amdgcn_mfma_f32_32x32x16_bf16(PK(l3, h3), w3, od, 0, 0, 0);
#undef PK
}
__device__ __forceinline__ float bf_lo(unsigned w) { return __uint_as_float(w << 16); }
__device__ __forceinline__ float bf_hi(unsigned w) { return __uint_as_float(w & 0xffff0000u); }
constexpr int SGU_S_OFF = 2 * (int)SHM_V, SGU_S_LD = 132;
struct SguRegs { bf16x8 t00, t01, t10, t11; u32x4 uu[4], zz[4]; };
__device__ __forceinline__ void sgu_load(SguRegs& R, const bf16* __restrict__ Pb, int item, int sr, int sc, int lat) {
  const int ci = item >> 3, g = item & 7; const int chunk = lat ? (ci >> 5) * 34 + 2 + (ci & 31) : ci;     const long R0 = (long)chunk * 128;
  const bf16* vsrc = Pb + R0 * LDQ + 1024 + g * 128 + sc;
  R.t00 = *reinterpret_cast<const bf16x8*>(vsrc + (long)(sr) * LDQ); R.t01 = *reinterpret_cast<const bf16x8*>(vsrc + (long)(32 + sr) * LDQ);
  R.t10 = *reinterpret_cast<const bf16x8*>(vsrc + (long)(64 + sr) * LDQ); R.t11 = *reinterpret_cast<const bf16x8*>(vsrc + (long)(96 + sr) * LDQ);
  const bf16* urow = Pb + (R0 + sr) * LDQ + g * 128 + sc;
#pragma unroll
  for (int k = 0; k < 4; ++k) { R.uu[k] = *reinterpret_cast<const u32x4*>(urow + (long)(32 * k) * LDQ); R.zz[k] = *reinterpret_cast<const u32x4*>(urow + (long)(32 * k) * LDQ + 2048); }
}
__device__ __forceinline__ void sgu_phase(const bf16* __restrict__ Pb, bf16* __restrict__ YC, const bf16* __restrict__ Wf  ,
                                          const float* __restrict__ bsgu  , int first, int stride, int nitems, char* lds, int lat) {
  int tid_ = threadIdx.x; asm volatile("" : "+v"(tid_));
  const int tid = tid_, wid = tid >> 6, lane = tid & 63, r32 = lane & 31, hi = lane >> 5;
  bf16* V_lds = (bf16*)lds; float* S_lds = (float*)(lds + SGU_S_OFF);
  const int sr = tid >> 4, sc = (tid & 15) * 8, vst0 = v_st(sr, sc), vst1 = v_st(32 + sr, sc);
  const int pb = wid & 3, P0 = 32 * pb, DB = 2 * (wid >> 2);
  const int vb = (int)(uintptr_t)V_lds + v_rd_base(lane) + DB * 512;
  if (first >= nitems) return;
  SguRegs C, N;
  sgu_load(C, Pb, first, sr, sc, lat);
  for (int item = first; item < nitems; item += stride) {
    const int ci = item >> 3, g = item & 7; const int chunk = lat ? (ci >> 5) * 34 + 2 + (ci & 31) : ci; const long R0 = (long)chunk * 128;
    *(bf16x8*)((char*)V_lds + vst0) = C.t00; *(bf16x8*)((char*)V_lds + vst1) = C.t01;
    *(bf16x8*)((char*)V_lds + SHM_V + vst0) = C.t10; *(bf16x8*)((char*)V_lds + SHM_V + vst1) = C.t11;
    const bf16x8* wfp = reinterpret_cast<const bf16x8*>(Wf) + ((long)(g * 4 + pb) * 8) * 64 + lane;
    bf16x8 wf[2][4];
#pragma unroll
    for (int T = 0; T < 2; ++T)
#pragma unroll
      for (int s = 0; s < 4; ++s) wf[T][s] = wfp[(T * 4 + s) * 64];
    const bool has_next = item + stride < nitems;
    if (has_next) sgu_load(N, Pb, item + stride, sr, sc, lat);
    __syncthreads();
    f32x16 o0 = {}, o1 = {};
    sgu_one<0>(o0, vb, wf[0][0], wf[0][1], wf[0][2], wf[0][3]); sgu_one<1>(o1, vb, wf[0][0], wf[0][1], wf[0][2], wf[0][3]);
    sgu_one<0>(o0, vb + (int)SHM_V, wf[1][0], wf[1][1], wf[1][2], wf[1][3]); sgu_one<1>(o1, vb + (int)SHM_V, wf[1][0], wf[1][1], wf[1][2], wf[1][3]);
#pragma unroll
    for (int dd = 0; dd < 2; ++dd)
#pragma unroll
      for (int g4 = 0; g4 < 4; ++g4) { const int d = 32 * (DB + dd) + 8 * g4 + 4 * hi; const f32x16& o = dd ? o1 : o0;
        *reinterpret_cast<f32x4v*>(S_lds + (P0 + r32) * SGU_S_LD + d) = (f32x4v){o[4 * g4 + 0], o[4 * g4 + 1], o[4 * g4 + 2], o[4 * g4 + 3]}; }
    __syncthreads();
#pragma unroll
    for (int k = 0; k < 4; ++k) { const int row = sr + 32 * k; const float bias = bsgu[g * 128 + row];
      const f32x4v s0 = *reinterpret_cast<const f32x4v*>(S_lds + row * SGU_S_LD + sc), s1 = *reinterpret_cast<const f32x4v*>(S_lds + row * SGU_S_LD + sc + 4);
      const u32x4 u = C.uu[k], z = C.zz[k]; u32x4 w;
      w.x = cvtpk(bf_lo(u.x) * (s0[0] + bias) * bf_lo(z.x), bf_hi(u.x) * (s0[1] + bias) * bf_hi(z.x));
      w.y = cvtpk(bf_lo(u.y) * (s0[2] + bias) * bf_lo(z.y), bf_hi(u.y) * (s0[3] + bias) * bf_hi(z.y));
      w.z = cvtpk(bf_lo(u.z) * (s1[0] + bias) * bf_lo(z.z), bf_hi(u.z) * (s1[1] + bias) * bf_hi(z.z));
      w.w = cvtpk(bf_lo(u.w) * (s1[2] + bias) * bf_lo(z.w), bf_hi(u.w) * (s1[3] + bias) * bf_hi(z.w));
      *reinterpret_cast<u32x4*>(YC + (R0 + row) * LDO + g * 128 + sc) = w; }
    if (has_next) C = N;
    __syncthreads();
  }
}
}
typedef float f32x4 __attribute__((ext_vector_type(4)));
typedef unsigned v4u __attribute__((ext_vector_type(4)));
typedef unsigned short bf16_t;
#define LDS_WAIT() asm volatile("s_waitcnt lgkmcnt(0)" ::: "memory")
__device__ __forceinline__ unsigned f2bf(float f) { unsigned u = __builtin_bit_cast(unsigned, f); return (u + 0x7fffu + ((u >> 16) & 1u)) >> 16; }
__device__ __forceinline__ unsigned pk2(float lo, float hi) { return f2bf(lo) | (f2bf(hi) << 16); }
__device__ __forceinline__ float wave_sum(float v) {
#pragma unroll
    for (int o = 1; o < 64; o <<= 1) v += __shfl_xor(v, o);
    return v;
}
__device__ __forceinline__ int physrow_in(int c) {
    if (c < C_Q || c >= C_VA) return c;
    const int d = c & 127; const int p = (d & 0x40) | ((d & 0x10) << 1) | ((d & 0xC) << 1) | ((d & 0x20) >> 3) | (d & 3);
    return (c & ~127) | p;
}
__device__ __forceinline__ void p0_transpose_item(const float* W, int K, int N, bf16_t* WT, bool perm, LAS float* scr, int item, int lane) {
    const int nblk = N / 32, kb = item / nblk, nb = item % nblk, k0 = 64 * kb, n0 = 32 * nb;
#pragma unroll 8
    for (int i = 0; i < 32; ++i) { const int kk = 2 * i + (lane >> 5); scr[kk * 33 + (lane & 31)] = W[(size_t)(k0 + kk) * N + n0 + (lane & 31)]; }
    LDS_WAIT(); asm volatile("" ::: "memory");
    const int c = lane & 7;
#pragma unroll
    for (int j = 0; j < 4; ++j) { const int n = (lane >> 3) + 8 * j; const LAS float* s = scr + (8 * c) * 33 + n;
        v4u o; o.x = pk2(s[0 * 33], s[1 * 33]); o.y = pk2(s[2 * 33], s[3 * 33]); o.z = pk2(s[4 * 33], s[5 * 33]); o.w = pk2(s[6 * 33], s[7 * 33]);
        const int rown = perm ? physrow_in(n0 + n) : (n0 + n);
        *(v4u*)(WT + (size_t)rown * K + k0 + 8 * c) = o; }
    LDS_WAIT(); asm volatile("" ::: "memory");
}
__device__ __forceinline__ void p0_prologue(const Args& a, LAS unsigned char* lds, int tid, int lane, int wave, int vcu, int G) {
    float* mod = (float*)(a.ws + WS_MOD);
    {
        LAS float* sl = (LAS float*)lds; LAS float* red = (LAS float*)(lds + 40960);
        for (int i = tid; i < 5 * 2048; i += 512) { const float v = (i < 4 * 2048) ? a.in[1][i] : a.in[3][i - 4 * 2048]; sl[i] = v / (1.f + __expf(-v)); }
        __syncthreads();
        const int cgp = tid % 12, kl = tid / 12;
        for (int item = vcu; item < 256; item += G) {
            const int l = item >> 7, j0 = (item & 127) * 48;
            if (kl < 42) {
                f32x4 acc[5];
#pragma unroll
                for (int r = 0; r < 5; ++r) acc[r] = (f32x4){0.f, 0.f, 0.f, 0.f};
                const float* wp = a.in[5] + (size_t)l * 2048 * 6144 + j0 + cgp * 4;
#pragma unroll 12
                for (int k = kl; k < 2048; k += 42) { const f32x4 w = *(const f32x4*)(wp + (size_t)k * 6144);
#pragma unroll
                    for (int r = 0; r < 5; ++r) acc[r] += sl[r * 2048 + k] * w; }
#pragma unroll
                for (int r = 0; r < 5; ++r) *(LAS f32x4*)(red + (kl * 5 + r) * 48 + cgp * 4) = acc[r];
            }
            __syncthreads();
            if (tid < 240) { const int r = tid / 48, c = tid % 48; float s = 0.f;
                for (int q = 0; q < 42; ++q) s += red[(q * 5 + r) * 48 + c];
                mod[(l * 5 + r) * 6144 + j0 + c] = s + a.in[6][l * 6144 + j0 + c]; }
            __syncthreads();
        }
    }
    if (vcu == G - 1) {
        float* rc = (float*)(a.ws + WS_ROPE); float* rs = rc + 2048;
        for (int idx = tid; idx < 2048; idx += 512) { const int pos = idx >> 5, i = idx & 31;
            const float inv = exp2f(-(float)(2 * i) * (1.f / 64.f) * 13.287712379549449f);
            const float ang = (float)pos * inv; rc[idx] = cosf(ang); rs[idx] = sinf(ang); }
    }
    {
        v4u* Wf = (v4u*)(a.ws + WS_WSGU);
        for (int idx = vcu * 512 + tid; idx < 2 * 8 * 4 * 8 * 64; idx += G * 512) { const int ln = idx & 63, ts = (idx >> 6) & 7, pbb = (idx >> 9) & 3, lg = idx >> 11;
            const float* q = a.in[8] + ((size_t)lg * 128 + 32 * pbb + (ln & 31)) * 128 + 16 * ts + 8 * (ln >> 5);
            const f32x4 lo = *(const f32x4*)q, hh = *(const f32x4*)(q + 4);
            v4u o; o.x = pk2(lo[0], lo[1]); o.y = pk2(lo[2], lo[3]); o.z = pk2(hh[0], hh[1]); o.w = pk2(hh[2], hh[3]); Wf[idx] = o; }
    }
    {
        LAS float* scr = (LAS float*)(lds + wave * 16384);
        const int gw = vcu * 8 + wave, NGW = G * 8;
        bf16_t* WinT = (bf16_t*)(a.ws + WS_WIN); bf16_t* WoutT = (bf16_t*)(a.ws + WS_WOUT);
        constexpr int I_IN = 32 * (DIN / 32), I_OUT = 32 * (DM / 32), I_L = I_IN + I_OUT;
        for (int it = gw; it < 2 * I_L; it += NGW) { const int l = it / I_L; const int r = it - l * I_L;
            if (r < I_IN) p0_transpose_item(a.in[7] + (size_t)l * DM * DIN, DM, DIN, WinT + (size_t)l * DIN * DM, true, scr, r, lane);
            else p0_transpose_item(a.in[13] + (size_t)l * DM * DM, DM, DM, WoutT + (size_t)l * DM * DM, false, scr, r - I_IN, lane); }
    }
}
__device__ __forceinline__ void pA_norm(const Args& a, int l, int gw, int NGW, int lane_) {
    int lane = lane_; asm volatile("" : "+v"(lane));
    const float* mod = (const float*)(a.ws + WS_MOD) + (size_t)l * 5 * 6144;
    const float* nw = a.in[4] + l * DM;
    const float* xc1 = (const float*)(a.ws + WS_XC1);
    bf16_t* H = (bf16_t*)(a.ws + WS_H);
    const int rpw = (MROWS + NGW - 1) / NGW;
    const int R0 = gw * rpw, R1 = (R0 + rpw < MROWS) ? R0 + rpw : MROWS;
    int cur = -1; f32x4 g[8], sh[8];
    for (int R = R0; R < R1; ++R) {
        const int b = R / RPB, rb = R - b * RPB; const bool isctx = rb < CTX; const int rm = isctx ? 4 : b;
        const float* src = (l == 0) ? (isctx ? a.in[2] + (size_t)(b * CTX + rb) * DM : a.in[0] + (size_t)(b * SEQ + rb - CTX) * DM)
                                    : (isctx ? xc1 + (size_t)(b * CTX + rb) * DM : a.out + (size_t)(b * SEQ + rb - CTX) * DM);
        if (rm != cur) { cur = rm;
#pragma unroll
            for (int j = 0; j < 8; ++j) { const int c = 4 * lane + 256 * j; const f32x4 w = *(const f32x4*)(nw + c), sc = *(const f32x4*)(mod + rm * 6144 + 2048 + c);
                g[j] = w * (1.f + sc); sh[j] = *(const f32x4*)(mod + rm * 6144 + c); } }
        f32x4 v[8]; float s = 0.f;
#pragma unroll
        for (int j = 0; j < 8; ++j) { v[j] = *(const f32x4*)(src + 4 * lane + 256 * j); s += (v[j][0] * v[j][0] + v[j][1] * v[j][1]) + (v[j][2] * v[j][2] + v[j][3] * v[j][3]); }
        const float rstd = 1.f / sqrtf(wave_sum(s) * (1.f / DM) + EPS);
        unsigned long long* o8 = (unsigned long long*)(H + (size_t)R * DM) + lane;
#pragma unroll
        for (int j = 0; j < 8; ++j) { const f32x4 y = v[j] * rstd * g[j] + sh[j]; o8[64 * j] = (unsigned long long)pk2(y[0], y[1]) | ((unsigned long long)pk2(y[2], y[3]) << 32); }
    }
}

#define RLX_AGENT __ATOMIC_RELAXED, __HIP_MEMORY_SCOPE_AGENT
#define XB_TMO      128
#define XB_XCNT(j)  (256  + 64 * (j))
#define XB_XSUB(j)  (1280 + 64 * (j))
#define XB_XGEN(j)  (2304 + 64 * (j))
#define XB_TOP      3328
#define XB_TOPGEN   3392
#define XCD_BAR_WORDS 3456
#define XB_SPIN_CAP (1u << 18)

__device__ __forceinline__ unsigned xb_ld(unsigned* p)              { return __hip_atomic_load(p, __ATOMIC_RELAXED, __HIP_MEMORY_SCOPE_AGENT); }
__device__ __forceinline__ unsigned xb_add(unsigned* p, unsigned v) { return __hip_atomic_fetch_add(p, v, __ATOMIC_RELAXED, __HIP_MEMORY_SCOPE_AGENT); }
__device__ __forceinline__ unsigned xb_xcc_id() { return (unsigned)__builtin_amdgcn_s_getreg((3 << 11) | 20) & 0xFu; }
#define XB_SPIN(cond, bar) do { unsigned _sp = 0; while (cond) { __builtin_amdgcn_s_sleep(1); \
    if ((++_sp & 255u) == 0u) { if (xb_ld(&(bar)[XB_TMO])) break; if (_sp > XB_SPIN_CAP) { atomicAdd(&(bar)[XB_TMO], 1u); break; } } } } while (0)

struct XcdBarrier {
    unsigned* bar; unsigned x;
    volatile LAS unsigned* st;
};

__device__ __forceinline__ XcdBarrier xcd_barrier_post(unsigned* bar, volatile LAS unsigned* st) {
    XcdBarrier b; b.bar = bar; b.x = xb_xcc_id(); b.st = st;
    if (threadIdx.x == 0) (void)xb_add(&bar[XB_XCNT(b.x)], 1u);
    return b;
}
__device__ __forceinline__ void xcd_barrier_complete(unsigned* bar, unsigned x, unsigned& nloc, unsigned& nx) {
    const unsigned G = gridDim.x * gridDim.y * gridDim.z;
    unsigned sum, cnt, mine, sp = 0u;
    for (;;) {
        sum = 0u; cnt = 0u; mine = 0u;
#pragma unroll
        for (unsigned j = 0; j < 16; ++j) { const unsigned c = xb_ld(&bar[XB_XCNT(j)]); sum += c; cnt += (c > 0u) ? 1u : 0u; mine = (j == x) ? c : mine; }
        if (sum == G) break;
        __builtin_amdgcn_s_sleep(1);
        if ((++sp & 255u) == 0u) { if (xb_ld(&bar[XB_TMO])) break; if (sp > XB_SPIN_CAP) { atomicAdd(&bar[XB_TMO], 1u); break; } }
    }
    nloc = mine > 0u ? mine : 1u; nx = cnt > 0u ? cnt : 1u;
}

__device__ __forceinline__ void xcd_barrier(const XcdBarrier& b) {
    asm volatile("s_waitcnt vmcnt(0)" ::: "memory");
    __syncthreads();
    if (threadIdx.x == 0) {
        unsigned* bar = b.bar;
        __builtin_amdgcn_s_waitcnt(0);
        unsigned nloc = b.st[0], nx = b.st[1];
        if (nloc == 0u) { xcd_barrier_complete(bar, b.x, nloc, nx); b.st[0] = nloc; b.st[1] = nx; }
        const unsigned old = xb_add(&bar[XB_XSUB(b.x)], 1u);
        const unsigned gen = old / nloc;
        if (old + 1u == (gen + 1u) * nloc) {
            __builtin_amdgcn_fence(__ATOMIC_RELEASE, "agent");
            asm volatile("s_waitcnt vmcnt(0)" ::: "memory");
            const unsigned og = xb_add(&bar[XB_TOP], 1u);
            const unsigned tg = og / nx;
            if (og + 1u == (tg + 1u) * nx) xb_add(&bar[XB_TOPGEN], 1u);
            else XB_SPIN(xb_ld(&bar[XB_TOPGEN]) == tg, bar);
            __builtin_amdgcn_fence(__ATOMIC_ACQUIRE, "agent");
            xb_add(&bar[XB_XGEN(b.x)], 1u);
            asm volatile("s_waitcnt vmcnt(0)" ::: "memory");
        } else {
            XB_SPIN(xb_ld(&bar[XB_XGEN(b.x)]) == gen, bar);
            __builtin_amdgcn_fence(__ATOMIC_ACQUIRE, "agent");
            asm volatile("s_waitcnt vmcnt(0)" ::: "memory");
        }
    }
    __syncthreads();
}

__global__ void __launch_bounds__(512, 2) mk_fwd(Args a) {
    extern __shared__ __attribute__((aligned(16))) unsigned char lds[];
    cg::grid_group grid = cg::this_grid();
    LAS unsigned char* L = (LAS unsigned char*)lds;
    const int tid = threadIdx.x, lane = tid & 63, wave = __builtin_amdgcn_readfirstlane(tid >> 6);
    const int G = gridDim.x, bx = blockIdx.x; const int vcu = (G % 8 == 0) ? (bx % 8) * (G / 8) + bx / 8 : bx;
    const int lo = a.ph_lo, hi = a.ph_hi;
#define IN(k) (lo <= (k) && (k) < hi)
#define SEAM(k) do { if (IN(k) && IN((k) + 1)) { if (a.coop == 2) grid.sync(); else xcd_barrier(xbar); } } while (0)
    volatile LAS unsigned* xst = (volatile LAS unsigned*)(L + XCH_OFF + 8192);
    if (tid < 2) xst[tid] = 0u;
    __syncthreads();
    XcdBarrier xbar; xbar.bar = (unsigned*)(a.ws + WS_BAR); xbar.x = 0; xbar.st = xst;
    if (a.coop) xbar = xcd_barrier_post((unsigned*)(a.ws + WS_BAR), xst);

    bf16_t* Hb = (bf16_t*)(a.ws + WS_H); bf16_t* Pb = (bf16_t*)(a.ws + WS_P);
    if (IN(0)) { p0_prologue(a, L, tid, lane, wave, vcu, G); }
    SEAM(0);
#pragma nounroll
    for (int l = 0; l < 2; ++l) {
        const int pb = 1 + 4 * l;
        if (IN(pb)) { pA_norm(a, l, vcu * 8 + wave, G * 8, lane); }
        SEAM(pb);
        if (IN(pb + 1)) {
            pg8::Gemm g{Hb, (const bf16_t*)(a.ws + WS_WIN) + (size_t)l * DIN * DM, MROWS, DIN, DM};
            pg8::SchedX S; if (l == 0) S.init(68, 22, G, bx, 0, 0); else S.init(64, 22, G, bx, 1, 8);
            pg8::EpiIn E{Pb, a.in[10] + l * 1024, a.in[11] + l * 128, a.in[12] + l * 128, (const float*)(a.ws + WS_ROPE), (const float*)(a.ws + WS_ROPE) + 2048, (LAS float*)(L + XCH_OFF), (bf16_t*)(a.ws + WS_KC), (bf16_t*)(a.ws + WS_VC)};
            pg8::gemm_phase<pg8::EpiIn, pg8::SchedX, true, true>(L, g, S, E);
        }
        SEAM(pb + 1);
        if (IN(pb + 2)) {
            const at::bf16* P = (const at::bf16*)Pb; at::bf16* YC = (at::bf16*)Hb;
#pragma nounroll
            for (int st = 0; st < 2; ++st) {
            const bool do_sgu = (((st ^ vcu) & 1) == 0);
            if (do_sgu) { if (a.sub & 1)
            at::sgu_phase(P, YC, (const at::bf16*)(a.ws + WS_WSGU) + (size_t)l * 8 * 128 * 128, a.in[9] + l * 8 * 128, vcu, G, l == 0 ? 136 * 8 : 128 * 8, (char*)lds, l); }
            else {
            const int ntot = (a.sub & 2) ? 512 + (l == 0 ? 32 : 0) : 0;
            for (int i = 0;; ++i) { int Li = i * G + vcu; if (Li >= 512) Li -= 64;
                if (Li >= ntot || (i >= 2 && Li < 512)) break;
                int b, h, qrow, seq;
                if (Li < 512) { const int qb = Li & 15; h = (Li >> 4) & 7; b = Li >> 7; qrow = b * RPB + CTX + qb * 256; seq = RPB; }
                else { const int c = Li - 512; b = c >> 3; h = c & 7; qrow = b * RPB; seq = CTX; }
                const long krow = (long)b * RPB; const int kvh = h >> 2;
                const long kvo = ((long)(b * 2 + kvh) * RPB) * 128;
                at::attn_dense_body(P + (long)qrow * DIN + C_Q + h * 128, (const at::bf16*)(a.ws + WS_KC) + kvo, (const at::bf16*)(a.ws + WS_VC) + kvo,
                                    P + (long)qrow * DIN + C_ZB + h * 128, YC + (long)qrow * DM + 1024 + h * 128, seq, (char*)lds);
                __syncthreads(); } }
            __syncthreads(); }
        }
        SEAM(pb + 2);
        if (IN(pb + 3)) {
            pg8::Gemm g{Hb, (const bf16_t*)(a.ws + WS_WOUT) + (size_t)l * DM * DM, MROWS, DM, DM};
            pg8::SchedX S; if (l == 0) S.init(68, 8, G, bx, 0, 0); else S.init(64, 8, G, bx, 1, 0);
            pg8::EpiOut E{l == 0 ? a.in[0] : a.out, a.in[2], a.out, (float*)(a.ws + WS_XC1), (const float*)(a.ws + WS_MOD) + (size_t)l * 5 * 6144 + 4096};
            pg8::gemm_phase<pg8::EpiOut, pg8::SchedX, false, true>(L, g, S, E);
        }
        SEAM(pb + 3);
    }
#undef IN
#undef SEAM
}

extern "C" void kernel_launch(void* const* d_in, const int* in_sizes, int n_in, void* d_out, int out_size, void* d_ws, size_t ws_size, hipStream_t stream) {
    static int grid = 0;
    if (grid == 0) {
        if (n_in != 14 || in_sizes[0] != NB * SEQ * DM || out_size != NB * SEQ * DM || ws_size < WS_END) {
            fprintf(stderr, "kernel_launch: shape mismatch (n_in %d, in0 %d, out %d, ws %zu; need ws >= %zu); nothing launched\n", n_in, n_in > 0 ? in_sizes[0] : -1, out_size, ws_size, (size_t)WS_END); grid = -1; return; }
        int dev = 0, cus = 0, per_cu = 0;
        if (hipGetDevice(&dev) != hipSuccess || hipDeviceGetAttribute(&cus, hipDeviceAttributeMultiprocessorCount, dev) != hipSuccess) { fprintf(stderr, "kernel_launch: device query failed\n"); grid = -1; return; }
        if (hipFuncSetAttribute((const void*)mk_fwd, hipFuncAttributeMaxDynamicSharedMemorySize, LDS_BYTES) != hipSuccess) { fprintf(stderr, "kernel_launch: hipFuncSetAttribute failed\n"); grid = -1; return; }
        if (hipOccupancyMaxActiveBlocksPerMultiprocessor(&per_cu, (const void*)mk_fwd, 512, LDS_BYTES) != hipSuccess || per_cu < 1) { fprintf(stderr, "kernel_launch: occupancy query says %d blocks per CU\n", per_cu); per_cu = 1; }
        (void)hipGetLastError();
        grid = cus * 1;
    }
    if (grid < 0) return;
    Args a{};
    for (int i = 0; i < 14; ++i) a.in[i] = (const float*)d_in[i];
    a.out = (float*)d_out; a.ws = (unsigned char*)d_ws; a.sub = 3;
#if MK_MULTI
    for (int ph = 0; ph < NPHASE; ++ph) { a.ph_lo = ph; a.ph_hi = ph + 1; a.coop = 0;
        hipLaunchKernelGGL(mk_fwd, dim3(grid), dim3(512), LDS_BYTES, stream, a);
        const hipError_t le = hipPeekAtLastError(); if (le != hipSuccess) { fprintf(stderr, "kernel_launch: launch %d failed: %s\n", ph, hipGetErrorName(le)); break; }
#ifdef PROBE_PH
        if ((PROBE_PH >> ph) & 1) { a.sub = PROBE_SUB; hipLaunchKernelGGL(mk_fwd, dim3(grid), dim3(512), LDS_BYTES, stream, a); a.sub = 3; }
#endif
    }
#else
    a.ph_lo = 0; a.ph_hi = NPHASE; a.coop = 1;
    if (hipMemsetAsync((char*)d_ws + WS_BAR, 0, 16384, stream) != hipSuccess) { fprintf(stderr, "kernel_launch: hipMemsetAsync of the barrier words failed\n"); return; }
    void* args[] = {&a};
    const hipError_t e = hipLaunchCooperativeKernel((const void*)mk_fwd, dim3(grid), dim3(512), args, LDS_BYTES, stream);
    if (e != hipSuccess) fprintf(stderr, "kernel_launch: cooperative launch failed: %s (grid %d)\n", hipGetErrorString(e), grid);
#endif
}
```

```cpp
#include <hip/hip_runtime.h>
#include <hip/hip_cooperative_groups.h>
#include <hip/hip_bf16.h>
#include <cstdio>
#include <cstdint>
namespace cg = cooperative_groups;

#ifndef MK_MULTI
#define MK_MULTI 0
#endif

constexpr int DM = 2048, NB = 4, SEQ = 4096, CTX = 256, RPB = CTX + SEQ, MROWS = NB * RPB, DIN = 5632;
constexpr int C_U = 0, C_V = 1024, C_ZA = 2048, C_Q = 3072, C_K = 4096, C_VA = 4352, C_ZB = 4608;
constexpr int TPB = RPB / 256;
constexpr float EPS = 1e-6f;
constexpr int NPHASE = 9;
constexpr size_t MiB = 1u << 20;
constexpr size_t WS_MOD = 0;
constexpr size_t WS_ROPE = 1 * MiB;
constexpr size_t WS_WSGU = 2 * MiB;
constexpr size_t WS_BAR = 3 * MiB;
constexpr size_t WS_XC1 = 4 * MiB;
constexpr size_t WS_WIN = 16 * MiB;
constexpr size_t WS_WOUT = 64 * MiB;
constexpr size_t WS_H = 80 * MiB;
constexpr size_t WS_P = 160 * MiB;
constexpr size_t WS_KC = 352 * MiB;
constexpr size_t WS_VC = 368 * MiB;
constexpr size_t WS_END = 384 * MiB;
constexpr int LDS_BYTES = 163840;
constexpr int XCH_OFF = 131072;

struct Args { const float* in[14]; float* out; unsigned char* ws; int ph_lo, ph_hi, coop, sub; };
#define LAS __attribute__((address_space(3)))
namespace pg8 {
#define PG8_LAS __attribute__((address_space(3)))
typedef unsigned short bf16_t;
typedef short bf16x8 __attribute__((ext_vector_type(8)));
typedef float f32x4 __attribute__((ext_vector_type(4)));
typedef unsigned u32x4 __attribute__((ext_vector_type(4)));
constexpr int BM = 256, BK = 64, HALF = 128, HTB = HALF * BK * 2  , STAGE_BYTES = 8 * HTB, NXCD = 8, WGM = 8;

__host__ __device__ __forceinline__ int lds_byte(int r, int c) { const int st = (r >> 4) * 2 + (c >> 5), rr = r & 15, cc = c & 31, ob = rr * 64 + cc * 2; return st * 1024 + (ob ^ (((ob >> 9) & 1) << 5)); }
__host__ __device__ __forceinline__ void stage_rc(int b, int& R, int& C) { const int st = b / 1024, sb = b % 1024, swz = sb ^ (((sb >> 9) & 1) << 5); R = (st >> 1) * 16 + swz / 64; C = (st & 1) * 32 + (swz % 64) / 2; }
__host__ __device__ __forceinline__ int perm32(int rho) { const int n = rho >> 4, i = rho & 15; return 8 * (i >> 2) + 4 * n + (i & 3); }

struct Unit { int pm, pn; };
struct Gemm { const bf16_t* A; const bf16_t* Bt; int M, N, K; };

struct StaticOrder {
    int nM, nN, nwg, G, c;
    __host__ __device__ void init(int M, int N, int G_, int c_) { nM = M / BM; nN = N / BM; nwg = nM * nN; G = G_; c = c_; }
    __host__ __device__ bool next(int i, Unit& u) const {
        const long L = (long)i * G + c; if (L >= nwg) return false;
        int wgid = (int)L; { const int q = nwg / NXCD, r = nwg % NXCD, xcd = wgid % NXCD, off = wgid / NXCD; wgid = (xcd < r ? xcd * (q + 1) : r * (q + 1) + (xcd - r) * q) + off; }
        const int nig = WGM * nN, gid = wgid / nig, fm = gid * WGM, gsz = (nM - fm) < WGM ? (nM - fm) : WGM;
        u.pm = fm + ((wgid % nig) % gsz); u.pn = (wgid % nig) / gsz; return true;
    }
    __device__ __forceinline__ void a_ready(const Unit&) const {}
    __device__ __forceinline__ void done(const Unit&) const {}
};

__device__ __forceinline__ unsigned cvt_pk_bf16(float lo, float hi) { unsigned r; asm volatile("v_cvt_pk_bf16_f32 %0, %1, %2" : "=v"(r) : "v"(lo), "v"(hi)); return r; }
typedef float f32x2 __attribute__((ext_vector_type(2)));
__device__ __forceinline__ f32x4 gelu4(f32x4 x) {
    f32x4 o;
#pragma unroll
    for (int i = 0; i < 4; ++i) { const float v = x[i], t = v * (1.f + 0.044715f * v * v); const float e = __builtin_amdgcn_exp2f(-2.3022081981f * t); o[i] = v * __builtin_amdgcn_rcpf(1.f + e); }
    return o;
}
__device__ __forceinline__ f32x4 silu4(f32x4 x) {
    f32x4 o;
#pragma unroll
    for (int i = 0; i < 4; ++i) { const float v = x[i]; const float e = __builtin_amdgcn_exp2f(-1.4426950409f * v); o[i] = v * __builtin_amdgcn_rcpf(1.f + e); }
    return o;
}
__device__ __forceinline__ void store8(bf16_t* p, f32x4 v0, f32x4 v1) {
    u32x4 w; w.x = cvt_pk_bf16(v0[0], v0[1]); w.y = cvt_pk_bf16(v0[2], v0[3]); w.z = cvt_pk_bf16(v1[0], v1[1]); w.w = cvt_pk_bf16(v1[2], v1[3]); *(u32x4*)p = w;
}
struct EpiIn {
    static constexpr bool PERM = true, AFTER_DRAIN = false;
    bf16_t* P; const PG8_LAS float* vnw; const PG8_LAS float* qnw; const PG8_LAS float* knw; const PG8_LAS float* ropec; const PG8_LAS float* ropes; PG8_LAS float* xch; bf16_t* Kc; bf16_t* Vc;
    __device__ __forceinline__ void operator()(f32x4 (&acc)[2][2][4][2], const Unit& u, int wr, int wc, int fr, int fq) const {
        const int pn = u.pn;
        const int colw = wc * 32 + 8 * fq;
        bf16_t* base = P + (size_t)(u.pm * 256 + wr * 64 + fr) * 5632 + pn * 256 + colw;
        if (pn == 17) {
            const int b = u.pm / 17, rb = (u.pm % 17) * 256 + wr * 64 + fr;
            bf16_t* vb_ = Vc + ((size_t)(b * 2) * 4352 + rb) * 128 + colw;
#pragma unroll
            for (int ai = 0; ai < 2; ++ai)
#pragma unroll
                for (int m = 0; m < 4; ++m)
#pragma unroll
                    for (int bj = 0; bj < 2; ++bj) store8(vb_ + ((size_t)bj * 4352 + ai * 128 + m * 16) * 128, acc[ai][bj][m][0], acc[ai][bj][m][1]);
            return;
        }
        if (pn < 4 || (pn >= 8 && pn < 12) || pn >= 17) {
            const int act = pn < 4 ? 0 : (pn == 17 ? 2 : 1);
#pragma unroll
            for (int ai = 0; ai < 2; ++ai)
#pragma unroll
                for (int m = 0; m < 4; ++m) { bf16_t* rp = base + (size_t)(ai * 128 + m * 16) * 5632;
#pragma unroll
                    for (int bj = 0; bj < 2; ++bj) { f32x4 v0 = acc[ai][bj][m][0], v1 = acc[ai][bj][m][1];
                        if (act == 0) { v0 = gelu4(v0); v1 = gelu4(v1); } else if (act == 1) { v0 = silu4(v0); v1 = silu4(v1); }
                        store8(rp + bj * 128, v0, v1); } }
            return;
        }
        if (pn < 8) gn_path<true>(acc, u, wr, wc, fr, fq, base, colw); else gn_path<false>(acc, u, wr, wc, fr, fq, base, colw);
    }
    template <bool ISV>
    __device__ __forceinline__ void gn_path(const f32x4 (&acc)[2][2][4][2], const Unit& u, int wr, int wc, int fr, int fq, bf16_t* base, int colw) const {
        const int pn = u.pn;
#pragma unroll
        for (int ai = 0; ai < 2; ++ai)
#pragma unroll
            for (int m = 0; m < 4; ++m)
#pragma unroll
                for (int bj = 0; bj < 2; ++bj) { f32x4 a = acc[ai][bj][m][0], b = acc[ai][bj][m][1];
                    if (ISV) { a = gelu4(a); b = gelu4(b); }
                    float s = (a[0] * a[0] + a[1] * a[1]) + (a[2] * a[2] + a[3] * a[3]) + (b[0] * b[0] + b[1] * b[1]) + (b[2] * b[2] + b[3] * b[3]);
                    s += __shfl_xor(s, 16); s += __shfl_xor(s, 32);
                    if (fq == 0) xch[(ai * 128 + wr * 64 + m * 16 + fr) * 8 + bj * 4 + wc] = s;
                    if (ISV) __builtin_amdgcn_sched_barrier(0); }
        asm volatile("s_waitcnt lgkmcnt(0)" ::: "memory"); __builtin_amdgcn_s_barrier(); asm volatile("" ::: "memory");
        f32x4 w[2][2];
        if (ISV) {
#pragma unroll
            for (int bj = 0; bj < 2; ++bj)
#pragma unroll
                for (int n = 0; n < 2; ++n) w[bj][n] = *(const PG8_LAS f32x4*)(vnw + ((pn - 4) * 2 + bj) * 128 + colw + 4 * n);
        } else {
            const PG8_LAS float* nwp = pn < 16 ? qnw : knw; const int dlo = 64 * (wc >> 1) + 16 * (wc & 1) + 4 * fq;
            w[0][0] = *(const PG8_LAS f32x4*)(nwp + dlo); w[0][1] = *(const PG8_LAS f32x4*)(nwp + dlo + 32); w[1][0] = w[0][0]; w[1][1] = w[0][1];
        }
        const int jt = u.pm % 17;
        const bool rope = !ISV && jt != 0;
#pragma unroll
        for (int ai = 0; ai < 2; ++ai)
#pragma unroll
            for (int m = 0; m < 4; ++m) { const int rl = ai * 128 + wr * 64 + m * 16 + fr; bf16_t* rp = base + (size_t)(ai * 128 + m * 16) * 5632; size_t bjs = 128;
                if (!ISV) { if (pn == 16) { rp = Kc + ((size_t)((u.pm / 17) * 2) * 4352 + jt * 256 + rl) * 128 + colw; bjs = (size_t)4352 * 128; } }
                f32x4 cs = {1.f, 1.f, 1.f, 1.f}, sn = {0.f, 0.f, 0.f, 0.f};
                if (!ISV) { if (rope) { const int t = jt * 256 + rl - 256; const int pos = (wc >> 1) ? (t & 63) : (t >> 6); const int fi = pos * 32 + 16 * (wc & 1) + 4 * fq;
                    cs = *(const PG8_LAS f32x4*)(ropec + fi); sn = *(const PG8_LAS f32x4*)(ropes + fi); } }
#pragma unroll
                for (int bj = 0; bj < 2; ++bj) { const f32x4 pr = *(const PG8_LAS f32x4*)(xch + rl * 8 + bj * 4);
                    const float rstd = __builtin_amdgcn_rsqf(((pr[0] + pr[1]) + (pr[2] + pr[3])) * (1.f / 128.f) + 1e-6f);
                    f32x4 a0 = acc[ai][bj][m][0], a1 = acc[ai][bj][m][1];
                    if (ISV) { asm volatile("" : "+v"(a0), "+v"(a1));
                        a0 = gelu4(a0); a1 = gelu4(a1); }
                    a0 = a0 * rstd * w[bj][0]; a1 = a1 * rstd * w[bj][1];
                    if (!ISV) { const f32x4 o0 = a0 * cs - a1 * sn, o1 = a1 * cs + a0 * sn; a0 = o0; a1 = o1; }
                    store8(rp + bj * bjs, a0, a1); }
                asm volatile("" ::: "memory"); }
    }
};
struct EpiOut {
    static constexpr bool PERM = false, AFTER_DRAIN = false;
    const float* xsrc; const float* csrc; float* xdst; float* cdst; const float* gate;
    __device__ __forceinline__ void operator()(f32x4 (&acc)[2][2][4][2], const Unit& u, int wr, int wc, int fr, int fq) const {
        const int b = u.pm / 17, jt = u.pm % 17;
        const float* src; float* dst; int grow;
        if (jt == 0) { const size_t off = (size_t)(b * 256) * 2048; src = csrc + off; dst = cdst + off; grow = 4; }
        else { const size_t off = (size_t)(b * 4096 + (jt - 1) * 256) * 2048; src = xsrc + off; dst = xdst + off; grow = b; }
        const int col0 = u.pn * 256 + wc * 32 + 4 * fq;
        f32x4 gv[2][2];
#pragma unroll
        for (int bj = 0; bj < 2; ++bj)
#pragma unroll
            for (int n = 0; n < 2; ++n) gv[bj][n] = *(const f32x4*)(gate + grow * 6144 + col0 + bj * 128 + n * 16);
#pragma unroll
        for (int ai = 0; ai < 2; ++ai)
#pragma unroll
            for (int m = 0; m < 4; ++m) { const size_t ro = (size_t)(wr * 64 + fr + ai * 128 + m * 16) * 2048 + col0;
                f32x4 xs[2][2];
#pragma unroll
                for (int bj = 0; bj < 2; ++bj)
#pragma unroll
                    for (int n = 0; n < 2; ++n) xs[bj][n] = *(const f32x4*)(src + ro + bj * 128 + n * 16);
#pragma unroll
                for (int bj = 0; bj < 2; ++bj)
#pragma unroll
                    for (int n = 0; n < 2; ++n) *(f32x4*)(dst + ro + bj * 128 + n * 16) = xs[bj][n] + gv[bj][n] * acc[ai][bj][m][n];
                if (m & 1) asm volatile("" ::: "memory"); }
    }
};
struct SchedX {
    int nM, nN, nwg, G, c, lat, extra;
    __device__ void init(int nM_, int nN_, int G_, int c_, int lat_, int extra_) { nM = nM_; nN = nN_; nwg = nM_ * nN_; G = G_; c = c_; lat = lat_; extra = extra_; }
    __device__ bool next(int i, Unit& u) const {
        long L = (long)i * G + c;
        if (L < nwg) {
            int wgid = (int)L; { const int q = nwg / NXCD, r = nwg % NXCD, xcd = wgid % NXCD, off = wgid / NXCD; wgid = (xcd < r ? xcd * (q + 1) : r * (q + 1) + (xcd - r) * q) + off; }
            const int nig = WGM * nN, gid = wgid / nig, fm = gid * WGM, gsz = (nM - fm) < WGM ? (nM - fm) : WGM;
            const int pmq = fm + ((wgid % nig) % gsz); u.pn = (wgid % nig) / gsz;
            u.pm = lat ? (pmq / 16) * 17 + 1 + (pmq % 16) : pmq; return true;
        }
        L -= nwg; if (L < extra) { u.pm = (int)(L >> 1) * 17; u.pn = 16 + (int)(L & 1); return true; }
        return false;
    }
    __device__ __forceinline__ void a_ready(const Unit&) const {}
    __device__ __forceinline__ void done(const Unit&) const {}
};
template <class Epi, class Sched, bool ALIGN_EPI = false, bool SP2 = false>
__device__ __forceinline__ void gemm_phase(PG8_LAS unsigned char* lds, const Gemm g, const Sched& S, const Epi& E) {
    int tid_ = threadIdx.x; asm volatile("" : "+v"(tid_));
    const int tid = tid_, wid = __builtin_amdgcn_readfirstlane(tid >> 6), lane = tid & 63, wr = wid >> 2, wc = wid & 3, fr = lane & 15, fq = lane >> 4;
    const int K = g.K, nt = K / BK;
    unsigned voffA[2], voffB[2];
#pragma unroll
    for (int i = 0; i < 2; ++i) { int R, C; stage_rc(tid * 16 + i * 8192, R, C); const int Rb = Epi::PERM ? ((R & ~31) + perm32(R & 31)) : R;
        voffA[i] = (unsigned)(R * K + C) * 2u; voffB[i] = (unsigned)(Rb * K + C) * 2u; }
    const size_t kstep = (size_t)(BK * 2);
    const size_t hstep = (size_t)HALF * K * 2;
    const size_t tstep = 2 * hstep;
    const unsigned ldsw = (unsigned)wid * 1024u;
    const int aoff = lds_byte(wr * 64 + fr, fq * 8), boff = lds_byte(wc * 32 + fr, fq * 8);
#define PG8_SA(b, h) (((b) * 2 + (h)) * HTB)
#define PG8_SB(b, h) ((4 + (b) * 2 + (h)) * HTB)
#define PG8_STAGE(bufoff, gbase, voff) do { _Pragma("unroll") for (int _i = 0; _i < 2; ++_i) \
        __builtin_amdgcn_global_load_lds((const unsigned*)((const char*)(gbase) + (voff)[_i]), (PG8_LAS unsigned*)(lds + (bufoff) + ldsw + _i * 8192), 16, 0, 0); } while (0)
#define PG8_LDA(dst, b, h) do { _Pragma("unroll") for (int m = 0; m < 4; ++m) _Pragma("unroll") for (int k = 0; k < 2; ++k) dst[m][k] = *(const PG8_LAS bf16x8*)(lds + PG8_SA(b, h) + aoff + m * 2048 + k * 1024); } while (0)
#define PG8_LDB(dst, b, h) do { _Pragma("unroll") for (int n = 0; n < 2; ++n) _Pragma("unroll") for (int k = 0; k < 2; ++k) dst[n][k] = *(const PG8_LAS bf16x8*)(lds + PG8_SB(b, h) + boff + n * 2048 + k * 1024); } while (0)
#define PG8_MMA(ai, bj, At, Bt) do { __builtin_amdgcn_s_setprio(1); _Pragma("unroll") for (int m = 0; m < 4; ++m) _Pragma("unroll") for (int n = 0; n < 2; ++n) _Pragma("unroll") for (int k = 0; k < 2; ++k) \
        acc[ai][bj][m][n] = __builtin_amdgcn_mfma_f32_16x16x32_bf16(Bt[n][k], At[m][k], acc[ai][bj][m][n], 0, 0, 0); __builtin_amdgcn_s_setprio(0); } while (0)
#define PG8_WAIT_V(n) asm volatile("s_waitcnt vmcnt(" #n ")" ::: "memory")
#define PG8_WAIT_L(n) asm volatile("s_waitcnt lgkmcnt(" #n ")" ::: "memory")
#define PG8_BAR __builtin_amdgcn_s_barrier()
#define PG8_SCHED __builtin_amdgcn_sched_barrier(0)
    Unit cur, nxt; int ui = 0;
    if (!S.next(0, cur)) return;
    f32x4 acc[2][2][4][2];
#pragma unroll
    for (int a = 0; a < 2; ++a)
#pragma unroll
        for (int b = 0; b < 2; ++b)
#pragma unroll
            for (int m = 0; m < 4; ++m)
#pragma unroll
                for (int n = 0; n < 2; ++n) acc[a][b][m][n] = (f32x4){0.f, 0.f, 0.f, 0.f};
    bf16x8 At[4][2], B0[2][2], B1[2][2];
    const char* cA = (const char*)g.A + (size_t)cur.pm * tstep; const char* cB = (const char*)g.Bt + (size_t)cur.pn * tstep;
    S.a_ready(cur);
    if constexpr (SP2) {
        PG8_STAGE(PG8_SB(0, 0), cB, voffB); PG8_STAGE(PG8_SB(0, 1), cB + hstep, voffB); PG8_STAGE(PG8_SA(0, 0), cA, voffA); PG8_STAGE(PG8_SA(0, 1), cA + hstep, voffA);
        if (wr == 1) PG8_BAR;
        PG8_WAIT_V(2); PG8_BAR;
        PG8_STAGE(PG8_SB(1, 0), cB + kstep, voffB); PG8_STAGE(PG8_SA(1, 0), cA + kstep, voffA); PG8_STAGE(PG8_SB(1, 1), cB + hstep + kstep, voffB);
        PG8_WAIT_V(6); PG8_BAR;
    } else {
        PG8_STAGE(PG8_SB(0, 0), cB, voffB); PG8_STAGE(PG8_SA(0, 0), cA, voffA); PG8_STAGE(PG8_SB(0, 1), cB + hstep, voffB); PG8_STAGE(PG8_SA(0, 1), cA + hstep, voffA);
        if (wr == 1) PG8_BAR;
        PG8_WAIT_V(4); PG8_BAR;
        PG8_STAGE(PG8_SB(1, 0), cB + kstep, voffB); PG8_STAGE(PG8_SA(1, 0), cA + kstep, voffA); PG8_STAGE(PG8_SB(1, 1), cB + hstep + kstep, voffB);
        PG8_WAIT_V(6); PG8_BAR;
    }
    for (;;) {
        const bool has_next = S.next(ui + 1, nxt);
        const char* nA = has_next ? (const char*)g.A + (size_t)nxt.pm * tstep : cA; const char* nB = has_next ? (const char*)g.Bt + (size_t)nxt.pn * tstep : cB;
        for (int t = 0; t < nt; t += 2) {
            const bool last = (t == nt - 2);
            const char* a1 = cA + (size_t)(t + 1) * kstep;
            const char* a2 = last ? nA : cA + (size_t)(t + 2) * kstep; const char* b2 = last ? nB : cB + (size_t)(t + 2) * kstep;
            const char* a3 = a2 + kstep; const char* b3 = b2 + kstep;
            if (last && has_next) S.a_ready(nxt);
            if constexpr (SP2) {
            PG8_LDB(B0, 0, 0); PG8_LDB(B1, 0, 1); PG8_SCHED; PG8_LDA(At, 0, 0); PG8_STAGE(PG8_SA(1, 1), a1 + hstep, voffA);
            PG8_WAIT_V(8); PG8_WAIT_L(0); PG8_BAR; PG8_MMA(0, 0, At, B0); PG8_MMA(0, 1, At, B1); PG8_BAR; PG8_SCHED;
            PG8_LDA(At, 0, 1); PG8_STAGE(PG8_SB(0, 0), b2, voffB); PG8_STAGE(PG8_SB(0, 1), b2 + hstep, voffB); PG8_STAGE(PG8_SA(0, 0), a2, voffA);
            PG8_WAIT_V(8); PG8_WAIT_L(0); PG8_BAR; PG8_MMA(1, 0, At, B0); PG8_MMA(1, 1, At, B1); PG8_BAR; PG8_SCHED;
            PG8_LDB(B0, 1, 0); PG8_LDB(B1, 1, 1); PG8_SCHED; PG8_LDA(At, 1, 0); PG8_STAGE(PG8_SA(0, 1), a2 + hstep, voffA);
            PG8_WAIT_V(8); PG8_WAIT_L(0); PG8_BAR; PG8_MMA(0, 0, At, B0); PG8_MMA(0, 1, At, B1); PG8_BAR; PG8_SCHED;
            PG8_LDA(At, 1, 1); PG8_STAGE(PG8_SB(1, 0), b3, voffB); PG8_STAGE(PG8_SB(1, 1), b3 + hstep, voffB); PG8_STAGE(PG8_SA(1, 0), a3, voffA);
            PG8_WAIT_V(8); PG8_WAIT_L(0); PG8_BAR; PG8_MMA(1, 0, At, B0); PG8_MMA(1, 1, At, B1); PG8_BAR; PG8_SCHED;
            } else {
            PG8_LDB(B0, 0, 0); PG8_SCHED; PG8_LDA(At, 0, 0); PG8_STAGE(PG8_SA(1, 1), a1 + hstep, voffA);
            PG8_WAIT_L(8); PG8_BAR; PG8_WAIT_L(0); PG8_MMA(0, 0, At, B0); PG8_BAR; PG8_SCHED;
            PG8_LDB(B1, 0, 1); PG8_STAGE(PG8_SB(0, 0), b2, voffB);
            PG8_BAR; PG8_WAIT_L(0); PG8_MMA(0, 1, At, B1); PG8_BAR;
            PG8_LDA(At, 0, 1); PG8_STAGE(PG8_SA(0, 0), a2, voffA);
            PG8_BAR; PG8_WAIT_L(0); PG8_MMA(1, 0, At, B0); PG8_BAR; PG8_SCHED;
            PG8_STAGE(PG8_SB(0, 1), b2 + hstep, voffB);
            PG8_WAIT_V(6); PG8_BAR; PG8_MMA(1, 1, At, B1); PG8_BAR;
            PG8_LDB(B0, 1, 0); PG8_SCHED; PG8_LDA(At, 1, 0); PG8_STAGE(PG8_SA(0, 1), a2 + hstep, voffA);
            PG8_WAIT_L(8); PG8_BAR; PG8_WAIT_L(0); PG8_MMA(0, 0, At, B0); PG8_BAR; PG8_SCHED;
            PG8_LDB(B1, 1, 1); PG8_STAGE(PG8_SB(1, 0), b3, voffB);
            PG8_BAR; PG8_WAIT_L(0); PG8_MMA(0, 1, At, B1); PG8_BAR;
            PG8_LDA(At, 1, 1); PG8_STAGE(PG8_SA(1, 0), a3, voffA);
            PG8_BAR; PG8_WAIT_L(0); PG8_MMA(1, 0, At, B0); PG8_BAR; PG8_SCHED;
            PG8_STAGE(PG8_SB(1, 1), b3 + hstep, voffB);
            PG8_WAIT_V(6); PG8_BAR; PG8_MMA(1, 1, At, B1); PG8_BAR;
            }
        }
        if constexpr (ALIGN_EPI) { if (wr == 0) PG8_BAR; }
        if constexpr (!Epi::AFTER_DRAIN) { int fr_e = fr, fq_e = fq; asm volatile("" : "+v"(fr_e), "+v"(fq_e));
            E(acc, cur, wr, wc, fr_e, fq_e); S.done(cur); }
        if (!has_next) break;
#pragma unroll
        for (int a = 0; a < 2; ++a)
#pragma unroll
            for (int b = 0; b < 2; ++b)
#pragma unroll
                for (int m = 0; m < 4; ++m)
#pragma unroll
                    for (int n = 0; n < 2; ++n) acc[a][b][m][n] = (f32x4){0.f, 0.f, 0.f, 0.f};
        cur = nxt; cA = nA; cB = nB; ++ui;
        if constexpr (ALIGN_EPI) { if (wr == 1) PG8_BAR; }
    }
    PG8_WAIT_V(0);
    if constexpr (!ALIGN_EPI) { if (wr == 0) PG8_BAR; }
    PG8_BAR;
    if constexpr (Epi::AFTER_DRAIN) { E.fused(acc, cur, wr, wc, fr, fq, lds, wid, lane); S.done(cur); }
#undef PG8_SA
#undef PG8_SB
#undef PG8_STAGE
#undef PG8_LDA
#undef PG8_LDB
#undef PG8_MMA
#undef PG8_WAIT_V
#undef PG8_WAIT_L
#undef PG8_BAR
#undef PG8_SCHED
}
}
namespace at {
using bf16 = __hip_bfloat16;
constexpr int   D = 128, NW = 8, QBLK = 32, KVBLK = 64;
constexpr float SCALE = 0.088388347648318440f;
#ifndef ATTN_THR
#define ATTN_THR 8.f
#endif
constexpr float THR = ATTN_THR;
constexpr int SDEPTH = 2;
constexpr int LDQ = 5632, LDK = 128, LDO = 2048;
constexpr size_t SHM_V = KVBLK * D * 2, SHM_K = KVBLK * D * 2, SHM_ATTN = 2 * SHM_V + 2 * SHM_K + NW * 64 * 4;
using f32x4v = __attribute__((ext_vector_type(4))) float;
using bf16x8 = __attribute__((ext_vector_type(8))) short;
using s16x4  = __attribute__((ext_vector_type(4))) short;
using f32x16 = __attribute__((ext_vector_type(16))) float;
using f32x8  = __attribute__((ext_vector_type(8))) float;
using u32x4  = __attribute__((ext_vector_type(4))) unsigned;
#define KSWZ(row, colB) ((row) * 256 + ((colB) ^ (((row) & 7) << 4)))
#define SBAR() __builtin_amdgcn_sched_barrier(0)
__device__ __forceinline__ int crow(int r, int hi) { return (r & 3) + 8 * (r >> 2) + 4 * hi; }
__device__ __forceinline__ unsigned cvtpk(float lo, float hi) {
  unsigned r; asm volatile("v_cvt_pk_bf16_f32 %0, %1, %2" : "=v"(r) : "v"(lo), "v"(hi)); return r;
}
template <typename TIn> struct Stage;
template <> struct Stage<bf16>  { using T = bf16x8;
  __device__ static __forceinline__ T ld8(const bf16* p) { return *reinterpret_cast<const bf16x8*>(p); }
  __device__ static __forceinline__ bf16x8 tobf(T x) { return x; } };
template <> struct Stage<float> { using T = f32x8;
  __device__ static __forceinline__ T ld8(const float* p) { return *reinterpret_cast<const f32x8*>(p); }
  __device__ static __forceinline__ bf16x8 tobf(T x) {
    u32x4 w = {cvtpk(x[0], x[1]), cvtpk(x[2], x[3]), cvtpk(x[4], x[5]), cvtpk(x[6], x[7])}; return *reinterpret_cast<bf16x8*>(&w); } };

__device__ __forceinline__ void partialSM(f32x16& p0, f32x16& p1, float& m_reg, float& mn, float& alpha) {
  constexpr float C = SCALE * 1.4426950408889634f;
  float pmax = p0[0]; for (int r = 1; r < 16; ++r) pmax = fmaxf(pmax, p0[r]); for (int r = 0; r < 16; ++r) pmax = fmaxf(pmax, p1[r]);
  { auto rr = __builtin_amdgcn_permlane32_swap(__float_as_uint(pmax), __float_as_uint(pmax), false, false);
    pmax = fmaxf(__uint_as_float(rr[0]), __uint_as_float(rr[1])); }
  if (__builtin_expect(__all(pmax - m_reg <= THR / SCALE), 1)) { mn = m_reg; alpha = 1.f; }
  else { mn = fmaxf(m_reg, pmax); alpha = __builtin_amdgcn_exp2f((m_reg - mn) * C); m_reg = mn; }
  float mnC = -mn * C;
  for (int r = 0; r < 16; ++r) p0[r] = fmaf(p0[r], C, mnC); for (int r = 0; r < 16; ++r) p1[r] = fmaf(p1[r], C, mnC);
  for (int r = 0; r < 16; ++r) p0[r] = __builtin_amdgcn_exp2f(p0[r]);
}
__device__ __forceinline__ void finishSM(f32x16& p0, f32x16& p1, float alpha, float& l_reg, bf16x8& pa0, bf16x8& pa1, bf16x8& pa2, bf16x8& pa3) {
  for (int r = 0; r < 16; ++r) p1[r] = __builtin_amdgcn_exp2f(p1[r]);
  float ps = 0; for (int r = 0; r < 16; ++r) ps += p0[r]; for (int r = 0; r < 16; ++r) ps += p1[r];
  { auto rr = __builtin_amdgcn_permlane32_swap(__float_as_uint(ps), __float_as_uint(ps), false, false);
    ps = __uint_as_float(rr[0]) + __uint_as_float(rr[1]); }
  l_reg = l_reg * alpha + ps;
#define PK4(P, BASE, OUT) do { unsigned a0 = cvtpk(P[BASE + 0], P[BASE + 1]), a1 = cvtpk(P[BASE + 2], P[BASE + 3]);   \
    unsigned b0 = cvtpk(P[BASE + 4], P[BASE + 5]), b1 = cvtpk(P[BASE + 6], P[BASE + 7]);                              \
    auto r0 = __builtin_amdgcn_permlane32_swap(a0, b0, false, false); auto r1 = __builtin_amdgcn_permlane32_swap(a1, b1, false, false); \
    u32x4 w = {r0[0], r1[0], r0[1], r1[1]}; OUT = *reinterpret_cast<bf16x8*>(&w); } while (0)
  PK4(p0, 0, pa0); PK4(p0, 8, pa1); PK4(p1, 0, pa2); PK4(p1, 8, pa3);
#undef PK4
}
__device__ __forceinline__ void qkt(f32x16& p0, f32x16& p1, const bf16* Ks, const bf16x8* qr, int r32, int hi) {
  p0 = f32x16{}; p1 = f32x16{};
  for (int d0 = 0; d0 < 8; ++d0) { int cb = (d0 * 16 + hi * 8) * 2;
    bf16x8 b0 = *reinterpret_cast<const bf16x8*>((const char*)Ks + KSWZ(r32, cb));
    bf16x8 b1 = *reinterpret_cast<const bf16x8*>((const char*)Ks + KSWZ(32 + r32, cb));
    p0 = __builtin_amdgcn_mfma_f32_32x32x16_bf16(b0, qr[d0], p0, 0, 0, 0);
    p1 = __builtin_amdgcn_mfma_f32_32x32x16_bf16(b1, qr[d0], p1, 0, 0, 0); }
}
__device__ __forceinline__ int v_st(int k, int c) { const int kk = (k & ~0xC) | ((k & 4) << 1) | ((k & 8) >> 1); return ((kk >> 3) * 4 + (c >> 5)) * 512 + ((kk & 7) * 32 + (c & 31)) * 2; }
__device__ __forceinline__ int v_rd_base(int lane) { return ((lane & 3) << 3) | (((lane >> 2) & 3) << 6) | (((lane >> 4) & 1) << 5) | (((lane >> 5) & 1) << 8); }
constexpr int v_rd_off(int d0, int ks, int half) { return d0 * 512 + ks * 4096 + half * 2048; }
template <int OFF> __device__ __forceinline__ s16x4 tr_read(int vb) {
  s16x4 r; asm volatile("ds_read_b64_tr_b16 %0, %1 offset:%2" : "=&v"(r) : "v"(vb), "i"(OFF) : "memory"); return r;
}
template <int D0> __device__ __forceinline__ void pv_one(f32x16& od, int vb, bf16x8 pa0, bf16x8 pa1, bf16x8 pa2, bf16x8 pa3) {
  const s16x4 l0 = tr_read<v_rd_off(D0, 0, 0)>(vb), h0 = tr_read<v_rd_off(D0, 0, 1)>(vb), l1 = tr_read<v_rd_off(D0, 1, 0)>(vb), h1 = tr_read<v_rd_off(D0, 1, 1)>(vb);
  const s16x4 l2 = tr_read<v_rd_off(D0, 2, 0)>(vb), h2 = tr_read<v_rd_off(D0, 2, 1)>(vb), l3 = tr_read<v_rd_off(D0, 3, 0)>(vb), h3 = tr_read<v_rd_off(D0, 3, 1)>(vb);
  asm volatile("s_waitcnt lgkmcnt(0)" ::: "memory"); SBAR();
#define PK(L, H) (bf16x8){L[0], L[1], L[2], L[3], H[0], H[1], H[2], H[3]}
  od = __builtin_amdgcn_mfma_f32_32x32x16_bf16(pa0, PK(l0, h0), od, 0, 0, 0);
  od = __builtin_amdgcn_mfma_f32_32x32x16_bf16(pa1, PK(l1, h1), od, 0, 0, 0);
  od = __builtin_amdgcn_mfma_f32_32x32x16_bf16(pa2, PK(l2, h2), od, 0, 0, 0);
  od = __builtin_amdgcn_mfma_f32_32x32x16_bf16(pa3, PK(l3, h3), od, 0, 0, 0);
#undef PK
}
__device__ __forceinline__ void pv_d0(f32x16* o, int vb, bf16x8 pa0, bf16x8 pa1, bf16x8 pa2, bf16x8 pa3) {
  pv_one<0>(o[0], vb, pa0, pa1, pa2, pa3); pv_one<1>(o[1], vb, pa0, pa1, pa2, pa3); pv_one<2>(o[2], vb, pa0, pa1, pa2, pa3); pv_one<3>(o[3], vb, pa0, pa1, pa2, pa3);
}

__device__ __forceinline__ void attn_dense_body(const bf16* __restrict__ Qb, const bf16* __restrict__ Kh, const bf16* __restrict__ Vh,
                                                const bf16* __restrict__ Zb, bf16* __restrict__ Ob, int seq, char* lds) {
  using TQ = bf16; using St = Stage<bf16>; using SQ = Stage<TQ>;
  int tid_ = threadIdx.x; asm volatile("" : "+v"(tid_));
  const int tid = tid_, wid = tid >> 6, lane = tid & 63, r32 = lane & 31, hi = lane >> 5;
  bf16* V_lds = (bf16*)lds; bf16* K_lds = (bf16*)(lds + 2 * SHM_V);
  float* ws = (float*)(lds + 2 * SHM_V + 2 * SHM_K) + wid * 64; float* li_l = ws; float* al_l = ws + 32;
  float m_reg = -1e30f, l_reg = 0; f32x16 o[4] = {}; bf16x8 qr[8];
  const TQ* Qw = Qb + (long)(wid * QBLK + r32) * LDQ + hi * 8;
#pragma unroll
  for (int d0 = 0; d0 < 8; ++d0) qr[d0] = SQ::tobf(SQ::ld8(Qw + d0 * 16));
  const int sr = tid >> 4, sc = (tid & 15) * 8, vst0 = v_st(sr, sc), vst1 = v_st(32 + sr, sc);
  const int vb0 = (int)(uintptr_t)V_lds + v_rd_base(lane);
  struct { typename St::T vs0, vs1, ks0, ks1; } sr_[SDEPTH];
#define SLOAD(i, k0) do { sr_[i].vs0 = St::ld8(&Vh[(long)((k0) + sr) * LDK + sc]); sr_[i].vs1 = St::ld8(&Vh[(long)((k0) + 32 + sr) * LDK + sc]); \
    sr_[i].ks0 = St::ld8(&Kh[(long)((k0) + sr) * LDK + sc]); sr_[i].ks1 = St::ld8(&Kh[(long)((k0) + 32 + sr) * LDK + sc]); } while (0)
#define SWRITE(b, i) do { *(bf16x8*)((char*)V_lds + (b) * SHM_V + vst0) = St::tobf(sr_[i].vs0);          \
    *(bf16x8*)((char*)V_lds + (b) * SHM_V + vst1) = St::tobf(sr_[i].vs1); int kc = sc * 2;               \
    *(bf16x8*)((char*)K_lds + (b) * SHM_K + KSWZ(sr, kc)) = St::tobf(sr_[i].ks0);                       \
    *(bf16x8*)((char*)K_lds + (b) * SHM_K + KSWZ(32 + sr, kc)) = St::tobf(sr_[i].ks1); } while (0)
#define SWAIT() do { if constexpr (SDEPTH == 2) asm volatile("s_waitcnt vmcnt(4)" ::: "memory"); else asm volatile("s_waitcnt vmcnt(0)" ::: "memory"); } while (0)
#define RESC(a) do { if (__any((a) < 1.f)) { if (hi == 0) al_l[r32] = (a); asm volatile("s_waitcnt lgkmcnt(0)" ::: "memory"); \
    for (int d = 0; d < 4; ++d) for (int r = 0; r < 16; ++r) o[d][r] *= al_l[crow(r, hi)]; } } while (0)
  f32x16 pA0, pA1, pB0, pB1; float mnA, mnB, alA, alB; bf16x8 pa0, pa1, pa2, pa3; const int NT = seq / KVBLK;
  constexpr int SE = 0, SO = SDEPTH - 1;
  SLOAD(SE, 0); asm volatile("s_waitcnt vmcnt(0)" ::: "memory"); SWRITE(0, SE); __syncthreads();
  qkt(pA0, pA1, K_lds, qr, r32, hi); partialSM(pA0, pA1, m_reg, mnA, alA);
  SLOAD(SO, KVBLK); if constexpr (SDEPTH == 2) { if (2 < NT) SLOAD(SE, 2 * KVBLK); }
  SWAIT(); SWRITE(1, SO); __syncthreads();
  for (int j = 1; j + 1 < NT; j += 2) {
    SBAR(); qkt(pB0, pB1, (bf16*)((char*)K_lds + SHM_K), qr, r32, hi);
    finishSM(pA0, pA1, alA, l_reg, pa0, pa1, pa2, pa3); SBAR();
    SLOAD(SO, (j + SDEPTH) * KVBLK); SBAR();
    pv_d0(o, vb0, pa0, pa1, pa2, pa3); partialSM(pB0, pB1, m_reg, mnB, alB);
    __syncthreads(); SWAIT(); SWRITE(0, SE);
    RESC(alB); __syncthreads();
    SBAR(); qkt(pA0, pA1, K_lds, qr, r32, hi);
    finishSM(pB0, pB1, alB, l_reg, pa0, pa1, pa2, pa3); SBAR();
    if (SDEPTH == 1 || j + 3 < NT) SLOAD(SE, (j + 1 + SDEPTH) * KVBLK); SBAR();
    pv_d0(o, vb0 + (int)SHM_V, pa0, pa1, pa2, pa3); partialSM(pA0, pA1, m_reg, mnA, alA);
    __syncthreads(); SWAIT(); SWRITE(1, SO);
    RESC(alA); __syncthreads();
  }
  SBAR(); qkt(pB0, pB1, (bf16*)((char*)K_lds + SHM_K), qr, r32, hi);
  finishSM(pA0, pA1, alA, l_reg, pa0, pa1, pa2, pa3); SBAR();
  pv_d0(o, vb0, pa0, pa1, pa2, pa3); partialSM(pB0, pB1, m_reg, mnB, alB);
  __syncthreads(); RESC(alB);
  finishSM(pB0, pB1, alB, l_reg, pa0, pa1, pa2, pa3); SBAR();
  pv_d0(o, vb0 + (int)SHM_V, pa0, pa1, pa2, pa3);
  if (hi == 0) li_l[r32] = l_reg; asm volatile("s_waitcnt lgkmcnt(0)" ::: "memory");
  float rli[16];
#pragma unroll
  for (int r = 0; r < 16; ++r) rli[r] = __builtin_amdgcn_rcpf(li_l[crow(r, hi)]);
  bf16* Ow = Ob + (long)(wid * QBLK) * LDO; const bf16* Zw = Zb + (long)(wid * QBLK) * LDQ;
  char* stg = lds + (2 * SHM_V + 2 * SHM_K + NW * 64 * 4) + wid * (32 * 272);
#pragma unroll
  for (int r = 0; r < 16; ++r) { const int orow = crow(r, hi);
#pragma unroll
    for (int d0 = 0; d0 < 4; ++d0) *(unsigned short*)(stg + orow * 272 + (d0 * 32 + r32) * 2) = (unsigned short)cvtpk(o[d0][r] * rli[r], 0.f); }
  asm volatile("s_waitcnt lgkmcnt(0)" ::: "memory");
  { const int c8 = (lane & 15) * 8, rq = lane >> 4;
#pragma unroll
    for (int i = 0; i < 8; ++i) { const int row = rq + 4 * i;
      const u32x4 ov = *reinterpret_cast<const u32x4*>(stg + row * 272 + c8 * 2);
      const u32x4 zv = *reinterpret_cast<const u32x4*>(Zw + (long)row * LDQ + c8);
      u32x4 w;
#define OZ(k) cvtpk(__uint_as_float(ov[k] << 16) * __uint_as_float(zv[k] << 16), __uint_as_float(ov[k] & 0xffff0000u) * __uint_as_float(zv[k] & 0xffff0000u))
      w[0] = OZ(0); w[1] = OZ(1); w[2] = OZ(2); w[3] = OZ(3);
#undef OZ
      *reinterpret_cast<u32x4*>(Ow + (long)row * LDO + c8) = w; } }
#undef SLOAD
#undef SWRITE
#undef SWAIT
#undef RESC
}
template <int D0> __device__ __forceinline__ void sgu_one(f32x16& od, int vb, bf16x8 w0, bf16x8 w1, bf16x8 w2, bf16x8 w3) {
  const s16x4 l0 = tr_read<v_rd_off(D0, 0, 0)>(vb), h0 = tr_read<v_rd_off(D0, 0, 1)>(vb), l1 = tr_read<v_rd_off(D0, 1, 0)>(vb), h1 = tr_read<v_rd_off(D0, 1, 1)>(vb);
  const s16x4 l2 = tr_read<v_rd_off(D0, 2, 0)>(vb), h2 = tr_read<v_rd_off(D0, 2, 1)>(vb), l3 = tr_read<v_rd_off(D0, 3, 0)>(vb), h3 = tr_read<v_rd_off(D0, 3, 1)>(vb);
  asm volatile("s_waitcnt lgkmcnt(0)" ::: "memory"); SBAR();
#define PK(L, H) (bf16x8){L[0], L[1], L[2], L[3], H[0], H[1], H[2], H[3]}
  od = __builtin_amdgcn_mfma_f32_32x32x16_bf16(PK(l0, h0), w0, od, 0, 0, 0);
  od = __builtin_amdgcn_mfma_f32_32x32x16_bf16(PK(l1, h1), w1, od, 0, 0, 0);
  od = __builtin_amdgcn_mfma_f32_32x32x16_bf16(PK(l2, h2), w2, od, 0, 0, 0);
  od = __builtin_amdgcn_mfma_f32_32x32x16_bf16(PK(l3, h3), w3, od, 0, 0, 0);
#undef PK
}
__device__ __forceinline__ float bf_lo(unsigned w) { return __uint_as_float(w << 16); }
__device__ __forceinline__ float bf_hi(unsigned w) { return __uint_as_float(w & 0xffff0000u); }
constexpr int SGU_S_OFF = 2 * (int)SHM_V, SGU_S_LD = 132;
struct SguRegs { bf16x8 t00, t01, t10, t11; u32x4 uu[4], zz[4]; };
__device__ __forceinline__ void sgu_load(SguRegs& R, const bf16* __restrict__ Pb, int item, int sr, int sc, int lat) {
  const int ci = item >> 3, g = item & 7; const int chunk = lat ? (ci >> 5) * 34 + 2 + (ci & 31) : ci;     const long R0 = (long)chunk * 128;
  const bf16* vsrc = Pb + R0 * LDQ + 1024 + g * 128 + sc;
  R.t00 = *reinterpret_cast<const bf16x8*>(vsrc + (long)(sr) * LDQ); R.t01 = *reinterpret_cast<const bf16x8*>(vsrc + (long)(32 + sr) * LDQ);
  R.t10 = *reinterpret_cast<const bf16x8*>(vsrc + (long)(64 + sr) * LDQ); R.t11 = *reinterpret_cast<const bf16x8*>(vsrc + (long)(96 + sr) * LDQ);
  const bf16* urow = Pb + (R0 + sr) * LDQ + g * 128 + sc;
#pragma unroll
  for (int k = 0; k < 4; ++k) { R.uu[k] = *reinterpret_cast<const u32x4*>(urow + (long)(32 * k) * LDQ); R.zz[k] = *reinterpret_cast<const u32x4*>(urow + (long)(32 * k) * LDQ + 2048); }
}
__device__ __forceinline__ void sgu_phase(const bf16* __restrict__ Pb, bf16* __restrict__ YC, const bf16* __restrict__ Wf  ,
                                          const float* __restrict__ bsgu  , int first, int stride, int nitems, char* lds, int lat) {
  int tid_ = threadIdx.x; asm volatile("" : "+v"(tid_));
  const int tid = tid_, wid = tid >> 6, lane = tid & 63, r32 = lane & 31, hi = lane >> 5;
  bf16* V_lds = (bf16*)lds; float* S_lds = (float*)(lds + SGU_S_OFF);
  const int sr = tid >> 4, sc = (tid & 15) * 8, vst0 = v_st(sr, sc), vst1 = v_st(32 + sr, sc);
  const int pb = wid & 3, P0 = 32 * pb, DB = 2 * (wid >> 2);
  const int vb = (int)(uintptr_t)V_lds + v_rd_base(lane) + DB * 512;
  if (first >= nitems) return;
  SguRegs C, N;
  sgu_load(C, Pb, first, sr, sc, lat);
  for (int item = first; item < nitems; item += stride) {
    const int ci = item >> 3, g = item & 7; const int chunk = lat ? (ci >> 5) * 34 + 2 + (ci & 31) : ci; const long R0 = (long)chunk * 128;
    *(bf16x8*)((char*)V_lds + vst0) = C.t00; *(bf16x8*)((char*)V_lds + vst1) = C.t01;
    *(bf16x8*)((char*)V_lds + SHM_V + vst0) = C.t10; *(bf16x8*)((char*)V_lds + SHM_V + vst1) = C.t11;
    const bf16x8* wfp = reinterpret_cast<const bf16x8*>(Wf) + ((long)(g * 4 + pb) * 8) * 64 + lane;
    bf16x8 wf[2][4];
#pragma unroll
    for (int T = 0; T < 2; ++T)
#pragma unroll
      for (int s = 0; s < 4; ++s) wf[T][s] = wfp[(T * 4 + s) * 64];
    const bool has_next = item + stride < nitems;
    if (has_next) sgu_load(N, Pb, item + stride, sr, sc, lat);
    __syncthreads();
    f32x16 o0 = {}, o1 = {};
    sgu_one<0>(o0, vb, wf[0][0], wf[0][1], wf[0][2], wf[0][3]); sgu_one<1>(o1, vb, wf[0][0], wf[0][1], wf[0][2], wf[0][3]);
    sgu_one<0>(o0, vb + (int)SHM_V, wf[1][0], wf[1][1], wf[1][2], wf[1][3]); sgu_one<1>(o1, vb + (int)SHM_V, wf[1][0], wf[1][1], wf[1][2], wf[1][3]);
#pragma unroll
    for (int dd = 0; dd < 2; ++dd)
#pragma unroll
      for (int g4 = 0; g4 < 4; ++g4) { const int d = 32 * (DB + dd) + 8 * g4 + 4 * hi; const f32x16& o = dd ? o1 : o0;
        *reinterpret_cast<f32x4v*>(S_lds + (P0 + r32) * SGU_S_LD + d) = (f32x4v){o[4 * g4 + 0], o[4 * g4 + 1], o[4 * g4 + 2], o[4 * g4 + 3]}; }
    __syncthreads();
#pragma unroll
    for (int k = 0; k < 4; ++k) { const int row = sr + 32 * k; const float bias = bsgu[g * 128 + row];
      const f32x4v s0 = *reinterpret_cast<const f32x4v*>(S_lds + row * SGU_S_LD + sc), s1 = *reinterpret_cast<const f32x4v*>(S_lds + row * SGU_S_LD + sc + 4);
      const u32x4 u = C.uu[k], z = C.zz[k]; u32x4 w;
      w.x = cvtpk(bf_lo(u.x) * (s0[0] + bias) * bf_lo(z.x), bf_hi(u.x) * (s0[1] + bias) * bf_hi(z.x));
      w.y = cvtpk(bf_lo(u.y) * (s0[2] + bias) * bf_lo(z.y), bf_hi(u.y) * (s0[3] + bias) * bf_hi(z.y));
      w.z = cvtpk(bf_lo(u.z) * (s1[0] + bias) * bf_lo(z.z), bf_hi(u.z) * (s1[1] + bias) * bf_hi(z.z));
      w.w = cvtpk(bf_lo(u.w) * (s1[2] + bias) * bf_lo(z.w), bf_hi(u.w) * (s1[3] + bias) * bf_hi(z.w));
      *reinterpret_cast<u32x4*>(YC + (R0 + row) * LDO + g * 128 + sc) = w; }
    if (has_next) C = N;
    __syncthreads();
  }
}
}
typedef float f32x4 __attribute__((ext_vector_type(4)));
typedef unsigned v4u __attribute__((ext_vector_type(4)));
typedef unsigned short bf16_t;
#define LDS_WAIT() asm volatile("s_waitcnt lgkmcnt(0)" ::: "memory")
__device__ __forceinline__ unsigned f2bf(float f) { unsigned u = __builtin_bit_cast(unsigned, f); return (u + 0x7fffu + ((u >> 16) & 1u)) >> 16; }
__device__ __forceinline__ unsigned pk2(float lo, float hi) { return f2bf(lo) | (f2bf(hi) << 16); }
__device__ __forceinline__ float wave_sum(float v) {
#pragma unroll
    for (int o = 1; o < 64; o <<= 1) v += __shfl_xor(v, o);
    return v;
}
__device__ __forceinline__ int physrow_in(int c) {
    if (c < C_Q || c >= C_VA) return c;
    const int d = c & 127; const int p = (d & 0x40) | ((d & 0x10) << 1) | ((d & 0xC) << 1) | ((d & 0x20) >> 3) | (d & 3);
    return (c & ~127) | p;
}
__device__ __forceinline__ void p0_transpose_item(const float* W, int K, int N, bf16_t* WT, bool perm, LAS float* scr, int item, int lane) {
    const int nblk = N / 32, kb = item / nblk, nb = item % nblk, k0 = 64 * kb, n0 = 32 * nb;
#pragma unroll 8
    for (int i = 0; i < 32; ++i) { const int kk = 2 * i + (lane >> 5); scr[kk * 33 + (lane & 31)] = W[(size_t)(k0 + kk) * N + n0 + (lane & 31)]; }
    LDS_WAIT(); asm volatile("" ::: "memory");
    const int c = lane & 7;
#pragma unroll
    for (int j = 0; j < 4; ++j) { const int n = (lane >> 3) + 8 * j; const LAS float* s = scr + (8 * c) * 33 + n;
        v4u o; o.x = pk2(s[0 * 33], s[1 * 33]); o.y = pk2(s[2 * 33], s[3 * 33]); o.z = pk2(s[4 * 33], s[5 * 33]); o.w = pk2(s[6 * 33], s[7 * 33]);
        const int rown = perm ? physrow_in(n0 + n) : (n0 + n);
        *(v4u*)(WT + (size_t)rown * K + k0 + 8 * c) = o; }
    LDS_WAIT(); asm volatile("" ::: "memory");
}
__device__ __forceinline__ void p0_prologue(const Args& a, LAS unsigned char* lds, int tid, int lane, int wave, int vcu, int G) {
    float* mod = (float*)(a.ws + WS_MOD);
    {
        LAS float* sl = (LAS float*)lds; LAS float* red = (LAS float*)(lds + 40960);
        for (int i = tid; i < 5 * 2048; i += 512) { const float v = (i < 4 * 2048) ? a.in[1][i] : a.in[3][i - 4 * 2048]; sl[i] = v / (1.f + __expf(-v)); }
        __syncthreads();
        const int cgp = tid % 12, kl = tid / 12;
        for (int item = vcu; item < 256; item += G) {
            const int l = item >> 7, j0 = (item & 127) * 48;
            if (kl < 42) {
                f32x4 acc[5];
#pragma unroll
                for (int r = 0; r < 5; ++r) acc[r] = (f32x4){0.f, 0.f, 0.f, 0.f};
                const float* wp = a.in[5] + (size_t)l * 2048 * 6144 + j0 + cgp * 4;
#pragma unroll 4
                for (int k = kl; k < 2048; k += 42) { const f32x4 w = *(const f32x4*)(wp + (size_t)k * 6144);
#pragma unroll
                    for (int r = 0; r < 5; ++r) acc[r] += sl[r * 2048 + k] * w; }
#pragma unroll
                for (int r = 0; r < 5; ++r) *(LAS f32x4*)(red + (kl * 5 + r) * 48 + cgp * 4) = acc[r];
            }
            __syncthreads();
            if (tid < 240) { const int r = tid / 48, c = tid % 48; float s = 0.f;
                for (int q = 0; q < 42; ++q) s += red[(q * 5 + r) * 48 + c];
                mod[(l * 5 + r) * 6144 + j0 + c] = s + a.in[6][l * 6144 + j0 + c]; }
            __syncthreads();
        }
    }
    if (vcu == G - 1) {
        float* rc = (float*)(a.ws + WS_ROPE); float* rs = rc + 2048;
        for (int idx = tid; idx < 2048; idx += 512) { const int pos = idx >> 5, i = idx & 31;
            const float inv = exp2f(-(float)(2 * i) * (1.f / 64.f) * 13.287712379549449f);
            const float ang = (float)pos * inv; rc[idx] = cosf(ang); rs[idx] = sinf(ang); }
    }
    {
        v4u* Wf = (v4u*)(a.ws + WS_WSGU);
        for (int idx = vcu * 512 + tid; idx < 2 * 8 * 4 * 8 * 64; idx += G * 512) { const int ln = idx & 63, ts = (idx >> 6) & 7, pbb = (idx >> 9) & 3, lg = idx >> 11;
            const float* q = a.in[8] + ((size_t)lg * 128 + 32 * pbb + (ln & 31)) * 128 + 16 * ts + 8 * (ln >> 5);
            const f32x4 lo = *(const f32x4*)q, hh = *(const f32x4*)(q + 4);
            v4u o; o.x = pk2(lo[0], lo[1]); o.y = pk2(lo[2], lo[3]); o.z = pk2(hh[0], hh[1]); o.w = pk2(hh[2], hh[3]); Wf[idx] = o; }
    }
    {
        LAS float* scr = (LAS float*)(lds + wave * 16384);
        const int gw = vcu * 8 + wave, NGW = G * 8;
        bf16_t* WinT = (bf16_t*)(a.ws + WS_WIN); bf16_t* WoutT = (bf16_t*)(a.ws + WS_WOUT);
        constexpr int I_IN = 32 * (DIN / 32), I_OUT = 32 * (DM / 32), I_L = I_IN + I_OUT;
        for (int it = gw; it < 2 * I_L; it += NGW) { const int l = it / I_L; const int r = it - l * I_L;
            if (r < I_IN) p0_transpose_item(a.in[7] + (size_t)l * DM * DIN, DM, DIN, WinT + (size_t)l * DIN * DM, true, scr, r, lane);
            else p0_transpose_item(a.in[13] + (size_t)l * DM * DM, DM, DM, WoutT + (size_t)l * DM * DM, false, scr, r - I_IN, lane); }
    }
}
__device__ __forceinline__ void pA_norm(const Args& a, int l, int gw, int NGW, int lane_) {
    int lane = lane_; asm volatile("" : "+v"(lane));
    const float* mod = (const float*)(a.ws + WS_MOD) + (size_t)l * 5 * 6144;
    const float* nw = a.in[4] + l * DM;
    const float* xc1 = (const float*)(a.ws + WS_XC1);
    bf16_t* H = (bf16_t*)(a.ws + WS_H);
    const int rpw = (MROWS + NGW - 1) / NGW;
    const int R0 = gw * rpw, R1 = (R0 + rpw < MROWS) ? R0 + rpw : MROWS;
    int cur = -1; f32x4 g[8], sh[8];
    for (int R = R0; R < R1; ++R) {
        const int b = R / RPB, rb = R - b * RPB; const bool isctx = rb < CTX; const int rm = isctx ? 4 : b;
        const float* src = (l == 0) ? (isctx ? a.in[2] + (size_t)(b * CTX + rb) * DM : a.in[0] + (size_t)(b * SEQ + rb - CTX) * DM)
                                    : (isctx ? xc1 + (size_t)(b * CTX + rb) * DM : a.out + (size_t)(b * SEQ + rb - CTX) * DM);
        if (rm != cur) { cur = rm;
#pragma unroll
            for (int j = 0; j < 8; ++j) { const int c = 4 * lane + 256 * j; const f32x4 w = *(const f32x4*)(nw + c), sc = *(const f32x4*)(mod + rm * 6144 + 2048 + c);
                g[j] = w * (1.f + sc); sh[j] = *(const f32x4*)(mod + rm * 6144 + c); } }
        f32x4 v[8]; float s = 0.f;
#pragma unroll
        for (int j = 0; j < 8; ++j) { v[j] = *(const f32x4*)(src + 4 * lane + 256 * j); s += (v[j][0] * v[j][0] + v[j][1] * v[j][1]) + (v[j][2] * v[j][2] + v[j][3] * v[j][3]); }
        const float rstd = 1.f / sqrtf(wave_sum(s) * (1.f / DM) + EPS);
        unsigned long long* o8 = (unsigned long long*)(H + (size_t)R * DM) + lane;
#pragma unroll
        for (int j = 0; j < 8; ++j) { const f32x4 y = v[j] * rstd * g[j] + sh[j]; o8[64 * j] = (unsigned long long)pk2(y[0], y[1]) | ((unsigned long long)pk2(y[2], y[3]) << 32); }
    }
}

#define RLX_AGENT __ATOMIC_RELAXED, __HIP_MEMORY_SCOPE_AGENT
#define XB_TMO      128
#define XB_XCNT(j)  (256  + 64 * (j))
#define XB_XSUB(j)  (1280 + 64 * (j))
#define XB_XGEN(j)  (2304 + 64 * (j))
#define XB_TOP      3328
#define XB_TOPGEN   3392
#define XCD_BAR_WORDS 3456
#define XB_SPIN_CAP (1u << 18)

__device__ __forceinline__ unsigned xb_ld(unsigned* p)              { return __hip_atomic_load(p, __ATOMIC_RELAXED, __HIP_MEMORY_SCOPE_AGENT); }
__device__ __forceinline__ unsigned xb_add(unsigned* p, unsigned v) { return __hip_atomic_fetch_add(p, v, __ATOMIC_RELAXED, __HIP_MEMORY_SCOPE_AGENT); }
__device__ __forceinline__ unsigned xb_xcc_id() { return (unsigned)__builtin_amdgcn_s_getreg((3 << 11) | 20) & 0xFu; }
#define XB_SPIN(cond, bar) do { unsigned _sp = 0; while (cond) { __builtin_amdgcn_s_sleep(1); \
    if ((++_sp & 255u) == 0u) { if (xb_ld(&(bar)[XB_TMO])) break; if (_sp > XB_SPIN_CAP) { atomicAdd(&(bar)[XB_TMO], 1u); break; } } } } while (0)

struct XcdBarrier {
    unsigned* bar; unsigned x;
    volatile LAS unsigned* st;
};

__device__ __forceinline__ XcdBarrier xcd_barrier_post(unsigned* bar, volatile LAS unsigned* st) {
    XcdBarrier b; b.bar = bar; b.x = xb_xcc_id(); b.st = st;
    if (threadIdx.x == 0) (void)xb_add(&bar[XB_XCNT(b.x)], 1u);
    return b;
}
__device__ __forceinline__ void xcd_barrier_complete(unsigned* bar, unsigned x, unsigned& nloc, unsigned& nx) {
    const unsigned G = gridDim.x * gridDim.y * gridDim.z;
    unsigned sum, cnt, mine, sp = 0u;
    for (;;) {
        sum = 0u; cnt = 0u; mine = 0u;
#pragma unroll
        for (unsigned j = 0; j < 16; ++j) { const unsigned c = xb_ld(&bar[XB_XCNT(j)]); sum += c; cnt += (c > 0u) ? 1u : 0u; mine = (j == x) ? c : mine; }
        if (sum == G) break;
        __builtin_amdgcn_s_sleep(1);
        if ((++sp & 255u) == 0u) { if (xb_ld(&bar[XB_TMO])) break; if (sp > XB_SPIN_CAP) { atomicAdd(&bar[XB_TMO], 1u); break; } }
    }
    nloc = mine > 0u ? mine : 1u; nx = cnt > 0u ? cnt : 1u;
}

__device__ __forceinline__ void xcd_barrier(const XcdBarrier& b) {
    asm volatile("s_waitcnt vmcnt(0)" ::: "memory");
    __syncthreads();
    if (threadIdx.x == 0) {
        unsigned* bar = b.bar;
        __builtin_amdgcn_s_waitcnt(0);
        unsigned nloc = b.st[0], nx = b.st[1];
        if (nloc == 0u) { xcd_barrier_complete(bar, b.x, nloc, nx); b.st[0] = nloc; b.st[1] = nx; }
        const unsigned old = xb_add(&bar[XB_XSUB(b.x)], 1u);
        const unsigned gen = old / nloc;
        if (old + 1u == (gen + 1u) * nloc) {
            __builtin_amdgcn_fence(__ATOMIC_RELEASE, "agent");
            asm volatile("s_waitcnt vmcnt(0)" ::: "memory");
            const unsigned og = xb_add(&bar[XB_TOP], 1u);
            const unsigned tg = og / nx;
            if (og + 1u == (tg + 1u) * nx) xb_add(&bar[XB_TOPGEN], 1u);
            else XB_SPIN(xb_ld(&bar[XB_TOPGEN]) == tg, bar);
            __builtin_amdgcn_fence(__ATOMIC_ACQUIRE, "agent");
            xb_add(&bar[XB_XGEN(b.x)], 1u);
            asm volatile("s_waitcnt vmcnt(0)" ::: "memory");
        } else {
            XB_SPIN(xb_ld(&bar[XB_XGEN(b.x)]) == gen, bar);
            __builtin_amdgcn_fence(__ATOMIC_ACQUIRE, "agent");
            asm volatile("s_waitcnt vmcnt(0)" ::: "memory");
        }
    }
    __syncthreads();
}

__global__ void __launch_bounds__(512, 2) mk_fwd(Args a) {
    extern __shared__ __attribute__((aligned(16))) unsigned char lds[];
    cg::grid_group grid = cg::this_grid();
    LAS unsigned char* L = (LAS unsigned char*)lds;
    const int tid = threadIdx.x, lane = tid & 63, wave = __builtin_amdgcn_readfirstlane(tid >> 6);
    const int G = gridDim.x, bx = blockIdx.x; const int vcu = (G % 8 == 0) ? (bx % 8) * (G / 8) + bx / 8 : bx;
    const int lo = a.ph_lo, hi = a.ph_hi;
#define IN(k) (lo <= (k) && (k) < hi)
#define SEAM(k) do { if (IN(k) && IN((k) + 1)) { if (a.coop == 2) grid.sync(); else xcd_barrier(xbar); } } while (0)
    volatile LAS unsigned* xst = (volatile LAS unsigned*)(L + XCH_OFF + 8192);
    if (tid < 2) xst[tid] = 0u;
    __syncthreads();
    XcdBarrier xbar; xbar.bar = (unsigned*)(a.ws + WS_BAR); xbar.x = 0; xbar.st = xst;
    if (a.coop) xbar = xcd_barrier_post((unsigned*)(a.ws + WS_BAR), xst);

    bf16_t* Hb = (bf16_t*)(a.ws + WS_H); bf16_t* Pb = (bf16_t*)(a.ws + WS_P);
    if (IN(0)) { p0_prologue(a, L, tid, lane, wave, vcu, G); }
    SEAM(0);
#pragma nounroll
    for (int l = 0; l < 2; ++l) {
        const int pb = 1 + 4 * l;
        if (IN(pb)) { pA_norm(a, l, vcu * 8 + wave, G * 8, lane); }
        SEAM(pb);
        if (IN(pb + 1)) {
            pg8::Gemm g{Hb, (const bf16_t*)(a.ws + WS_WIN) + (size_t)l * DIN * DM, MROWS, DIN, DM};
            pg8::SchedX S; if (l == 0) S.init(68, 22, G, bx, 0, 0); else S.init(64, 22, G, bx, 1, 8);
            LAS float* Wn = (LAS float*)(L + 139520); LAS float* Tr = (LAS float*)(L + 147456);
            { const float* rg = (const float*)(a.ws + WS_ROPE); int tc = tid; asm volatile("" : "+v"(tc));
              for (int i = tc; i < 4096; i += 512) Tr[i] = rg[i];
              for (int i = tc; i < 1280; i += 512) Wn[i] = (i < 1024) ? a.in[10][l * 1024 + i] : ((i < 1152) ? a.in[11][l * 128 + i - 1024] : a.in[12][l * 128 + i - 1152]);
              __syncthreads(); }
            pg8::EpiIn E{Pb, Wn, Wn + 1024, Wn + 1152, Tr, Tr + 2048, (LAS float*)(L + XCH_OFF), (bf16_t*)(a.ws + WS_KC), (bf16_t*)(a.ws + WS_VC)};
            pg8::gemm_phase<pg8::EpiIn, pg8::SchedX, true, true>(L, g, S, E);
        }
        SEAM(pb + 1);
        if (IN(pb + 2)) {
            const at::bf16* P = (const at::bf16*)Pb; at::bf16* YC = (at::bf16*)Hb;
#pragma nounroll
            for (int st = 0; st < 2; ++st) {
            const bool do_sgu = (((st ^ vcu) & 1) == 0);
            if (do_sgu) { if (a.sub & 1)
            at::sgu_phase(P, YC, (const at::bf16*)(a.ws + WS_WSGU) + (size_t)l * 8 * 128 * 128, a.in[9] + l * 8 * 128, vcu, G, l == 0 ? 136 * 8 : 128 * 8, (char*)lds, l); }
            else {
            const int ntot = (a.sub & 2) ? 512 + (l == 0 ? 32 : 0) : 0;
            for (int i = 0;; ++i) { int Li = i * G + vcu; if (Li >= 512) Li -= 64;
                if (Li >= ntot || (i >= 2 && Li < 512)) break;
                int b, h, qrow, seq;
                if (Li < 512) { const int qb = Li & 15; h = (Li >> 4) & 7; b = Li >> 7; qrow = b * RPB + CTX + qb * 256; seq = RPB; }
                else { const int c = Li - 512; b = c >> 3; h = c & 7; qrow = b * RPB; seq = CTX; }
                const long krow = (long)b * RPB; const int kvh = h >> 2;
                const long kvo = ((long)(b * 2 + kvh) * RPB) * 128;
                at::attn_dense_body(P + (long)qrow * DIN + C_Q + h * 128, (const at::bf16*)(a.ws + WS_KC) + kvo, (const at::bf16*)(a.ws + WS_VC) + kvo,
                                    P + (long)qrow * DIN + C_ZB + h * 128, YC + (long)qrow * DM + 1024 + h * 128, seq, (char*)lds);
                __syncthreads(); } }
            __syncthreads(); }
        }
        SEAM(pb + 2);
        if (IN(pb + 3)) {
            pg8::Gemm g{Hb, (const bf16_t*)(a.ws + WS_WOUT) + (size_t)l * DM * DM, MROWS, DM, DM};
            pg8::SchedX S; if (l == 0) S.init(68, 8, G, bx, 0, 0); else S.init(64, 8, G, bx, 1, 0);
            pg8::EpiOut E{l == 0 ? a.in[0] : a.out, a.in[2], a.out, (float*)(a.ws + WS_XC1), (const float*)(a.ws + WS_MOD) + (size_t)l * 5 * 6144 + 4096};
            pg8::gemm_phase<pg8::EpiOut, pg8::SchedX, false, true>(L, g, S, E);
        }
        SEAM(pb + 3);
    }
#undef IN
#undef SEAM
}

extern "C" void kernel_launch(void* const* d_in, const int* in_sizes, int n_in, void* d_out, int out_size, void* d_ws, size_t ws_size, hipStream_t stream) {
    static int grid = 0;
    if (grid == 0) {
        if (n_in != 14 || in_sizes[0] != NB * SEQ * DM || out_size != NB * SEQ * DM || ws_size < WS_END) {
            fprintf(stderr, "kernel_launch: shape mismatch (n_in %d, in0 %d, out %d, ws %zu; need ws >= %zu); nothing launched\n", n_in, n_in > 0 ? in_sizes[0] : -1, out_size, ws_size, (size_t)WS_END); grid = -1; return; }
        int dev = 0, cus = 0, per_cu = 0;
        if (hipGetDevice(&dev) != hipSuccess || hipDeviceGetAttribute(&cus, hipDeviceAttributeMultiprocessorCount, dev) != hipSuccess) { fprintf(stderr, "kernel_launch: device query failed\n"); grid = -1; return; }
        if (hipFuncSetAttribute((const void*)mk_fwd, hipFuncAttributeMaxDynamicSharedMemorySize, LDS_BYTES) != hipSuccess) { fprintf(stderr, "kernel_launch: hipFuncSetAttribute failed\n"); grid = -1; return; }
        if (hipOccupancyMaxActiveBlocksPerMultiprocessor(&per_cu, (const void*)mk_fwd, 512, LDS_BYTES) != hipSuccess || per_cu < 1) { fprintf(stderr, "kernel_launch: occupancy query says %d blocks per CU\n", per_cu); per_cu = 1; }
        (void)hipGetLastError();
        grid = cus * 1;
    }
    if (grid < 0) return;
    Args a{};
    for (int i = 0; i < 14; ++i) a.in[i] = (const float*)d_in[i];
    a.out = (float*)d_out; a.ws = (unsigned char*)d_ws; a.sub = 3;
#if MK_MULTI
    for (int ph = 0; ph < NPHASE; ++ph) { a.ph_lo = ph; a.ph_hi = ph + 1; a.coop = 0;
        hipLaunchKernelGGL(mk_fwd, dim3(grid), dim3(512), LDS_BYTES, stream, a);
        const hipError_t le = hipPeekAtLastError(); if (le != hipSuccess) { fprintf(stderr, "kernel_launch: launch %d failed: %s\n", ph, hipGetErrorName(le)); break; }
#ifdef PROBE_PH
        if ((PROBE_PH >> ph) & 1) { a.sub = PROBE_SUB; hipLaunchKernelGGL(mk_fwd, dim3(grid), dim3(512), LDS_BYTES, stream, a); a.sub = 3; }
#endif
    }
#else
    a.ph_lo = 0; a.ph_hi = NPHASE; a.coop = 1;
    if (hipMemsetAsync((char*)d_ws + WS_BAR, 0, 16384, stream) != hipSuccess) { fprintf(stderr, "kernel_launch: hipMemsetAsync of the barrier words failed\n"); return; }
    void* args[] = {&a};
    const hipError_t e = hipLaunchCooperativeKernel((const void*)mk_fwd, dim3(grid), dim3(512), args, LDS_BYTES, stream);
    if (e != hipSuccess) fprintf(stderr, "kernel_launch: cooperative launch failed: %s (grid %d)\n", hipGetErrorString(e), grid);
#endif
}
```

```cpp
#include <hip/hip_runtime.h>
#include <hip/hip_cooperative_groups.h>
#include <hip/hip_bf16.h>
#include <cstdio>
#include <cstdint>
namespace cg = cooperative_groups;

#ifndef MK_MULTI
#define MK_MULTI 0
#endif

constexpr int DM = 2048, NB = 4, SEQ = 4096, CTX = 256, RPB = CTX + SEQ, MROWS = NB * RPB, DIN = 5632;
constexpr int C_U = 0, C_V = 1024, C_ZA = 2048, C_Q = 3072, C_K = 4096, C_VA = 4352, C_ZB = 4608;
constexpr int TPB = RPB / 256;
constexpr float EPS = 1e-6f;
constexpr int NPHASE = 9;
constexpr size_t MiB = 1u << 20;
constexpr size_t WS_MOD = 0;
constexpr size_t WS_ROPE = 1 * MiB;
constexpr size_t WS_WSGU = 2 * MiB;
constexpr size_t WS_BAR = 3 * MiB;
constexpr size_t WS_XC1 = 4 * MiB;
constexpr size_t WS_WIN = 16 * MiB;
constexpr size_t WS_WOUT = 64 * MiB;
constexpr size_t WS_H = 80 * MiB;
constexpr size_t WS_P = 160 * MiB;
constexpr size_t WS_KC = 352 * MiB;
constexpr size_t WS_VC = 368 * MiB;
constexpr size_t WS_END = 384 * MiB;
constexpr int LDS_BYTES = 147456;
constexpr int XCH_OFF = 131072;

struct Args { const float* in[14]; float* out; unsigned char* ws; int ph_lo, ph_hi, coop, sub; };
#define LAS __attribute__((address_space(3)))
namespace pg8 {
#define PG8_LAS __attribute__((address_space(3)))
typedef unsigned short bf16_t;
typedef short bf16x8 __attribute__((ext_vector_type(8)));
typedef float f32x4 __attribute__((ext_vector_type(4)));
typedef unsigned u32x4 __attribute__((ext_vector_type(4)));
constexpr int BM = 256, BK = 64, HALF = 128, HTB = HALF * BK * 2  , STAGE_BYTES = 8 * HTB, NXCD = 8, WGM = 8;

__host__ __device__ __forceinline__ int lds_byte(int r, int c) { const int st = (r >> 4) * 2 + (c >> 5), rr = r & 15, cc = c & 31, ob = rr * 64 + cc * 2; return st * 1024 + (ob ^ (((ob >> 9) & 1) << 5)); }
__host__ __device__ __forceinline__ void stage_rc(int b, int& R, int& C) { const int st = b / 1024, sb = b % 1024, swz = sb ^ (((sb >> 9) & 1) << 5); R = (st >> 1) * 16 + swz / 64; C = (st & 1) * 32 + (swz % 64) / 2; }
__host__ __device__ __forceinline__ int perm32(int rho) { const int n = rho >> 4, i = rho & 15; return 8 * (i >> 2) + 4 * n + (i & 3); }

struct Unit { int pm, pn, kind; };
struct Gemm { const bf16_t* A; const bf16_t* Bt; int M, N, K; const bf16_t* A2; const bf16_t* B2; };

struct StaticOrder {
    int nM, nN, nwg, G, c;
    __host__ __device__ void init(int M, int N, int G_, int c_) { nM = M / BM; nN = N / BM; nwg = nM * nN; G = G_; c = c_; }
    __host__ __device__ bool next(int i, Unit& u) const {
        const long L = (long)i * G + c; if (L >= nwg) return false;
        int wgid = (int)L; { const int q = nwg / NXCD, r = nwg % NXCD, xcd = wgid % NXCD, off = wgid / NXCD; wgid = (xcd < r ? xcd * (q + 1) : r * (q + 1) + (xcd - r) * q) + off; }
        const int nig = WGM * nN, gid = wgid / nig, fm = gid * WGM, gsz = (nM - fm) < WGM ? (nM - fm) : WGM;
        u.pm = fm + ((wgid % nig) % gsz); u.pn = (wgid % nig) / gsz; return true;
    }
    __device__ __forceinline__ void a_ready(const Unit&) const {}
    __device__ __forceinline__ void done(const Unit&) const {}
};

__device__ __forceinline__ unsigned cvt_pk_bf16(float lo, float hi) { unsigned r; asm volatile("v_cvt_pk_bf16_f32 %0, %1, %2" : "=v"(r) : "v"(lo), "v"(hi)); return r; }
typedef float f32x2 __attribute__((ext_vector_type(2)));
__device__ __forceinline__ f32x4 gelu4(f32x4 x) {
    f32x4 o;
#pragma unroll
    for (int i = 0; i < 4; ++i) { const float v = x[i], t = v * (1.f + 0.044715f * v * v); const float e = __builtin_amdgcn_exp2f(-2.3022081981f * t); o[i] = v * __builtin_amdgcn_rcpf(1.f + e); }
    return o;
}
__device__ __forceinline__ f32x4 silu4(f32x4 x) {
    f32x4 o;
#pragma unroll
    for (int i = 0; i < 4; ++i) { const float v = x[i]; const float e = __builtin_amdgcn_exp2f(-1.4426950409f * v); o[i] = v * __builtin_amdgcn_rcpf(1.f + e); }
    return o;
}
__device__ __forceinline__ void store8(bf16_t* p, f32x4 v0, f32x4 v1) {
    u32x4 w; w.x = cvt_pk_bf16(v0[0], v0[1]); w.y = cvt_pk_bf16(v0[2], v0[3]); w.z = cvt_pk_bf16(v1[0], v1[1]); w.w = cvt_pk_bf16(v1[2], v1[3]); *(u32x4*)p = w;
}
struct EpiIn {
    static constexpr bool PERM = true, AFTER_DRAIN = false;
    bf16_t* P; const float* vnw; const float* qnw; const float* knw; const float* ropec; const float* ropes; PG8_LAS float* xch; bf16_t* Kc; bf16_t* Vc;
    const float* cx_in; const float* cx_gate; float* xc1; const float* nrm_w; const float* nrm_mod; bf16_t* Hout; unsigned* cnt;
    __device__ __forceinline__ void operator()(f32x4 (&acc)[2][2][4][2], const Unit& u, int wr, int wc, int fr, int fq) const {
        if (u.kind == 1) { ctx_out(acc, u, wr, wc, fr, fq); return; }
        const int pn = u.pn;
        const int colw = wc * 32 + 8 * fq;
        bf16_t* base = P + (size_t)(u.pm * 256 + wr * 64 + fr) * 5632 + pn * 256 + colw;
        if (pn == 17) {
            const int b = u.pm / 17, rb = (u.pm % 17) * 256 + wr * 64 + fr;
            bf16_t* vb_ = Vc + ((size_t)(b * 2) * 4352 + rb) * 128 + colw;
#pragma unroll
            for (int ai = 0; ai < 2; ++ai)
#pragma unroll
                for (int m = 0; m < 4; ++m)
#pragma unroll
                    for (int bj = 0; bj < 2; ++bj) store8(vb_ + ((size_t)bj * 4352 + ai * 128 + m * 16) * 128, acc[ai][bj][m][0], acc[ai][bj][m][1]);
            return;
        }
        if (pn < 4 || (pn >= 8 && pn < 12) || pn >= 17) {
            const int act = pn < 4 ? 0 : (pn == 17 ? 2 : 1);
#pragma unroll
            for (int ai = 0; ai < 2; ++ai)
#pragma unroll
                for (int m = 0; m < 4; ++m) { bf16_t* rp = base + (size_t)(ai * 128 + m * 16) * 5632;
#pragma unroll
                    for (int bj = 0; bj < 2; ++bj) { f32x4 v0 = acc[ai][bj][m][0], v1 = acc[ai][bj][m][1];
                        if (act == 0) { v0 = gelu4(v0); v1 = gelu4(v1); } else if (act == 1) { v0 = silu4(v0); v1 = silu4(v1); }
                        store8(rp + bj * 128, v0, v1); } }
            return;
        }
        if (pn < 8) gn_path<true>(acc, u, wr, wc, fr, fq, base, colw); else gn_path<false>(acc, u, wr, wc, fr, fq, base, colw);
    }
    __device__ __forceinline__ void ctx_out(const f32x4 (&acc)[2][2][4][2], const Unit& u, int wr, int wc, int fr, int fq) const {
        const int b = u.pm / 17;
        const int col0 = u.pn * 256 + wc * 32 + 8 * fq;
        f32x4 gv[2][2];
#pragma unroll
        for (int bj = 0; bj < 2; ++bj)
#pragma unroll
            for (int n = 0; n < 2; ++n) gv[bj][n] = *(const f32x4*)(cx_gate + col0 + bj * 128 + 4 * n);
        const size_t rbase = (size_t)(b * 256 + wr * 64 + fr) * 2048 + col0;
#pragma unroll
        for (int ai = 0; ai < 2; ++ai)
#pragma unroll
            for (int m = 0; m < 4; ++m) { const size_t ro = rbase + (size_t)(ai * 128 + m * 16) * 2048;
                f32x4 xs[2][2];
#pragma unroll
                for (int bj = 0; bj < 2; ++bj)
#pragma unroll
                    for (int n = 0; n < 2; ++n) xs[bj][n] = *(const f32x4*)(cx_in + ro + bj * 128 + 4 * n);
#pragma unroll
                for (int bj = 0; bj < 2; ++bj)
#pragma unroll
                    for (int n = 0; n < 2; ++n) *(f32x4*)(xc1 + ro + bj * 128 + 4 * n) = xs[bj][n] + gv[bj][n] * acc[ai][bj][m][n];
                if (m & 1) asm volatile("" ::: "memory"); }
        const bool t0 = (wr == 0 && wc == 0 && fr == 0 && fq == 0);
        asm volatile("s_waitcnt vmcnt(0)" ::: "memory"); __builtin_amdgcn_s_barrier(); asm volatile("" ::: "memory");
        if (t0) { __builtin_amdgcn_fence(__ATOMIC_RELEASE, "agent"); asm volatile("s_waitcnt vmcnt(0)" ::: "memory");
            __hip_atomic_fetch_add(cnt + 64 * b, 1u, __ATOMIC_RELAXED, __HIP_MEMORY_SCOPE_AGENT);
            unsigned sp = 0; while (__hip_atomic_load(cnt + 64 * b, __ATOMIC_RELAXED, __HIP_MEMORY_SCOPE_AGENT) < 8u && ++sp < (1u << 18)) __builtin_amdgcn_s_sleep(2);
            __builtin_amdgcn_fence(__ATOMIC_ACQUIRE, "agent"); asm volatile("s_waitcnt vmcnt(0)" ::: "memory"); }
        __builtin_amdgcn_s_barrier(); asm volatile("" ::: "memory");
        { const int w8 = wr * 4 + wc, lane = fr + 16 * fq;
          f32x4 g[8], sh[8];
#pragma unroll
          for (int j = 0; j < 8; ++j) { const int c = 4 * lane + 256 * j; const f32x4 w = *(const f32x4*)(nrm_w + c), sc = *(const f32x4*)(nrm_mod + 2048 + c); g[j] = w * (1.f + sc); sh[j] = *(const f32x4*)(nrm_mod + c); }
          for (int rr = 0; rr < 4; ++rr) { const int rb = u.pn * 32 + w8 * 4 + rr;
              const float* src = xc1 + (size_t)(b * 256 + rb) * 2048;
              f32x4 v[8]; float ss = 0.f;
#pragma unroll
              for (int j = 0; j < 8; ++j) { v[j] = *(const f32x4*)(src + 4 * lane + 256 * j); ss += (v[j][0] * v[j][0] + v[j][1] * v[j][1]) + (v[j][2] * v[j][2] + v[j][3] * v[j][3]); }
#pragma unroll
              for (int o = 1; o < 64; o <<= 1) ss += __shfl_xor(ss, o);
              const float rstd = 1.f / sqrtf(ss * (1.f / 2048.f) + 1e-6f);
              unsigned long long* o8 = (unsigned long long*)(Hout + (size_t)(b * 4352 + rb) * 2048) + lane;
#pragma unroll
              for (int j = 0; j < 8; ++j) { const f32x4 y = v[j] * rstd * g[j] + sh[j]; o8[64 * j] = (unsigned long long)cvt_pk_bf16(y[0], y[1]) | ((unsigned long long)cvt_pk_bf16(y[2], y[3]) << 32); } } }
        asm volatile("s_waitcnt vmcnt(0)" ::: "memory"); __builtin_amdgcn_s_barrier(); asm volatile("" ::: "memory");
        if (t0) { __builtin_amdgcn_fence(__ATOMIC_RELEASE, "agent"); asm volatile("s_waitcnt vmcnt(0)" ::: "memory");
            __hip_atomic_fetch_add(cnt + 256 + 64 * b, 1u, __ATOMIC_RELAXED, __HIP_MEMORY_SCOPE_AGENT); }
    }
    template <bool ISV>
    __device__ __forceinline__ void gn_path(const f32x4 (&acc)[2][2][4][2], const Unit& u, int wr, int wc, int fr, int fq, bf16_t* base, int colw) const {
        const int pn = u.pn;
#pragma unroll
        for (int ai = 0; ai < 2; ++ai)
#pragma unroll
            for (int m = 0; m < 4; ++m)
#pragma unroll
                for (int bj = 0; bj < 2; ++bj) { f32x4 a = acc[ai][bj][m][0], b = acc[ai][bj][m][1];
                    if (ISV) { a = gelu4(a); b = gelu4(b); }
                    float s = (a[0] * a[0] + a[1] * a[1]) + (a[2] * a[2] + a[3] * a[3]) + (b[0] * b[0] + b[1] * b[1]) + (b[2] * b[2] + b[3] * b[3]);
                    s += __shfl_xor(s, 16); s += __shfl_xor(s, 32);
                    if (fq == 0) xch[(ai * 128 + wr * 64 + m * 16 + fr) * 8 + bj * 4 + wc] = s;
                    if (ISV) __builtin_amdgcn_sched_barrier(0); }
        asm volatile("s_waitcnt lgkmcnt(0)" ::: "memory"); __builtin_amdgcn_s_barrier(); asm volatile("" ::: "memory");
        f32x4 w[2][2];
        if (ISV) {
#pragma unroll
            for (int bj = 0; bj < 2; ++bj)
#pragma unroll
                for (int n = 0; n < 2; ++n) w[bj][n] = *(const f32x4*)(vnw + ((pn - 4) * 2 + bj) * 128 + colw + 4 * n);
        } else {
            const float* nwp = pn < 16 ? qnw : knw; const int dlo = 64 * (wc >> 1) + 16 * (wc & 1) + 4 * fq;
            w[0][0] = *(const f32x4*)(nwp + dlo); w[0][1] = *(const f32x4*)(nwp + dlo + 32); w[1][0] = w[0][0]; w[1][1] = w[0][1];
        }
        const int jt = u.pm % 17;
        const bool rope = !ISV && jt != 0;
#pragma unroll
        for (int ai = 0; ai < 2; ++ai)
#pragma unroll
            for (int m = 0; m < 4; ++m) { const int rl = ai * 128 + wr * 64 + m * 16 + fr; bf16_t* rp = base + (size_t)(ai * 128 + m * 16) * 5632; size_t bjs = 128;
                if (!ISV) { if (pn == 16) { rp = Kc + ((size_t)((u.pm / 17) * 2) * 4352 + jt * 256 + rl) * 128 + colw; bjs = (size_t)4352 * 128; } }
                f32x4 cs = {1.f, 1.f, 1.f, 1.f}, sn = {0.f, 0.f, 0.f, 0.f};
                if (!ISV) { if (rope) { const int t = jt * 256 + rl - 256; const int pos = (wc >> 1) ? (t & 63) : (t >> 6); const int fi = pos * 32 + 16 * (wc & 1) + 4 * fq;
                    cs = *(const f32x4*)(ropec + fi); sn = *(const f32x4*)(ropes + fi); } }
#pragma unroll
                for (int bj = 0; bj < 2; ++bj) { const f32x4 pr = *(const PG8_LAS f32x4*)(xch + rl * 8 + bj * 4);
                    const float rstd = __builtin_amdgcn_rsqf(((pr[0] + pr[1]) + (pr[2] + pr[3])) * (1.f / 128.f) + 1e-6f);
                    f32x4 a0 = acc[ai][bj][m][0], a1 = acc[ai][bj][m][1];
                    if (ISV) { asm volatile("" : "+v"(a0), "+v"(a1));
                        a0 = gelu4(a0); a1 = gelu4(a1); }
                    a0 = a0 * rstd * w[bj][0]; a1 = a1 * rstd * w[bj][1];
                    if (!ISV) { const f32x4 o0 = a0 * cs - a1 * sn, o1 = a1 * cs + a0 * sn; a0 = o0; a1 = o1; }
                    store8(rp + bj * bjs, a0, a1); }
                asm volatile("" ::: "memory"); }
    }
};
struct EpiOut {
    static constexpr bool PERM = false, AFTER_DRAIN = false;
    const float* xsrc; const float* csrc; float* xdst; float* cdst; const float* gate;
    __device__ __forceinline__ void operator()(f32x4 (&acc)[2][2][4][2], const Unit& u, int wr, int wc, int fr, int fq) const {
        const int b = u.pm / 17, jt = u.pm % 17;
        const float* src; float* dst; int grow;
        if (jt == 0) { const size_t off = (size_t)(b * 256) * 2048; src = csrc + off; dst = cdst + off; grow = 4; }
        else { const size_t off = (size_t)(b * 4096 + (jt - 1) * 256) * 2048; src = xsrc + off; dst = xdst + off; grow = b; }
        const int col0 = u.pn * 256 + wc * 32 + 4 * fq;
        f32x4 gv[2][2];
#pragma unroll
        for (int bj = 0; bj < 2; ++bj)
#pragma unroll
            for (int n = 0; n < 2; ++n) gv[bj][n] = *(const f32x4*)(gate + grow * 6144 + col0 + bj * 128 + n * 16);
#pragma unroll
        for (int ai = 0; ai < 2; ++ai)
#pragma unroll
            for (int m = 0; m < 4; ++m) { const size_t ro = (size_t)(wr * 64 + fr + ai * 128 + m * 16) * 2048 + col0;
                f32x4 xs[2][2];
#pragma unroll
                for (int bj = 0; bj < 2; ++bj)
#pragma unroll
                    for (int n = 0; n < 2; ++n) xs[bj][n] = *(const f32x4*)(src + ro + bj * 128 + n * 16);
#pragma unroll
                for (int bj = 0; bj < 2; ++bj)
#pragma unroll
                    for (int n = 0; n < 2; ++n) *(f32x4*)(dst + ro + bj * 128 + n * 16) = xs[bj][n] + gv[bj][n] * acc[ai][bj][m][n];
                if (m & 1) asm volatile("" ::: "memory"); }
    }
};
struct SchedX {
    int nM, nN, nwg, G, c, lat, extra, m2; unsigned* cnt;
    __device__ void init(int nM_, int nN_, int G_, int c_, int lat_, int extra_, int m2_ = 0, unsigned* cnt_ = nullptr) { nM = nM_; nN = nN_; nwg = nM_ * nN_; G = G_; c = c_; lat = lat_; extra = extra_; m2 = m2_; cnt = cnt_; }
    __device__ __forceinline__ void map(int wgid0, Unit& u) const {
        int wgid = wgid0; { const int q = nwg / NXCD, r = nwg % NXCD, xcd = wgid % NXCD, off = wgid / NXCD; wgid = (xcd < r ? xcd * (q + 1) : r * (q + 1) + (xcd - r) * q) + off; }
        const int nig = WGM * nN, gid = wgid / nig, fm = gid * WGM, gsz = (nM - fm) < WGM ? (nM - fm) : WGM;
        const int pmq = fm + ((wgid % nig) % gsz); u.pn = (wgid % nig) / gsz;
        u.pm = lat ? (pmq / 16) * 17 + 1 + (pmq % 16) : pmq;
    }
    __device__ bool next(int i, Unit& u) const {
        u.kind = 0;
        if (m2) {
            int ir = i;
            if (c >= 128 && c < 160) { if (i == 0) { const int j = c - 128; u.kind = 1; u.pm = (j >> 3) * 17; u.pn = j & 7; return true; } ir = i - 1; }
            const long L2 = (long)ir * G + c;
            if (L2 < nwg) { map((int)L2, u); return true; }
            if (c >= 160 && c < 168 && ir == 5) { const int j = c - 160, b = j >> 1; unsigned sp = 0;
                while (__hip_atomic_load(cnt + 256 + 64 * b, __ATOMIC_RELAXED, __HIP_MEMORY_SCOPE_AGENT) < 8u && ++sp < (1u << 18)) __builtin_amdgcn_s_sleep(2);
                __builtin_amdgcn_fence(__ATOMIC_ACQUIRE, "agent");
                u.pm = b * 17; u.pn = 16 + (j & 1); return true; }
            return false;
        }
        long L = (long)i * G + c;
        if (L < nwg) { map((int)L, u); return true; }
        L -= nwg; if (L < extra) { u.pm = (int)(L >> 1) * 17; u.pn = 16 + (int)(L & 1); return true; }
        return false;
    }
    __device__ __forceinline__ void a_ready(const Unit&) const {}
    __device__ __forceinline__ void done(const Unit&) const {}
};
template <class Epi, class Sched, bool ALIGN_EPI = false, bool SP2 = false>
__device__ __forceinline__ void gemm_phase(PG8_LAS unsigned char* lds, const Gemm g, const Sched& S, const Epi& E) {
    int tid_ = threadIdx.x; asm volatile("" : "+v"(tid_));
    const int tid = tid_, wid = __builtin_amdgcn_readfirstlane(tid >> 6), lane = tid & 63, wr = wid >> 2, wc = wid & 3, fr = lane & 15, fq = lane >> 4;
    const int K = g.K, nt = K / BK;
    unsigned voffA[2], voffB[2];
#pragma unroll
    for (int i = 0; i < 2; ++i) { int R, C; stage_rc(tid * 16 + i * 8192, R, C); const int Rb = Epi::PERM ? ((R & ~31) + perm32(R & 31)) : R;
        voffA[i] = (unsigned)(R * K + C) * 2u; voffB[i] = (unsigned)(Rb * K + C) * 2u; }
    const size_t kstep = (size_t)(BK * 2);
    const size_t hstep = (size_t)HALF * K * 2;
    const size_t tstep = 2 * hstep;
    const unsigned ldsw = (unsigned)wid * 1024u;
    const int aoff = lds_byte(wr * 64 + fr, fq * 8), boff = lds_byte(wc * 32 + fr, fq * 8);
#define PG8_SA(b, h) (((b) * 2 + (h)) * HTB)
#define PG8_SB(b, h) ((4 + (b) * 2 + (h)) * HTB)
#define PG8_STAGE(bufoff, gbase, voff) do { _Pragma("unroll") for (int _i = 0; _i < 2; ++_i) \
        __builtin_amdgcn_global_load_lds((const unsigned*)((const char*)(gbase) + (voff)[_i]), (PG8_LAS unsigned*)(lds + (bufoff) + ldsw + _i * 8192), 16, 0, 0); } while (0)
#define PG8_LDA(dst, b, h) do { _Pragma("unroll") for (int m = 0; m < 4; ++m) _Pragma("unroll") for (int k = 0; k < 2; ++k) dst[m][k] = *(const PG8_LAS bf16x8*)(lds + PG8_SA(b, h) + aoff + m * 2048 + k * 1024); } while (0)
#define PG8_LDB(dst, b, h) do { _Pragma("unroll") for (int n = 0; n < 2; ++n) _Pragma("unroll") for (int k = 0; k < 2; ++k) dst[n][k] = *(const PG8_LAS bf16x8*)(lds + PG8_SB(b, h) + boff + n * 2048 + k * 1024); } while (0)
#define PG8_MMA(ai, bj, At, Bt) do { __builtin_amdgcn_s_setprio(1); _Pragma("unroll") for (int m = 0; m < 4; ++m) _Pragma("unroll") for (int n = 0; n < 2; ++n) _Pragma("unroll") for (int k = 0; k < 2; ++k) \
        acc[ai][bj][m][n] = __builtin_amdgcn_mfma_f32_16x16x32_bf16(Bt[n][k], At[m][k], acc[ai][bj][m][n], 0, 0, 0); __builtin_amdgcn_s_setprio(0); } while (0)
#define PG8_WAIT_V(n) asm volatile("s_waitcnt vmcnt(" #n ")" ::: "memory")
#define PG8_WAIT_L(n) asm volatile("s_waitcnt lgkmcnt(" #n ")" ::: "memory")
#define PG8_BAR __builtin_amdgcn_s_barrier()
#define PG8_SCHED __builtin_amdgcn_sched_barrier(0)
    Unit cur, nxt; int ui = 0;
    if (!S.next(0, cur)) return;
    f32x4 acc[2][2][4][2];
#pragma unroll
    for (int a = 0; a < 2; ++a)
#pragma unroll
        for (int b = 0; b < 2; ++b)
#pragma unroll
            for (int m = 0; m < 4; ++m)
#pragma unroll
                for (int n = 0; n < 2; ++n) acc[a][b][m][n] = (f32x4){0.f, 0.f, 0.f, 0.f};
    bf16x8 At[4][2], B0[2][2], B1[2][2];
    const char* cA = (const char*)(cur.kind ? g.A2 : g.A) + (size_t)cur.pm * tstep; const char* cB = (const char*)(cur.kind ? g.B2 : g.Bt) + (size_t)cur.pn * tstep;
    S.a_ready(cur);
    if constexpr (SP2) {
        PG8_STAGE(PG8_SB(0, 0), cB, voffB); PG8_STAGE(PG8_SB(0, 1), cB + hstep, voffB); PG8_STAGE(PG8_SA(0, 0), cA, voffA); PG8_STAGE(PG8_SA(0, 1), cA + hstep, voffA);
        if (wr == 1) PG8_BAR;
        PG8_WAIT_V(2); PG8_BAR;
        PG8_STAGE(PG8_SB(1, 0), cB + kstep, voffB); PG8_STAGE(PG8_SA(1, 0), cA + kstep, voffA); PG8_STAGE(PG8_SB(1, 1), cB + hstep + kstep, voffB);
        PG8_WAIT_V(6); PG8_BAR;
    } else {
        PG8_STAGE(PG8_SB(0, 0), cB, voffB); PG8_STAGE(PG8_SA(0, 0), cA, voffA); PG8_STAGE(PG8_SB(0, 1), cB + hstep, voffB); PG8_STAGE(PG8_SA(0, 1), cA + hstep, voffA);
        if (wr == 1) PG8_BAR;
        PG8_WAIT_V(4); PG8_BAR;
        PG8_STAGE(PG8_SB(1, 0), cB + kstep, voffB); PG8_STAGE(PG8_SA(1, 0), cA + kstep, voffA); PG8_STAGE(PG8_SB(1, 1), cB + hstep + kstep, voffB);
        PG8_WAIT_V(6); PG8_BAR;
    }
    for (;;) {
        const bool has_next = S.next(ui + 1, nxt);
        const char* nA = has_next ? (const char*)(nxt.kind ? g.A2 : g.A) + (size_t)nxt.pm * tstep : cA; const char* nB = has_next ? (const char*)(nxt.kind ? g.B2 : g.Bt) + (size_t)nxt.pn * tstep : cB;
        for (int t = 0; t < nt; t += 2) {
            const bool last = (t == nt - 2);
            const char* a1 = cA + (size_t)(t + 1) * kstep;
            const char* a2 = last ? nA : cA + (size_t)(t + 2) * kstep; const char* b2 = last ? nB : cB + (size_t)(t + 2) * kstep;
            const char* a3 = a2 + kstep; const char* b3 = b2 + kstep;
            if (last && has_next) S.a_ready(nxt);
            if constexpr (SP2) {
            PG8_LDB(B0, 0, 0); PG8_LDB(B1, 0, 1); PG8_SCHED; PG8_LDA(At, 0, 0); PG8_STAGE(PG8_SA(1, 1), a1 + hstep, voffA);
            PG8_WAIT_V(8); PG8_WAIT_L(0); PG8_BAR; PG8_MMA(0, 0, At, B0); PG8_MMA(0, 1, At, B1); PG8_BAR; PG8_SCHED;
            PG8_LDA(At, 0, 1); PG8_STAGE(PG8_SB(0, 0), b2, voffB); PG8_STAGE(PG8_SB(0, 1), b2 + hstep, voffB); PG8_STAGE(PG8_SA(0, 0), a2, voffA);
            PG8_WAIT_V(8); PG8_WAIT_L(0); PG8_BAR; PG8_MMA(1, 0, At, B0); PG8_MMA(1, 1, At, B1); PG8_BAR; PG8_SCHED;
            PG8_LDB(B0, 1, 0); PG8_LDB(B1, 1, 1); PG8_SCHED; PG8_LDA(At, 1, 0); PG8_STAGE(PG8_SA(0, 1), a2 + hstep, voffA);
            PG8_WAIT_V(8); PG8_WAIT_L(0); PG8_BAR; PG8_MMA(0, 0, At, B0); PG8_MMA(0, 1, At, B1); PG8_BAR; PG8_SCHED;
            PG8_LDA(At, 1, 1); PG8_STAGE(PG8_SB(1, 0), b3, voffB); PG8_STAGE(PG8_SB(1, 1), b3 + hstep, voffB); PG8_STAGE(PG8_SA(1, 0), a3, voffA);
            PG8_WAIT_V(8); PG8_WAIT_L(0); PG8_BAR; PG8_MMA(1, 0, At, B0); PG8_MMA(1, 1, At, B1); PG8_BAR; PG8_SCHED;
            } else {
            PG8_LDB(B0, 0, 0); PG8_SCHED; PG8_LDA(At, 0, 0); PG8_STAGE(PG8_SA(1, 1), a1 + hstep, voffA);
            PG8_WAIT_L(8); PG8_BAR; PG8_WAIT_L(0); PG8_MMA(0, 0, At, B0); PG8_BAR; PG8_SCHED;
            PG8_LDB(B1, 0, 1); PG8_STAGE(PG8_SB(0, 0), b2, voffB);
            PG8_BAR; PG8_WAIT_L(0); PG8_MMA(0, 1, At, B1); PG8_BAR;
            PG8_LDA(At, 0, 1); PG8_STAGE(PG8_SA(0, 0), a2, voffA);
            PG8_BAR; PG8_WAIT_L(0); PG8_MMA(1, 0, At, B0); PG8_BAR; PG8_SCHED;
            PG8_STAGE(PG8_SB(0, 1), b2 + hstep, voffB);
            PG8_WAIT_V(6); PG8_BAR; PG8_MMA(1, 1, At, B1); PG8_BAR;
            PG8_LDB(B0, 1, 0); PG8_SCHED; PG8_LDA(At, 1, 0); PG8_STAGE(PG8_SA(0, 1), a2 + hstep, voffA);
            PG8_WAIT_L(8); PG8_BAR; PG8_WAIT_L(0); PG8_MMA(0, 0, At, B0); PG8_BAR; PG8_SCHED;
            PG8_LDB(B1, 1, 1); PG8_STAGE(PG8_SB(1, 0), b3, voffB);
            PG8_BAR; PG8_WAIT_L(0); PG8_MMA(0, 1, At, B1); PG8_BAR;
            PG8_LDA(At, 1, 1); PG8_STAGE(PG8_SA(1, 0), a3, voffA);
            PG8_BAR; PG8_WAIT_L(0); PG8_MMA(1, 0, At, B0); PG8_BAR; PG8_SCHED;
            PG8_STAGE(PG8_SB(1, 1), b3 + hstep, voffB);
            PG8_WAIT_V(6); PG8_BAR; PG8_MMA(1, 1, At, B1); PG8_BAR;
            }
        }
        if constexpr (ALIGN_EPI) { if (wr == 0) PG8_BAR; }
        if constexpr (!Epi::AFTER_DRAIN) { int fr_e = fr, fq_e = fq; asm volatile("" : "+v"(fr_e), "+v"(fq_e));
            E(acc, cur, wr, wc, fr_e, fq_e); S.done(cur); }
        if (!has_next) break;
#pragma unroll
        for (int a = 0; a < 2; ++a)
#pragma unroll
            for (int b = 0; b < 2; ++b)
#pragma unroll
                for (int m = 0; m < 4; ++m)
#pragma unroll
                    for (int n = 0; n < 2; ++n) acc[a][b][m][n] = (f32x4){0.f, 0.f, 0.f, 0.f};
        cur = nxt; cA = nA; cB = nB; ++ui;
        if constexpr (ALIGN_EPI) { if (wr == 1) PG8_BAR; }
    }
    PG8_WAIT_V(0);
    if constexpr (!ALIGN_EPI) { if (wr == 0) PG8_BAR; }
    PG8_BAR;
    if constexpr (Epi::AFTER_DRAIN) { E.fused(acc, cur, wr, wc, fr, fq, lds, wid, lane); S.done(cur); }
#undef PG8_SA
#undef PG8_SB
#undef PG8_STAGE
#undef PG8_LDA
#undef PG8_LDB
#undef PG8_MMA
#undef PG8_WAIT_V
#undef PG8_WAIT_L
#undef PG8_BAR
#undef PG8_SCHED
}
}
namespace at {
using bf16 = __hip_bfloat16;
constexpr int   D = 128, NW = 8, QBLK = 32, KVBLK = 64;
constexpr float SCALE = 0.088388347648318440f;
#ifndef ATTN_THR
#define ATTN_THR 8.f
#endif
constexpr float THR = ATTN_THR;
constexpr int SDEPTH = 2;
constexpr int LDQ = 5632, LDK = 128, LDO = 2048;
constexpr size_t SHM_V = KVBLK * D * 2, SHM_K = KVBLK * D * 2, SHM_ATTN = 2 * SHM_V + 2 * SHM_K + NW * 64 * 4;
using f32x4v = __attribute__((ext_vector_type(4))) float;
using bf16x8 = __attribute__((ext_vector_type(8))) short;
using s16x4  = __attribute__((ext_vector_type(4))) short;
using f32x16 = __attribute__((ext_vector_type(16))) float;
using f32x8  = __attribute__((ext_vector_type(8))) float;
using u32x4  = __attribute__((ext_vector_type(4))) unsigned;
#define KSWZ(row, colB) ((row) * 256 + ((colB) ^ (((row) & 7) << 4)))
#define SBAR() __builtin_amdgcn_sched_barrier(0)
__device__ __forceinline__ int crow(int r, int hi) { return (r & 3) + 8 * (r >> 2) + 4 * hi; }
__device__ __forceinline__ unsigned cvtpk(float lo, float hi) {
  unsigned r; asm volatile("v_cvt_pk_bf16_f32 %0, %1, %2" : "=v"(r) : "v"(lo), "v"(hi)); return r;
}
template <typename TIn> struct Stage;
template <> struct Stage<bf16>  { using T = bf16x8;
  __device__ static __forceinline__ T ld8(const bf16* p) { return *reinterpret_cast<const bf16x8*>(p); }
  __device__ static __forceinline__ bf16x8 tobf(T x) { return x; } };
template <> struct Stage<float> { using T = f32x8;
  __device__ static __forceinline__ T ld8(const float* p) { return *reinterpret_cast<const f32x8*>(p); }
  __device__ static __forceinline__ bf16x8 tobf(T x) {
    u32x4 w = {cvtpk(x[0], x[1]), cvtpk(x[2], x[3]), cvtpk(x[4], x[5]), cvtpk(x[6], x[7])}; return *reinterpret_cast<bf16x8*>(&w); } };

__device__ __forceinline__ void partialSM(f32x16& p0, f32x16& p1, float& m_reg, float& mn, float& alpha) {
  constexpr float C = SCALE * 1.4426950408889634f;
  float pmax = p0[0]; for (int r = 1; r < 16; ++r) pmax = fmaxf(pmax, p0[r]); for (int r = 0; r < 16; ++r) pmax = fmaxf(pmax, p1[r]);
  { auto rr = __builtin_amdgcn_permlane32_swap(__float_as_uint(pmax), __float_as_uint(pmax), false, false);
    pmax = fmaxf(__uint_as_float(rr[0]), __uint_as_float(rr[1])); }
  if (__builtin_expect(__all(pmax - m_reg <= THR / SCALE), 1)) { mn = m_reg; alpha = 1.f; }
  else { mn = fmaxf(m_reg, pmax); alpha = __builtin_amdgcn_exp2f((m_reg - mn) * C); m_reg = mn; }
  float mnC = -mn * C;
  for (int r = 0; r < 16; ++r) p0[r] = fmaf(p0[r], C, mnC); for (int r = 0; r < 16; ++r) p1[r] = fmaf(p1[r], C, mnC);
  for (int r = 0; r < 16; ++r) p0[r] = __builtin_amdgcn_exp2f(p0[r]);
}
__device__ __forceinline__ void finishSM(f32x16& p0, f32x16& p1, float alpha, float& l_reg, bf16x8& pa0, bf16x8& pa1, bf16x8& pa2, bf16x8& pa3) {
  for (int r = 0; r < 16; ++r) p1[r] = __builtin_amdgcn_exp2f(p1[r]);
  float ps = 0; for (int r = 0; r < 16; ++r) ps += p0[r]; for (int r = 0; r < 16; ++r) ps += p1[r];
  { auto rr = __builtin_amdgcn_permlane32_swap(__float_as_uint(ps), __float_as_uint(ps), false, false);
    ps = __uint_as_float(rr[0]) + __uint_as_float(rr[1]); }
  l_reg = l_reg * alpha + ps;
#define PK4(P, BASE, OUT) do { unsigned a0 = cvtpk(P[BASE + 0], P[BASE + 1]), a1 = cvtpk(P[BASE + 2], P[BASE + 3]);   \
    unsigned b0 = cvtpk(P[BASE + 4], P[BASE + 5]), b1 = cvtpk(P[BASE + 6], P[BASE + 7]);                              \
    auto r0 = __builtin_amdgcn_permlane32_swap(a0, b0, false, false); auto r1 = __builtin_amdgcn_permlane32_swap(a1, b1, false, false); \
    u32x4 w = {r0[0], r1[0], r0[1], r1[1]}; OUT = *reinterpret_cast<bf16x8*>(&w); } while (0)
  PK4(p0, 0, pa0); PK4(p0, 8, pa1); PK4(p1, 0, pa2); PK4(p1, 8, pa3);
#undef PK4
}
__device__ __forceinline__ void qkt(f32x16& p0, f32x16& p1, const bf16* Ks, const bf16x8* qr, int r32, int hi) {
  p0 = f32x16{}; p1 = f32x16{};
  for (int d0 = 0; d0 < 8; ++d0) { int cb = (d0 * 16 + hi * 8) * 2;
    bf16x8 b0 = *reinterpret_cast<const bf16x8*>((const char*)Ks + KSWZ(r32, cb));
    bf16x8 b1 = *reinterpret_cast<const bf16x8*>((const char*)Ks + KSWZ(32 + r32, cb));
    p0 = __builtin_amdgcn_mfma_f32_32x32x16_bf16(b0, qr[d0], p0, 0, 0, 0);
    p1 = __builtin_amdgcn_mfma_f32_32x32x16_bf16(b1, qr[d0], p1, 0, 0, 0); }
}
__device__ __forceinline__ int v_st(int k, int c) { const int kk = (k & ~0xC) | ((k & 4) << 1) | ((k & 8) >> 1); return ((kk >> 3) * 4 + (c >> 5)) * 512 + ((kk & 7) * 32 + (c & 31)) * 2; }
__device__ __forceinline__ int v_rd_base(int lane) { return ((lane & 3) << 3) | (((lane >> 2) & 3) << 6) | (((lane >> 4) & 1) << 5) | (((lane >> 5) & 1) << 8); }
constexpr int v_rd_off(int d0, int ks, int half) { return d0 * 512 + ks * 4096 + half * 2048; }
template <int OFF> __device__ __forceinline__ s16x4 tr_read(int vb) {
  s16x4 r; asm volatile("ds_read_b64_tr_b16 %0, %1 offset:%2" : "=&v"(r) : "v"(vb), "i"(OFF) : "memory"); return r;
}
template <int D0> __device__ __forceinline__ void pv_one(f32x16& od, int vb, bf16x8 pa0, bf16x8 pa1, bf16x8 pa2, bf16x8 pa3) {
  const s16x4 l0 = tr_read<v_rd_off(D0, 0, 0)>(vb), h0 = tr_read<v_rd_off(D0, 0, 1)>(vb), l1 = tr_read<v_rd_off(D0, 1, 0)>(vb), h1 = tr_read<v_rd_off(D0, 1, 1)>(vb);
  const s16x4 l2 = tr_read<v_rd_off(D0, 2, 0)>(vb), h2 = tr_read<v_rd_off(D0, 2, 1)>(vb), l3 = tr_read<v_rd_off(D0, 3, 0)>(vb), h3 = tr_read<v_rd_off(D0, 3, 1)>(vb);
  asm volatile("s_waitcnt lgkmcnt(0)" ::: "memory"); SBAR();
#define PK(L, H) (bf16x8){L[0], L[1], L[2], L[3], H[0], H[1], H[2], H[3]}
  od = __builtin_amdgcn_mfma_f32_32x32x16_bf16(pa0, PK(l0, h0), od, 0, 0, 0);
  od = __builtin_amdgcn_mfma_f32_32x32x16_bf16(pa1, PK(l1, h1), od, 0, 0, 0);
  od = __builtin_amdgcn_mfma_f32_32x32x16_bf16(pa2, PK(l2, h2), od, 0, 0, 0);
  od = __builtin_amdgcn_mfma_f32_32x32x16_bf16(pa3, PK(l3, h3), od, 0, 0, 0);
#undef PK
}
__device__ __forceinline__ void pv_d0(f32x16* o, int vb, bf16x8 pa0, bf16x8 pa1, bf16x8 pa2, bf16x8 pa3) {
  pv_one<0>(o[0], vb, pa0, pa1, pa2, pa3); pv_one<1>(o[1], vb, pa0, pa1, pa2, pa3); pv_one<2>(o[2], vb, pa0, pa1, pa2, pa3); pv_one<3>(o[3], vb, pa0, pa1, pa2, pa3);
}

__device__ __forceinline__ void attn_dense_body(const bf16* __restrict__ Qb, const bf16* __restrict__ Kh, const bf16* __restrict__ Vh,
                                                const bf16* __restrict__ Zb, bf16* __restrict__ Ob, int seq, char* lds) {
  using TQ = bf16; using St = Stage<bf16>; using SQ = Stage<TQ>;
  int tid_ = threadIdx.x; asm volatile("" : "+v"(tid_));
  const int tid = tid_, wid = tid >> 6, lane = tid & 63, r32 = lane & 31, hi = lane >> 5;
  bf16* V_lds = (bf16*)lds; bf16* K_lds = (bf16*)(lds + 2 * SHM_V);
  float* ws = (float*)(lds + 2 * SHM_V + 2 * SHM_K) + wid * 64; float* li_l = ws; float* al_l = ws + 32;
  float m_reg = -1e30f, l_reg = 0; f32x16 o[4] = {}; bf16x8 qr[8];
  const TQ* Qw = Qb + (long)(wid * QBLK + r32) * LDQ + hi * 8;
#pragma unroll
  for (int d0 = 0; d0 < 8; ++d0) qr[d0] = SQ::tobf(SQ::ld8(Qw + d0 * 16));
  const int sr = tid >> 4, sc = (tid & 15) * 8, vst0 = v_st(sr, sc), vst1 = v_st(32 + sr, sc);
  const int vb0 = (int)(uintptr_t)V_lds + v_rd_base(lane);
  struct { typename St::T vs0, vs1, ks0, ks1; } sr_[SDEPTH];
#define SLOAD(i, k0) do { sr_[i].vs0 = St::ld8(&Vh[(long)((k0) + sr) * LDK + sc]); sr_[i].vs1 = St::ld8(&Vh[(long)((k0) + 32 + sr) * LDK + sc]); \
    sr_[i].ks0 = St::ld8(&Kh[(long)((k0) + sr) * LDK + sc]); sr_[i].ks1 = St::ld8(&Kh[(long)((k0) + 32 + sr) * LDK + sc]); } while (0)
#define SWRITE(b, i) do { *(bf16x8*)((char*)V_lds + (b) * SHM_V + vst0) = St::tobf(sr_[i].vs0);          \
    *(bf16x8*)((char*)V_lds + (b) * SHM_V + vst1) = St::tobf(sr_[i].vs1); int kc = sc * 2;               \
    *(bf16x8*)((char*)K_lds + (b) * SHM_K + KSWZ(sr, kc)) = St::tobf(sr_[i].ks0);                       \
    *(bf16x8*)((char*)K_lds + (b) * SHM_K + KSWZ(32 + sr, kc)) = St::tobf(sr_[i].ks1); } while (0)
#define SWAIT() do { if constexpr (SDEPTH == 2) asm volatile("s_waitcnt vmcnt(4)" ::: "memory"); else asm volatile("s_waitcnt vmcnt(0)" ::: "memory"); } while (0)
#define RESC(a) do { if (__any((a) < 1.f)) { if (hi == 0) al_l[r32] = (a); asm volatile("s_waitcnt lgkmcnt(0)" ::: "memory"); \
    for (int d = 0; d < 4; ++d) for (int r = 0; r < 16; ++r) o[d][r] *= al_l[crow(r, hi)]; } } while (0)
  f32x16 pA0, pA1, pB0, pB1; float mnA, mnB, alA, alB; bf16x8 pa0, pa1, pa2, pa3; const int NT = seq / KVBLK;
  constexpr int SE = 0, SO = SDEPTH - 1;
  SLOAD(SE, 0); asm volatile("s_waitcnt vmcnt(0)" ::: "memory"); SWRITE(0, SE); __syncthreads();
  qkt(pA0, pA1, K_lds, qr, r32, hi); partialSM(pA0, pA1, m_reg, mnA, alA);
  SLOAD(SO, KVBLK); if constexpr (SDEPTH == 2) { if (2 < NT) SLOAD(SE, 2 * KVBLK); }
  SWAIT(); SWRITE(1, SO); __syncthreads();
  for (int j = 1; j + 1 < NT; j += 2) {
    SBAR(); qkt(pB0, pB1, (bf16*)((char*)K_lds + SHM_K), qr, r32, hi);
    finishSM(pA0, pA1, alA, l_reg, pa0, pa1, pa2, pa3); SBAR();
    SLOAD(SO, (j + SDEPTH) * KVBLK); SBAR();
    pv_d0(o, vb0, pa0, pa1, pa2, pa3); partialSM(pB0, pB1, m_reg, mnB, alB);
    __syncthreads(); SWAIT(); SWRITE(0, SE);
    RESC(alB); __syncthreads();
    SBAR(); qkt(pA0, pA1, K_lds, qr, r32, hi);
    finishSM(pB0, pB1, alB, l_reg, pa0, pa1, pa2, pa3); SBAR();
    if (SDEPTH == 1 || j + 3 < NT) SLOAD(SE, (j + 1 + SDEPTH) * KVBLK); SBAR();
    pv_d0(o, vb0 + (int)SHM_V, pa0, pa1, pa2, pa3); partialSM(pA0, pA1, m_reg, mnA, alA);
    __syncthreads(); SWAIT(); SWRITE(1, SO);
    RESC(alA); __syncthreads();
  }
  SBAR(); qkt(pB0, pB1, (bf16*)((char*)K_lds + SHM_K), qr, r32, hi);
  finishSM(pA0, pA1, alA, l_reg, pa0, pa1, pa2, pa3); SBAR();
  pv_d0(o, vb0, pa0, pa1, pa2, pa3); partialSM(pB0, pB1, m_reg, mnB, alB);
  __syncthreads(); RESC(alB);
  finishSM(pB0, pB1, alB, l_reg, pa0, pa1, pa2, pa3); SBAR();
  pv_d0(o, vb0 + (int)SHM_V, pa0, pa1, pa2, pa3);
  if (hi == 0) li_l[r32] = l_reg; asm volatile("s_waitcnt lgkmcnt(0)" ::: "memory");
  float rli[16];
#pragma unroll
  for (int r = 0; r < 16; ++r) rli[r] = __builtin_amdgcn_rcpf(li_l[crow(r, hi)]);
  bf16* Ow = Ob + (long)(wid * QBLK) * LDO; const bf16* Zw = Zb + (long)(wid * QBLK) * LDQ;
  char* stg = lds + (2 * SHM_V + 2 * SHM_K + NW * 64 * 4) + wid * (32 * 272);
#pragma unroll
  for (int r = 0; r < 16; ++r) { const int orow = crow(r, hi);
#pragma unroll
    for (int d0 = 0; d0 < 4; ++d0) *(unsigned short*)(stg + orow * 272 + (d0 * 32 + r32) * 2) = (unsigned short)cvtpk(o[d0][r] * rli[r], 0.f); }
  asm volatile("s_waitcnt lgkmcnt(0)" ::: "memory");
  { const int c8 = (lane & 15) * 8, rq = lane >> 4;
#pragma unroll
    for (int i = 0; i < 8; ++i) { const int row = rq + 4 * i;
      const u32x4 ov = *reinterpret_cast<const u32x4*>(stg + row * 272 + c8 * 2);
      const u32x4 zv = *reinterpret_cast<const u32x4*>(Zw + (long)row * LDQ + c8);
      u32x4 w;
#define OZ(k) cvtpk(__uint_as_float(ov[k] << 16) * __uint_as_float(zv[k] << 16), __uint_as_float(ov[k] & 0xffff0000u) * __uint_as_float(zv[k] & 0xffff0000u))
      w[0] = OZ(0); w[1] = OZ(1); w[2] = OZ(2); w[3] = OZ(3);
#undef OZ
      *reinterpret_cast<u32x4*>(Ow + (long)row * LDO + c8) = w; } }
#undef SLOAD
#undef SWRITE
#undef SWAIT
#undef RESC
}
template <int D0> __device__ __forceinline__ void sgu_one(f32x16& od, int vb, bf16x8 w0, bf16x8 w1, bf16x8 w2, bf16x8 w3) {
  const s16x4 l0 = tr_read<v_rd_off(D0, 0, 0)>(vb), h0 = tr_read<v_rd_off(D0, 0, 1)>(vb), l1 = tr_read<v_rd_off(D0, 1, 0)>(vb), h1 = tr_read<v_rd_off(D0, 1, 1)>(vb);
  const s16x4 l2 = tr_read<v_rd_off(D0, 2, 0)>(vb), h2 = tr_read<v_rd_off(D0, 2, 1)>(vb), l3 = tr_read<v_rd_off(D0, 3, 0)>(vb), h3 = tr_read<v_rd_off(D0, 3, 1)>(vb);
  asm volatile("s_waitcnt lgkmcnt(0)" ::: "memory"); SBAR();
#define PK(L, H) (bf16x8){L[0], L[1], L[2], L[3], H[0], H[1], H[2], H[3]}
  od = __builtin_amdgcn_mfma_f32_32x32x16_bf16(PK(l0, h0), w0, od, 0, 0, 0);
  od = __builtin_amdgcn_mfma_f32_32x32x16_bf16(PK(l1, h1), w1, od, 0, 0, 0);
  od = __builtin_amdgcn_mfma_f32_32x32x16_bf16(PK(l2, h2), w2, od, 0, 0, 0);
  od = __builtin_amdgcn_mfma_f32_32x32x16_bf16(PK(l3, h3), w3, od, 0, 0, 0);
#undef PK
}
__device__ __forceinline__ float bf_lo(unsigned w) { return __uint_as_float(w << 16); }
__device__ __forceinline__ float bf_hi(unsigned w) { return __uint_as_float(w & 0xffff0000u); }
constexpr int SGU_S_OFF = 2 * (int)SHM_V, SGU_S_LD = 132;
struct SguRegs { bf16x8 t00, t01, t10, t11; u32x4 uu[4], zz[4]; };
__device__ __forceinline__ void sgu_load(SguRegs& R, const bf16* __restrict__ Pb, int item, int sr, int sc, int lat) {
  const int ci = item >> 3, g = item & 7; const int chunk = lat ? (ci >> 5) * 34 + 2 + (ci & 31) : ci;     const long R0 = (long)chunk * 128;
  const bf16* vsrc = Pb + R0 * LDQ + 1024 + g * 128 + sc;
  R.t00 = *reinterpret_cast<const bf16x8*>(vsrc + (long)(sr) * LDQ); R.t01 = *reinterpret_cast<const bf16x8*>(vsrc + (long)(32 + sr) * LDQ);
  R.t10 = *reinterpret_cast<const bf16x8*>(vsrc + (long)(64 + sr) * LDQ); R.t11 = *reinterpret_cast<const bf16x8*>(vsrc + (long)(96 + sr) * LDQ);
  const bf16* urow = Pb + (R0 + sr) * LDQ + g * 128 + sc;
#pragma unroll
  for (int k = 0; k < 4; ++k) { R.uu[k] = *reinterpret_cast<const u32x4*>(urow + (long)(32 * k) * LDQ); R.zz[k] = *reinterpret_cast<const u32x4*>(urow + (long)(32 * k) * LDQ + 2048); }
}
__device__ __forceinline__ void sgu_phase(const bf16* __restrict__ Pb, bf16* __restrict__ YC, const bf16* __restrict__ Wf  ,
                                          const float* __restrict__ bsgu  , int first, int stride, int nitems, char* lds, int lat) {
  int tid_ = threadIdx.x; asm volatile("" : "+v"(tid_));
  const int tid = tid_, wid = tid >> 6, lane = tid & 63, r32 = lane & 31, hi = lane >> 5;
  bf16* V_lds = (bf16*)lds; float* S_lds = (float*)(lds + SGU_S_OFF);
  const int sr = tid >> 4, sc = (tid & 15) * 8, vst0 = v_st(sr, sc), vst1 = v_st(32 + sr, sc);
  const int pb = wid & 3, P0 = 32 * pb, DB = 2 * (wid >> 2);
  const int vb = (int)(uintptr_t)V_lds + v_rd_base(lane) + DB * 512;
  if (first >= nitems) return;
  SguRegs C, N;
  sgu_load(C, Pb, first, sr, sc, lat);
  for (int item = first; item < nitems; item += stride) {
    const int ci = item >> 3, g = item & 7; const int chunk = lat ? (ci >> 5) * 34 + 2 + (ci & 31) : ci; const long R0 = (long)chunk * 128;
    *(bf16x8*)((char*)V_lds + vst0) = C.t00; *(bf16x8*)((char*)V_lds + vst1) = C.t01;
    *(bf16x8*)((char*)V_lds + SHM_V + vst0) = C.t10; *(bf16x8*)((char*)V_lds + SHM_V + vst1) = C.t11;
    const bf16x8* wfp = reinterpret_cast<const bf16x8*>(Wf) + ((long)(g * 4 + pb) * 8) * 64 + lane;
    bf16x8 wf[2][4];
#pragma unroll
    for (int T = 0; T < 2; ++T)
#pragma unroll
      for (int s = 0; s < 4; ++s) wf[T][s] = wfp[(T * 4 + s) * 64];
    const bool has_next = item + stride < nitems;
    if (has_next) sgu_load(N, Pb, item + stride, sr, sc, lat);
    __syncthreads();
    f32x16 o0 = {}, o1 = {};
    sgu_one<0>(o0, vb, wf[0][0], wf[0][1], wf[0][2], wf[0][3]); sgu_one<1>(o1, vb, wf[0][0], wf[0][1], wf[0][2], wf[0][3]);
    sgu_one<0>(o0, vb + (int)SHM_V, wf[1][0], wf[1][1], wf[1][2], wf[1][3]); sgu_one<1>(o1, vb + (int)SHM_V, wf[1][0], wf[1][1], wf[1][2], wf[1][3]);
#pragma unroll
    for (int dd = 0; dd < 2; ++dd)
#pragma unroll
      for (int g4 = 0; g4 < 4; ++g4) { const int d = 32 * (DB + dd) + 8 * g4 + 4 * hi; const f32x16& o = dd ? o1 : o0;
        *reinterpret_cast<f32x4v*>(S_lds + (P0 + r32) * SGU_S_LD + d) = (f32x4v){o[4 * g4 + 0], o[4 * g4 + 1], o[4 * g4 + 2], o[4 * g4 + 3]}; }
    __syncthreads();
#pragma unroll
    for (int k = 0; k < 4; ++k) { const int row = sr + 32 * k; const float bias = bsgu[g * 128 + row];
      const f32x4v s0 = *reinterpret_cast<const f32x4v*>(S_lds + row * SGU_S_LD + sc), s1 = *reinterpret_cast<const f32x4v*>(S_lds + row * SGU_S_LD + sc + 4);
      const u32x4 u = C.uu[k], z = C.zz[k]; u32x4 w;
      w.x = cvtpk(bf_lo(u.x) * (s0[0] + bias) * bf_lo(z.x), bf_hi(u.x) * (s0[1] + bias) * bf_hi(z.x));
      w.y = cvtpk(bf_lo(u.y) * (s0[2] + bias) * bf_lo(z.y), bf_hi(u.y) * (s0[3] + bias) * bf_hi(z.y));
      w.z = cvtpk(bf_lo(u.z) * (s1[0] + bias) * bf_lo(z.z), bf_hi(u.z) * (s1[1] + bias) * bf_hi(z.z));
      w.w = cvtpk(bf_lo(u.w) * (s1[2] + bias) * bf_lo(z.w), bf_hi(u.w) * (s1[3] + bias) * bf_hi(z.w));
      *reinterpret_cast<u32x4*>(YC + (R0 + row) * LDO + g * 128 + sc) = w; }
    if (has_next) C = N;
    __syncthreads();
  }
}
}
typedef float f32x4 __attribute__((ext_vector_type(4)));
typedef unsigned v4u __attribute__((ext_vector_type(4)));
typedef unsigned short bf16_t;
#define LDS_WAIT() asm volatile("s_waitcnt lgkmcnt(0)" ::: "memory")
__device__ __forceinline__ unsigned f2bf(float f) { unsigned u = __builtin_bit_cast(unsigned, f); return (u + 0x7fffu + ((u >> 16) & 1u)) >> 16; }
__device__ __forceinline__ unsigned pk2(float lo, float hi) { return f2bf(lo) | (f2bf(hi) << 16); }
__device__ __forceinline__ float wave_sum(float v) {
#pragma unroll
    for (int o = 1; o < 64; o <<= 1) v += __shfl_xor(v, o);
    return v;
}
__device__ __forceinline__ int physrow_in(int c) {
    if (c < C_Q || c >= C_VA) return c;
    const int d = c & 127; const int p = (d & 0x40) | ((d & 0x10) << 1) | ((d & 0xC) << 1) | ((d & 0x20) >> 3) | (d & 3);
    return (c & ~127) | p;
}
__device__ __forceinline__ void p0_transpose_item(const float* W, int K, int N, bf16_t* WT, bool perm, LAS float* scr, int item, int lane) {
    const int nblk = N / 32, kb = item / nblk, nb = item % nblk, k0 = 64 * kb, n0 = 32 * nb;
#pragma unroll 8
    for (int i = 0; i < 32; ++i) { const int kk = 2 * i + (lane >> 5); scr[kk * 33 + (lane & 31)] = W[(size_t)(k0 + kk) * N + n0 + (lane & 31)]; }
    LDS_WAIT(); asm volatile("" ::: "memory");
    const int c = lane & 7;
#pragma unroll
    for (int j = 0; j < 4; ++j) { const int n = (lane >> 3) + 8 * j; const LAS float* s = scr + (8 * c) * 33 + n;
        v4u o; o.x = pk2(s[0 * 33], s[1 * 33]); o.y = pk2(s[2 * 33], s[3 * 33]); o.z = pk2(s[4 * 33], s[5 * 33]); o.w = pk2(s[6 * 33], s[7 * 33]);
        const int rown = perm ? physrow_in(n0 + n) : (n0 + n);
        *(v4u*)(WT + (size_t)rown * K + k0 + 8 * c) = o; }
    LDS_WAIT(); asm volatile("" ::: "memory");
}
__device__ __forceinline__ void p0_prologue(const Args& a, LAS unsigned char* lds, int tid, int lane, int wave, int vcu, int G) {
    float* mod = (float*)(a.ws + WS_MOD);
    {
        LAS float* sl = (LAS float*)lds; LAS float* red = (LAS float*)(lds + 40960);
        for (int i = tid; i < 5 * 2048; i += 512) { const float v = (i < 4 * 2048) ? a.in[1][i] : a.in[3][i - 4 * 2048]; sl[i] = v / (1.f + __expf(-v)); }
        __syncthreads();
        const int cgp = tid % 12, kl = tid / 12;
        for (int item = vcu; item < 256; item += G) {
            const int l = item >> 7, j0 = (item & 127) * 48;
            if (kl < 42) {
                f32x4 acc[5];
#pragma unroll
                for (int r = 0; r < 5; ++r) acc[r] = (f32x4){0.f, 0.f, 0.f, 0.f};
                const float* wp = a.in[5] + (size_t)l * 2048 * 6144 + j0 + cgp * 4;
#pragma unroll 4
                for (int k = kl; k < 2048; k += 42) { const f32x4 w = *(const f32x4*)(wp + (size_t)k * 6144);
#pragma unroll
                    for (int r = 0; r < 5; ++r) acc[r] += sl[r * 2048 + k] * w; }
#pragma unroll
                for (int r = 0; r < 5; ++r) *(LAS f32x4*)(red + (kl * 5 + r) * 48 + cgp * 4) = acc[r];
            }
            __syncthreads();
            if (tid < 240) { const int r = tid / 48, c = tid % 48; float s = 0.f;
                for (int q = 0; q < 42; ++q) s += red[(q * 5 + r) * 48 + c];
                mod[(l * 5 + r) * 6144 + j0 + c] = s + a.in[6][l * 6144 + j0 + c]; }
            __syncthreads();
        }
    }
    if (vcu == G - 1) {
        float* rc = (float*)(a.ws + WS_ROPE); float* rs = rc + 2048;
        for (int idx = tid; idx < 2048; idx += 512) { const int pos = idx >> 5, i = idx & 31;
            const float inv = exp2f(-(float)(2 * i) * (1.f / 64.f) * 13.287712379549449f);
            const float ang = (float)pos * inv; rc[idx] = cosf(ang); rs[idx] = sinf(ang); }
    }
    {
        v4u* Wf = (v4u*)(a.ws + WS_WSGU);
        for (int idx = vcu * 512 + tid; idx < 2 * 8 * 4 * 8 * 64; idx += G * 512) { const int ln = idx & 63, ts = (idx >> 6) & 7, pbb = (idx >> 9) & 3, lg = idx >> 11;
            const float* q = a.in[8] + ((size_t)lg * 128 + 32 * pbb + (ln & 31)) * 128 + 16 * ts + 8 * (ln >> 5);
            const f32x4 lo = *(const f32x4*)q, hh = *(const f32x4*)(q + 4);
            v4u o; o.x = pk2(lo[0], lo[1]); o.y = pk2(lo[2], lo[3]); o.z = pk2(hh[0], hh[1]); o.w = pk2(hh[2], hh[3]); Wf[idx] = o; }
    }
    {
        LAS float* scr = (LAS float*)(lds + wave * 16384);
        const int gw = vcu * 8 + wave, NGW = G * 8;
        bf16_t* WinT = (bf16_t*)(a.ws + WS_WIN); bf16_t* WoutT = (bf16_t*)(a.ws + WS_WOUT);
        constexpr int I_IN = 32 * (DIN / 32), I_OUT = 32 * (DM / 32), I_L = I_IN + I_OUT;
        for (int it = gw; it < 2 * I_L; it += NGW) { const int l = it / I_L; const int r = it - l * I_L;
            if (r < I_IN) p0_transpose_item(a.in[7] + (size_t)l * DM * DIN, DM, DIN, WinT + (size_t)l * DIN * DM, true, scr, r, lane);
            else p0_transpose_item(a.in[13] + (size_t)l * DM * DM, DM, DM, WoutT + (size_t)l * DM * DM, false, scr, r - I_IN, lane); }
    }
}
__device__ __forceinline__ void pA_norm(const Args& a, int l, int gw, int NGW, int lane_) {
    int lane = lane_; asm volatile("" : "+v"(lane));
    const float* mod = (const float*)(a.ws + WS_MOD) + (size_t)l * 5 * 6144;
    const float* nw = a.in[4] + l * DM;
    const float* xc1 = (const float*)(a.ws + WS_XC1);
    bf16_t* H = (bf16_t*)(a.ws + WS_H);
    const int rpw = (MROWS + NGW - 1) / NGW;
    const int R0 = gw * rpw, R1 = (R0 + rpw < MROWS) ? R0 + rpw : MROWS;
    int cur = -1; f32x4 g[8], sh[8];
    for (int R = R0; R < R1; ++R) {
        const int b = R / RPB, rb = R - b * RPB; const bool isctx = rb < CTX; const int rm = isctx ? 4 : b;
        if (l == 1 && isctx && NGW == 2048) continue;
        const float* src = (l == 0) ? (isctx ? a.in[2] + (size_t)(b * CTX + rb) * DM : a.in[0] + (size_t)(b * SEQ + rb - CTX) * DM)
                                    : (isctx ? xc1 + (size_t)(b * CTX + rb) * DM : a.out + (size_t)(b * SEQ + rb - CTX) * DM);
        if (rm != cur) { cur = rm;
#pragma unroll
            for (int j = 0; j < 8; ++j) { const int c = 4 * lane + 256 * j; const f32x4 w = *(const f32x4*)(nw + c), sc = *(const f32x4*)(mod + rm * 6144 + 2048 + c);
                g[j] = w * (1.f + sc); sh[j] = *(const f32x4*)(mod + rm * 6144 + c); } }
        f32x4 v[8]; float s = 0.f;
#pragma unroll
        for (int j = 0; j < 8; ++j) { v[j] = *(const f32x4*)(src + 4 * lane + 256 * j); s += (v[j][0] * v[j][0] + v[j][1] * v[j][1]) + (v[j][2] * v[j][2] + v[j][3] * v[j][3]); }
        const float rstd = 1.f / sqrtf(wave_sum(s) * (1.f / DM) + EPS);
        unsigned long long* o8 = (unsigned long long*)(H + (size_t)R * DM) + lane;
#pragma unroll
        for (int j = 0; j < 8; ++j) { const f32x4 y = v[j] * rstd * g[j] + sh[j]; o8[64 * j] = (unsigned long long)pk2(y[0], y[1]) | ((unsigned long long)pk2(y[2], y[3]) << 32); }
    }
}

#define RLX_AGENT __ATOMIC_RELAXED, __HIP_MEMORY_SCOPE_AGENT
#define XB_TMO      128
#define XB_XCNT(j)  (256  + 64 * (j))
#define XB_XSUB(j)  (1280 + 64 * (j))
#define XB_XGEN(j)  (2304 + 64 * (j))
#define XB_TOP      3328
#define XB_TOPGEN   3392
#define XCD_BAR_WORDS 3456
#define XB_SPIN_CAP (1u << 18)

__device__ __forceinline__ unsigned xb_ld(unsigned* p)              { return __hip_atomic_load(p, __ATOMIC_RELAXED, __HIP_MEMORY_SCOPE_AGENT); }
__device__ __forceinline__ unsigned xb_add(unsigned* p, unsigned v) { return __hip_atomic_fetch_add(p, v, __ATOMIC_RELAXED, __HIP_MEMORY_SCOPE_AGENT); }
__device__ __forceinline__ unsigned xb_xcc_id() { return (unsigned)__builtin_amdgcn_s_getreg((3 << 11) | 20) & 0xFu; }
#define XB_SPIN(cond, bar) do { unsigned _sp = 0; while (cond) { __builtin_amdgcn_s_sleep(1); \
    if ((++_sp & 255u) == 0u) { if (xb_ld(&(bar)[XB_TMO])) break; if (_sp > XB_SPIN_CAP) { atomicAdd(&(bar)[XB_TMO], 1u); break; } } } } while (0)

struct XcdBarrier {
    unsigned* bar; unsigned x;
    volatile LAS unsigned* st;
};

__device__ __forceinline__ XcdBarrier xcd_barrier_post(unsigned* bar, volatile LAS unsigned* st) {
    XcdBarrier b; b.bar = bar; b.x = xb_xcc_id(); b.st = st;
    if (threadIdx.x == 0) (void)xb_add(&bar[XB_XCNT(b.x)], 1u);
    return b;
}
__device__ __forceinline__ void xcd_barrier_complete(unsigned* bar, unsigned x, unsigned& nloc, unsigned& nx) {
    const unsigned G = gridDim.x * gridDim.y * gridDim.z;
    unsigned sum, cnt, mine, sp = 0u;
    for (;;) {
        sum = 0u; cnt = 0u; mine = 0u;
#pragma unroll
        for (unsigned j = 0; j < 16; ++j) { const unsigned c = xb_ld(&bar[XB_XCNT(j)]); sum += c; cnt += (c > 0u) ? 1u : 0u; mine = (j == x) ? c : mine; }
        if (sum == G) break;
        __builtin_amdgcn_s_sleep(1);
        if ((++sp & 255u) == 0u) { if (xb_ld(&bar[XB_TMO])) break; if (sp > XB_SPIN_CAP) { atomicAdd(&bar[XB_TMO], 1u); break; } }
    }
    nloc = mine > 0u ? mine : 1u; nx = cnt > 0u ? cnt : 1u;
}

__device__ __forceinline__ void xcd_barrier(const XcdBarrier& b) {
    asm volatile("s_waitcnt vmcnt(0)" ::: "memory");
    __syncthreads();
    if (threadIdx.x == 0) {
        unsigned* bar = b.bar;
        __builtin_amdgcn_s_waitcnt(0);
        unsigned nloc = b.st[0], nx = b.st[1];
        if (nloc == 0u) { xcd_barrier_complete(bar, b.x, nloc, nx); b.st[0] = nloc; b.st[1] = nx; }
        const unsigned old = xb_add(&bar[XB_XSUB(b.x)], 1u);
        const unsigned gen = old / nloc;
        if (old + 1u == (gen + 1u) * nloc) {
            __builtin_amdgcn_fence(__ATOMIC_RELEASE, "agent");
            asm volatile("s_waitcnt vmcnt(0)" ::: "memory");
            const unsigned og = xb_add(&bar[XB_TOP], 1u);
            const unsigned tg = og / nx;
            if (og + 1u == (tg + 1u) * nx) xb_add(&bar[XB_TOPGEN], 1u);
            else XB_SPIN(xb_ld(&bar[XB_TOPGEN]) == tg, bar);
            __builtin_amdgcn_fence(__ATOMIC_ACQUIRE, "agent");
            xb_add(&bar[XB_XGEN(b.x)], 1u);
            asm volatile("s_waitcnt vmcnt(0)" ::: "memory");
        } else {
            XB_SPIN(xb_ld(&bar[XB_XGEN(b.x)]) == gen, bar);
            __builtin_amdgcn_fence(__ATOMIC_ACQUIRE, "agent");
            asm volatile("s_waitcnt vmcnt(0)" ::: "memory");
        }
    }
    __syncthreads();
}

__global__ void __launch_bounds__(512, 2) mk_fwd(Args a) {
    extern __shared__ __attribute__((aligned(16))) unsigned char lds[];
    cg::grid_group grid = cg::this_grid();
    LAS unsigned char* L = (LAS unsigned char*)lds;
    const int tid = threadIdx.x, lane = tid & 63, wave = __builtin_amdgcn_readfirstlane(tid >> 6);
    const int G = gridDim.x, bx = blockIdx.x; const int vcu = (G % 8 == 0) ? (bx % 8) * (G / 8) + bx / 8 : bx;
    const int lo = a.ph_lo, hi = a.ph_hi;
#define IN(k) (lo <= (k) && (k) < hi)
#define SEAM(k) do { if (IN(k) && IN((k) + 1)) { if (a.coop == 2) grid.sync(); else xcd_barrier(xbar); } } while (0)
    volatile LAS unsigned* xst = (volatile LAS unsigned*)(L + XCH_OFF + 8192);
    if (tid < 2) xst[tid] = 0u;
    __syncthreads();
    XcdBarrier xbar; xbar.bar = (unsigned*)(a.ws + WS_BAR); xbar.x = 0; xbar.st = xst;
    if (a.coop) xbar = xcd_barrier_post((unsigned*)(a.ws + WS_BAR), xst);

    bf16_t* Hb = (bf16_t*)(a.ws + WS_H); bf16_t* Pb = (bf16_t*)(a.ws + WS_P);
    if (IN(0)) { p0_prologue(a, L, tid, lane, wave, vcu, G); }
    SEAM(0);
#pragma nounroll
    for (int l = 0; l < 2; ++l) {
        const int pb = 1 + 4 * l;
        if (IN(pb)) { pA_norm(a, l, vcu * 8 + wave, G * 8, lane); }
        SEAM(pb);
        if (IN(pb + 1)) {
            const int m2 = (G == 256) ? 1 : 0;
            pg8::Gemm g{Hb, (const bf16_t*)(a.ws + WS_WIN) + (size_t)l * DIN * DM, MROWS, DIN, DM, Hb, (const bf16_t*)(a.ws + WS_WOUT)};
            pg8::SchedX S; if (l == 0) S.init(68, 22, G, bx, 0, 0); else S.init(64, 22, G, bx, 1, m2 ? 0 : 8, m2, (unsigned*)(a.ws + WS_BAR) + 3584);
            pg8::EpiIn E{Pb, a.in[10] + l * 1024, a.in[11] + l * 128, a.in[12] + l * 128, (const float*)(a.ws + WS_ROPE), (const float*)(a.ws + WS_ROPE) + 2048, (LAS float*)(L + XCH_OFF), (bf16_t*)(a.ws + WS_KC), (bf16_t*)(a.ws + WS_VC),
                         a.in[2], (const float*)(a.ws + WS_MOD) + 4 * 6144 + 4096, (float*)(a.ws + WS_XC1), a.in[4] + DM, (const float*)(a.ws + WS_MOD) + (5 + 4) * 6144, Hb, (unsigned*)(a.ws + WS_BAR) + 3584};
            pg8::gemm_phase<pg8::EpiIn, pg8::SchedX, true, true>(L, g, S, E);
        }
        SEAM(pb + 1);
        if (IN(pb + 2)) {
            const at::bf16* P = (const at::bf16*)Pb; at::bf16* YC = (at::bf16*)Hb;
#pragma nounroll
            for (int st = 0; st < 2; ++st) {
            const bool do_sgu = (((st ^ vcu) & 1) == 0);
            if (do_sgu) { if (a.sub & 1)
            at::sgu_phase(P, YC, (const at::bf16*)(a.ws + WS_WSGU) + (size_t)l * 8 * 128 * 128, a.in[9] + l * 8 * 128, vcu, G, l == 0 ? 136 * 8 : 128 * 8, (char*)lds, l); }
            else {
            const int ntot = (a.sub & 2) ? 512 + (l == 0 ? 32 : 0) : 0;
            for (int i = 0;; ++i) { int Li = i * G + vcu; if (Li >= 512) Li -= 64;
                if (Li >= ntot || (i >= 2 && Li < 512)) break;
                int b, h, qrow, seq;
                if (Li < 512) { const int qb = Li & 15; h = (Li >> 4) & 7; b = Li >> 7; qrow = b * RPB + CTX + qb * 256; seq = RPB; }
                else { const int c = Li - 512; b = c >> 3; h = c & 7; qrow = b * RPB; seq = CTX; }
                const long krow = (long)b * RPB; const int kvh = h >> 2;
                const long kvo = ((long)(b * 2 + kvh) * RPB) * 128;
                at::attn_dense_body(P + (long)qrow * DIN + C_Q + h * 128, (const at::bf16*)(a.ws + WS_KC) + kvo, (const at::bf16*)(a.ws + WS_VC) + kvo,
                                    P + (long)qrow * DIN + C_ZB + h * 128, YC + (long)qrow * DM + 1024 + h * 128, seq, (char*)lds);
                __syncthreads(); } }
            __syncthreads(); }
        }
        SEAM(pb + 2);
        if (IN(pb + 3)) {
            pg8::Gemm g{Hb, (const bf16_t*)(a.ws + WS_WOUT) + (size_t)l * DM * DM, MROWS, DM, DM};
            pg8::SchedX S; if (l == 0 && G != 256) S.init(68, 8, G, bx, 0, 0); else S.init(64, 8, G, bx, 1, 0);
            pg8::EpiOut E{l == 0 ? a.in[0] : a.out, a.in[2], a.out, (float*)(a.ws + WS_XC1), (const float*)(a.ws + WS_MOD) + (size_t)l * 5 * 6144 + 4096};
            pg8::gemm_phase<pg8::EpiOut, pg8::SchedX, false, true>(L, g, S, E);
        }
        SEAM(pb + 3);
    }
#undef IN
#undef SEAM
}

extern "C" void kernel_launch(void* const* d_in, const int* in_sizes, int n_in, void* d_out, int out_size, void* d_ws, size_t ws_size, hipStream_t stream) {
    static int grid = 0;
    if (grid == 0) {
        if (n_in != 14 || in_sizes[0] != NB * SEQ * DM || out_size != NB * SEQ * DM || ws_size < WS_END) {
            fprintf(stderr, "kernel_launch: shape mismatch (n_in %d, in0 %d, out %d, ws %zu; need ws >= %zu); nothing launched\n", n_in, n_in > 0 ? in_sizes[0] : -1, out_size, ws_size, (size_t)WS_END); grid = -1; return; }
        int dev = 0, cus = 0, per_cu = 0;
        if (hipGetDevice(&dev) != hipSuccess || hipDeviceGetAttribute(&cus, hipDeviceAttributeMultiprocessorCount, dev) != hipSuccess) { fprintf(stderr, "kernel_launch: device query failed\n"); grid = -1; return; }
        if (hipFuncSetAttribute((const void*)mk_fwd, hipFuncAttributeMaxDynamicSharedMemorySize, LDS_BYTES) != hipSuccess) { fprintf(stderr, "kernel_launch: hipFuncSetAttribute failed\n"); grid = -1; return; }
        if (hipOccupancyMaxActiveBlocksPerMultiprocessor(&per_cu, (const void*)mk_fwd, 512, LDS_BYTES) != hipSuccess || per_cu < 1) { fprintf(stderr, "kernel_launch: occupancy query says %d blocks per CU\n", per_cu); per_cu = 1; }
        (void)hipGetLastError();
        grid = cus * 1;
    }
    if (grid < 0) return;
    Args a{};
    for (int i = 0; i < 14; ++i) a.in[i] = (const float*)d_in[i];
    a.out = (float*)d_out; a.ws = (unsigned char*)d_ws; a.sub = 3;
#if MK_MULTI
    for (int ph = 0; ph < NPHASE; ++ph) { a.ph_lo = ph; a.ph_hi = ph + 1; a.coop = 0;
        hipLaunchKernelGGL(mk_fwd, dim3(grid), dim3(512), LDS_BYTES, stream, a);
        const hipError_t le = hipPeekAtLastError(); if (le != hipSuccess) { fprintf(stderr, "kernel_launch: launch %d failed: %s\n", ph, hipGetErrorName(le)); break; }
#ifdef PROBE_PH
        if ((PROBE_PH >> ph) & 1) { a.sub = PROBE_SUB; hipLaunchKernelGGL(mk_fwd, dim3(grid), dim3(512), LDS_BYTES, stream, a); a.sub = 3; }
#endif
    }
#else
    a.ph_lo = 0; a.ph_hi = NPHASE; a.coop = 1;
    if (hipMemsetAsync((char*)d_ws + WS_BAR, 0, 16384, stream) != hipSuccess) { fprintf(stderr, "kernel_launch: hipMemsetAsync of the barrier words failed\n"); return; }
    void* args[] = {&a};
    const hipError_t e = hipLaunchCooperativeKernel((const void*)mk_fwd, dim3(grid), dim3(512), args, LDS_BYTES, stream);
    if (e != hipSuccess) fprintf(stderr, "kernel_launch: cooperative launch failed: %s (grid %d)\n", hipGetErrorString(e), grid);
#endif
}
```

```cpp
#include <hip/hip_runtime.h>
#include <hip/hip_cooperative_groups.h>
#include <hip/hip_bf16.h>
#include <cstdio>
#include <cstdint>
namespace cg = cooperative_groups;

#ifndef MK_MULTI
#define MK_MULTI 0
#endif

constexpr int DM = 2048, NB = 4, SEQ = 4096, CTX = 256, RPB = CTX + SEQ, MROWS = NB * RPB, DIN = 5632;
constexpr int C_U = 0, C_V = 1024, C_ZA = 2048, C_Q = 3072, C_K = 4096, C_VA = 4352, C_ZB = 4608;
constexpr int TPB = RPB / 256;
constexpr float EPS = 1e-6f;
constexpr int NPHASE = 9;
constexpr size_t MiB = 1u << 20;
constexpr size_t WS_MOD = 0;
constexpr size_t WS_ROPE = 1 * MiB;
constexpr size_t WS_WSGU = 2 * MiB;
constexpr size_t WS_BAR = 3 * MiB;
constexpr size_t WS_XC1 = 4 * MiB;
constexpr size_t WS_WIN = 16 * MiB;
constexpr size_t WS_WOUT = 64 * MiB;
constexpr size_t WS_H = 80 * MiB;
constexpr size_t WS_P = 160 * MiB;
constexpr size_t WS_KC = 352 * MiB;
constexpr size_t WS_VC = 368 * MiB;
constexpr size_t WS_END = 384 * MiB;
constexpr int LDS_BYTES = 147456;
constexpr int XCH_OFF = 131072;

struct Args { const float* in[14]; float* out; unsigned char* ws; int ph_lo, ph_hi, coop, sub; };
#define LAS __attribute__((address_space(3)))
namespace pg8 {
#define PG8_LAS __attribute__((address_space(3)))
typedef unsigned short bf16_t;
typedef short bf16x8 __attribute__((ext_vector_type(8)));
typedef float f32x4 __attribute__((ext_vector_type(4)));
typedef unsigned u32x4 __attribute__((ext_vector_type(4)));
constexpr int BM = 256, BK = 64, HALF = 128, HTB = HALF * BK * 2  , STAGE_BYTES = 8 * HTB, NXCD = 8, WGM = 8;

__host__ __device__ __forceinline__ int lds_byte(int r, int c) { const int st = (r >> 4) * 2 + (c >> 5), rr = r & 15, cc = c & 31, ob = rr * 64 + cc * 2; return st * 1024 + (ob ^ (((ob >> 9) & 1) << 5)); }
__host__ __device__ __forceinline__ void stage_rc(int b, int& R, int& C) { const int st = b / 1024, sb = b % 1024, swz = sb ^ (((sb >> 9) & 1) << 5); R = (st >> 1) * 16 + swz / 64; C = (st & 1) * 32 + (swz % 64) / 2; }
__host__ __device__ __forceinline__ int perm32(int rho) { const int n = rho >> 4, i = rho & 15; return 8 * (i >> 2) + 4 * n + (i & 3); }

struct Unit { int pm, pn, kind; };
struct Gemm { const bf16_t* A; const bf16_t* Bt; int M, N, K; const bf16_t* A2; const bf16_t* B2; };

struct StaticOrder {
    int nM, nN, nwg, G, c;
    __host__ __device__ void init(int M, int N, int G_, int c_) { nM = M / BM; nN = N / BM; nwg = nM * nN; G = G_; c = c_; }
    __host__ __device__ bool next(int i, Unit& u) const {
        const long L = (long)i * G + c; if (L >= nwg) return false;
        int wgid = (int)L; { const int q = nwg / NXCD, r = nwg % NXCD, xcd = wgid % NXCD, off = wgid / NXCD; wgid = (xcd < r ? xcd * (q + 1) : r * (q + 1) + (xcd - r) * q) + off; }
        const int nig = WGM * nN, gid = wgid / nig, fm = gid * WGM, gsz = (nM - fm) < WGM ? (nM - fm) : WGM;
        u.pm = fm + ((wgid % nig) % gsz); u.pn = (wgid % nig) / gsz; return true;
    }
    __device__ __forceinline__ void a_ready(const Unit&) const {}
    __device__ __forceinline__ void done(const Unit&) const {}
};

__device__ __forceinline__ unsigned cvt_pk_bf16(float lo, float hi) { unsigned r; asm volatile("v_cvt_pk_bf16_f32 %0, %1, %2" : "=v"(r) : "v"(lo), "v"(hi)); return r; }
typedef float f32x2 __attribute__((ext_vector_type(2)));
__device__ __forceinline__ f32x4 gelu4(f32x4 x) {
    f32x4 o;
#pragma unroll
    for (int i = 0; i < 4; ++i) { const float v = x[i], t = v * (1.f + 0.044715f * v * v); const float e = __builtin_amdgcn_exp2f(-2.3022081981f * t); o[i] = v * __builtin_amdgcn_rcpf(1.f + e); }
    return o;
}
__device__ __forceinline__ f32x4 silu4(f32x4 x) {
    f32x4 o;
#pragma unroll
    for (int i = 0; i < 4; ++i) { const float v = x[i]; const float e = __builtin_amdgcn_exp2f(-1.4426950409f * v); o[i] = v * __builtin_amdgcn_rcpf(1.f + e); }
    return o;
}
__device__ __forceinline__ void store8(bf16_t* p, f32x4 v0, f32x4 v1) {
    u32x4 w; w.x = cvt_pk_bf16(v0[0], v0[1]); w.y = cvt_pk_bf16(v0[2], v0[3]); w.z = cvt_pk_bf16(v1[0], v1[1]); w.w = cvt_pk_bf16(v1[2], v1[3]); *(u32x4*)p = w;
}
struct EpiIn {
    static constexpr bool PERM = true, AFTER_DRAIN = false;
    bf16_t* P; const float* vnw; const float* qnw; const float* knw; const float* ropec; const float* ropes; PG8_LAS float* xch; bf16_t* Kc; bf16_t* Vc;
    const float* cx_in; const float* cx_gate; float* xc1; const float* nrm_w; const float* nrm_mod; bf16_t* Hout; unsigned* cnt;
    __device__ __forceinline__ void operator()(f32x4 (&acc)[2][2][4][2], const Unit& u, int wr, int wc, int fr, int fq) const {
        if (u.kind == 1) { ctx_out(acc, u, wr, wc, fr, fq); return; }
        const int pn = u.pn;
        const int colw = wc * 32 + 8 * fq;
        bf16_t* base = P + (size_t)(u.pm * 256 + wr * 64 + fr) * 5632 + pn * 256 + colw;
        if (pn == 17) {
            const int b = u.pm / 17, rb = (u.pm % 17) * 256 + wr * 64 + fr;
            bf16_t* vb_ = Vc + ((size_t)(b * 2) * 4352 + rb) * 128 + colw;
#pragma unroll
            for (int ai = 0; ai < 2; ++ai)
#pragma unroll
                for (int m = 0; m < 4; ++m)
#pragma unroll
                    for (int bj = 0; bj < 2; ++bj) store8(vb_ + ((size_t)bj * 4352 + ai * 128 + m * 16) * 128, acc[ai][bj][m][0], acc[ai][bj][m][1]);
            return;
        }
        if (pn < 4 || (pn >= 8 && pn < 12) || pn >= 17) {
            const int act = pn < 4 ? 0 : (pn == 17 ? 2 : 1);
#pragma unroll
            for (int ai = 0; ai < 2; ++ai)
#pragma unroll
                for (int m = 0; m < 4; ++m) { bf16_t* rp = base + (size_t)(ai * 128 + m * 16) * 5632;
#pragma unroll
                    for (int bj = 0; bj < 2; ++bj) { f32x4 v0 = acc[ai][bj][m][0], v1 = acc[ai][bj][m][1];
                        if (act == 0) { v0 = gelu4(v0); v1 = gelu4(v1); } else if (act == 1) { v0 = silu4(v0); v1 = silu4(v1); }
                        store8(rp + bj * 128, v0, v1); } }
            return;
        }
        if (pn < 8) gn_path<true>(acc, u, wr, wc, fr, fq, base, colw); else gn_path<false>(acc, u, wr, wc, fr, fq, base, colw);
    }
    __device__ __forceinline__ void ctx_out(const f32x4 (&acc)[2][2][4][2], const Unit& u, int wr, int wc, int fr, int fq) const {
        const int b = u.pm / 17;
        const int col0 = u.pn * 256 + wc * 32 + 8 * fq;
        f32x4 gv[2][2];
#pragma unroll
        for (int bj = 0; bj < 2; ++bj)
#pragma unroll
            for (int n = 0; n < 2; ++n) gv[bj][n] = *(const f32x4*)(cx_gate + col0 + bj * 128 + 4 * n);
        const size_t rbase = (size_t)(b * 256 + wr * 64 + fr) * 2048 + col0;
#pragma unroll
        for (int ai = 0; ai < 2; ++ai)
#pragma unroll
            for (int m = 0; m < 4; ++m) { const size_t ro = rbase + (size_t)(ai * 128 + m * 16) * 2048;
                f32x4 xs[2][2];
#pragma unroll
                for (int bj = 0; bj < 2; ++bj)
#pragma unroll
                    for (int n = 0; n < 2; ++n) xs[bj][n] = *(const f32x4*)(cx_in + ro + bj * 128 + 4 * n);
#pragma unroll
                for (int bj = 0; bj < 2; ++bj)
#pragma unroll
                    for (int n = 0; n < 2; ++n) { const f32x4 o = xs[bj][n] + gv[bj][n] * acc[ai][bj][m][n]; float* dp = xc1 + ro + bj * 128 + 4 * n;
                        asm volatile("global_store_dwordx4 %0, %1, off sc1\n\ts_nop 1" :: "v"(dp), "v"(o) : "memory"); }
                if (m & 1) asm volatile("" ::: "memory"); }
        const bool t0 = (wr == 0 && wc == 0 && fr == 0 && fq == 0);
        asm volatile("s_waitcnt vmcnt(0)" ::: "memory"); __builtin_amdgcn_s_barrier(); asm volatile("" ::: "memory");
        if (t0) { __hip_atomic_fetch_add(cnt + 64 * b, 1u, __ATOMIC_RELAXED, __HIP_MEMORY_SCOPE_AGENT);
            unsigned sp = 0; while (__hip_atomic_load(cnt + 64 * b, __ATOMIC_RELAXED, __HIP_MEMORY_SCOPE_AGENT) < 8u && ++sp < (1u << 18)) __builtin_amdgcn_s_sleep(2);
            __builtin_amdgcn_fence(__ATOMIC_ACQUIRE, "agent"); asm volatile("s_waitcnt vmcnt(0)" ::: "memory"); }
        __builtin_amdgcn_s_barrier(); asm volatile("" ::: "memory");
        { const int w8 = wr * 4 + wc, lane = fr + 16 * fq;
          f32x4 g[8], sh[8];
#pragma unroll
          for (int j = 0; j < 8; ++j) { const int c = 4 * lane + 256 * j; const f32x4 w = *(const f32x4*)(nrm_w + c), sc = *(const f32x4*)(nrm_mod + 2048 + c); g[j] = w * (1.f + sc); sh[j] = *(const f32x4*)(nrm_mod + c); }
          for (int rr = 0; rr < 4; ++rr) { const int rb = u.pn * 32 + w8 * 4 + rr;
              const float* src = xc1 + (size_t)(b * 256 + rb) * 2048;
              f32x4 v[8]; float ss = 0.f;
#pragma unroll
              for (int j = 0; j < 8; ++j) { v[j] = *(const f32x4*)(src + 4 * lane + 256 * j); ss += (v[j][0] * v[j][0] + v[j][1] * v[j][1]) + (v[j][2] * v[j][2] + v[j][3] * v[j][3]); }
#pragma unroll
              for (int o = 1; o < 64; o <<= 1) ss += __shfl_xor(ss, o);
              const float rstd = 1.f / sqrtf(ss * (1.f / 2048.f) + 1e-6f);
              unsigned long long* o8 = (unsigned long long*)(Hout + (size_t)(b * 4352 + rb) * 2048) + lane;
#pragma unroll
              for (int j = 0; j < 8; ++j) { const f32x4 y = v[j] * rstd * g[j] + sh[j]; __hip_atomic_store(o8 + 64 * j, (unsigned long long)cvt_pk_bf16(y[0], y[1]) | ((unsigned long long)cvt_pk_bf16(y[2], y[3]) << 32), __ATOMIC_RELAXED, __HIP_MEMORY_SCOPE_AGENT); } } }
        asm volatile("s_waitcnt vmcnt(0)" ::: "memory"); __builtin_amdgcn_s_barrier(); asm volatile("" ::: "memory");
        if (t0) { __hip_atomic_fetch_add(cnt + 256 + 64 * b, 1u, __ATOMIC_RELAXED, __HIP_MEMORY_SCOPE_AGENT); }
    }
    template <bool ISV>
    __device__ __forceinline__ void gn_path(const f32x4 (&acc)[2][2][4][2], const Unit& u, int wr, int wc, int fr, int fq, bf16_t* base, int colw) const {
        const int pn = u.pn;
#pragma unroll
        for (int ai = 0; ai < 2; ++ai)
#pragma unroll
            for (int m = 0; m < 4; ++m)
#pragma unroll
                for (int bj = 0; bj < 2; ++bj) { f32x4 a = acc[ai][bj][m][0], b = acc[ai][bj][m][1];
                    if (ISV) { a = gelu4(a); b = gelu4(b); }
                    float s = (a[0] * a[0] + a[1] * a[1]) + (a[2] * a[2] + a[3] * a[3]) + (b[0] * b[0] + b[1] * b[1]) + (b[2] * b[2] + b[3] * b[3]);
                    s += __shfl_xor(s, 16); s += __shfl_xor(s, 32);
                    if (fq == 0) xch[(ai * 128 + wr * 64 + m * 16 + fr) * 8 + bj * 4 + wc] = s;
                    if (ISV) __builtin_amdgcn_sched_barrier(0); }
        asm volatile("s_waitcnt lgkmcnt(0)" ::: "memory"); __builtin_amdgcn_s_barrier(); asm volatile("" ::: "memory");
        f32x4 w[2][2];
        if (ISV) {
#pragma unroll
            for (int bj = 0; bj < 2; ++bj)
#pragma unroll
                for (int n = 0; n < 2; ++n) w[bj][n] = *(const f32x4*)(vnw + ((pn - 4) * 2 + bj) * 128 + colw + 4 * n);
        } else {
            const float* nwp = pn < 16 ? qnw : knw; const int dlo = 64 * (wc >> 1) + 16 * (wc & 1) + 4 * fq;
            w[0][0] = *(const f32x4*)(nwp + dlo); w[0][1] = *(const f32x4*)(nwp + dlo + 32); w[1][0] = w[0][0]; w[1][1] = w[0][1];
        }
        const int jt = u.pm % 17;
        const bool rope = !ISV && jt != 0;
#pragma unroll
        for (int ai = 0; ai < 2; ++ai)
#pragma unroll
            for (int m = 0; m < 4; ++m) { const int rl = ai * 128 + wr * 64 + m * 16 + fr; bf16_t* rp = base + (size_t)(ai * 128 + m * 16) * 5632; size_t bjs = 128;
                if (!ISV) { if (pn == 16) { rp = Kc + ((size_t)((u.pm / 17) * 2) * 4352 + jt * 256 + rl) * 128 + colw; bjs = (size_t)4352 * 128; } }
                f32x4 cs = {1.f, 1.f, 1.f, 1.f}, sn = {0.f, 0.f, 0.f, 0.f};
                if (!ISV) { if (rope) { const int t = jt * 256 + rl - 256; const int pos = (wc >> 1) ? (t & 63) : (t >> 6); const int fi = pos * 32 + 16 * (wc & 1) + 4 * fq;
                    cs = *(const f32x4*)(ropec + fi); sn = *(const f32x4*)(ropes + fi); } }
#pragma unroll
                for (int bj = 0; bj < 2; ++bj) { const f32x4 pr = *(const PG8_LAS f32x4*)(xch + rl * 8 + bj * 4);
                    const float rstd = __builtin_amdgcn_rsqf(((pr[0] + pr[1]) + (pr[2] + pr[3])) * (1.f / 128.f) + 1e-6f);
                    f32x4 a0 = acc[ai][bj][m][0], a1 = acc[ai][bj][m][1];
                    if (ISV) { asm volatile("" : "+v"(a0), "+v"(a1));
                        a0 = gelu4(a0); a1 = gelu4(a1); }
                    a0 = a0 * rstd * w[bj][0]; a1 = a1 * rstd * w[bj][1];
                    if (!ISV) { const f32x4 o0 = a0 * cs - a1 * sn, o1 = a1 * cs + a0 * sn; a0 = o0; a1 = o1; }
                    store8(rp + bj * bjs, a0, a1); }
                asm volatile("" ::: "memory"); }
    }
};
struct EpiOut {
    static constexpr bool PERM = false, AFTER_DRAIN = false;
    const float* xsrc; const float* csrc; float* xdst; float* cdst; const float* gate;
    __device__ __forceinline__ void operator()(f32x4 (&acc)[2][2][4][2], const Unit& u, int wr, int wc, int fr, int fq) const {
        const int b = u.pm / 17, jt = u.pm % 17;
        const float* src; float* dst; int grow;
        if (jt == 0) { const size_t off = (size_t)(b * 256) * 2048; src = csrc + off; dst = cdst + off; grow = 4; }
        else { const size_t off = (size_t)(b * 4096 + (jt - 1) * 256) * 2048; src = xsrc + off; dst = xdst + off; grow = b; }
        const int col0 = u.pn * 256 + wc * 32 + 4 * fq;
        f32x4 gv[2][2];
#pragma unroll
        for (int bj = 0; bj < 2; ++bj)
#pragma unroll
            for (int n = 0; n < 2; ++n) gv[bj][n] = *(const f32x4*)(gate + grow * 6144 + col0 + bj * 128 + n * 16);
#pragma unroll
        for (int ai = 0; ai < 2; ++ai)
#pragma unroll
            for (int m = 0; m < 4; ++m) { const size_t ro = (size_t)(wr * 64 + fr + ai * 128 + m * 16) * 2048 + col0;
                f32x4 xs[2][2];
#pragma unroll
                for (int bj = 0; bj < 2; ++bj)
#pragma unroll
                    for (int n = 0; n < 2; ++n) xs[bj][n] = *(const f32x4*)(src + ro + bj * 128 + n * 16);
#pragma unroll
                for (int bj = 0; bj < 2; ++bj)
#pragma unroll
                    for (int n = 0; n < 2; ++n) *(f32x4*)(dst + ro + bj * 128 + n * 16) = xs[bj][n] + gv[bj][n] * acc[ai][bj][m][n];
                if (m & 1) asm volatile("" ::: "memory"); }
    }
};
struct SchedX {
    int nM, nN, nwg, G, c, lat, extra, m2; unsigned* cnt;
    __device__ void init(int nM_, int nN_, int G_, int c_, int lat_, int extra_, int m2_ = 0, unsigned* cnt_ = nullptr) { nM = nM_; nN = nN_; nwg = nM_ * nN_; G = G_; c = c_; lat = lat_; extra = extra_; m2 = m2_; cnt = cnt_; }
    __device__ __forceinline__ void map(int wgid0, Unit& u) const {
        int wgid = wgid0; { const int q = nwg / NXCD, r = nwg % NXCD, xcd = wgid % NXCD, off = wgid / NXCD; wgid = (xcd < r ? xcd * (q + 1) : r * (q + 1) + (xcd - r) * q) + off; }
        const int nig = WGM * nN, gid = wgid / nig, fm = gid * WGM, gsz = (nM - fm) < WGM ? (nM - fm) : WGM;
        const int pmq = fm + ((wgid % nig) % gsz); u.pn = (wgid % nig) / gsz;
        u.pm = lat ? (pmq / 16) * 17 + 1 + (pmq % 16) : pmq;
    }
    __device__ bool next(int i, Unit& u) const {
        u.kind = 0;
        if (m2) {
            int ir = i;
            if (c >= 128 && c < 160) { if (i == 0) { const int j = c - 128; u.kind = 1; u.pm = (j >> 3) * 17; u.pn = j & 7; return true; } ir = i - 1; }
            const long L2 = (long)ir * G + c;
            if (L2 < nwg) { map((int)L2, u); return true; }
            if (c >= 160 && c < 168 && ir == 5) { const int j = c - 160, b = j >> 1; unsigned sp = 0;
                while (__hip_atomic_load(cnt + 256 + 64 * b, __ATOMIC_RELAXED, __HIP_MEMORY_SCOPE_AGENT) < 8u && ++sp < (1u << 18)) __builtin_amdgcn_s_sleep(2);
                __builtin_amdgcn_fence(__ATOMIC_ACQUIRE, "agent");
                u.pm = b * 17; u.pn = 16 + (j & 1); return true; }
            return false;
        }
        long L = (long)i * G + c;
        if (L < nwg) { map((int)L, u); return true; }
        L -= nwg; if (L < extra) { u.pm = (int)(L >> 1) * 17; u.pn = 16 + (int)(L & 1); return true; }
        return false;
    }
    __device__ __forceinline__ void a_ready(const Unit&) const {}
    __device__ __forceinline__ void done(const Unit&) const {}
};
template <class Epi, class Sched, bool ALIGN_EPI = false, bool SP2 = false>
__device__ __forceinline__ void gemm_phase(PG8_LAS unsigned char* lds, const Gemm g, const Sched& S, const Epi& E) {
    int tid_ = threadIdx.x; asm volatile("" : "+v"(tid_));
    const int tid = tid_, wid = __builtin_amdgcn_readfirstlane(tid >> 6), lane = tid & 63, wr = wid >> 2, wc = wid & 3, fr = lane & 15, fq = lane >> 4;
    const int K = g.K, nt = K / BK;
    unsigned voffA[2], voffB[2];
#pragma unroll
    for (int i = 0; i < 2; ++i) { int R, C; stage_rc(tid * 16 + i * 8192, R, C); const int Rb = Epi::PERM ? ((R & ~31) + perm32(R & 31)) : R;
        voffA[i] = (unsigned)(R * K + C) * 2u; voffB[i] = (unsigned)(Rb * K + C) * 2u; }
    const size_t kstep = (size_t)(BK * 2);
    const size_t hstep = (size_t)HALF * K * 2;
    const size_t tstep = 2 * hstep;
    const unsigned ldsw = (unsigned)wid * 1024u;
    const int aoff = lds_byte(wr * 64 + fr, fq * 8), boff = lds_byte(wc * 32 + fr, fq * 8);
#define PG8_SA(b, h) (((b) * 2 + (h)) * HTB)
#define PG8_SB(b, h) ((4 + (b) * 2 + (h)) * HTB)
#define PG8_STAGE(bufoff, gbase, voff) do { _Pragma("unroll") for (int _i = 0; _i < 2; ++_i) \
        __builtin_amdgcn_global_load_lds((const unsigned*)((const char*)(gbase) + (voff)[_i]), (PG8_LAS unsigned*)(lds + (bufoff) + ldsw + _i * 8192), 16, 0, 0); } while (0)
#define PG8_LDA(dst, b, h) do { _Pragma("unroll") for (int m = 0; m < 4; ++m) _Pragma("unroll") for (int k = 0; k < 2; ++k) dst[m][k] = *(const PG8_LAS bf16x8*)(lds + PG8_SA(b, h) + aoff + m * 2048 + k * 1024); } while (0)
#define PG8_LDB(dst, b, h) do { _Pragma("unroll") for (int n = 0; n < 2; ++n) _Pragma("unroll") for (int k = 0; k < 2; ++k) dst[n][k] = *(const PG8_LAS bf16x8*)(lds + PG8_SB(b, h) + boff + n * 2048 + k * 1024); } while (0)
#define PG8_MMA(ai, bj, At, Bt) do { __builtin_amdgcn_s_setprio(1); _Pragma("unroll") for (int m = 0; m < 4; ++m) _Pragma("unroll") for (int n = 0; n < 2; ++n) _Pragma("unroll") for (int k = 0; k < 2; ++k) \
        acc[ai][bj][m][n] = __builtin_amdgcn_mfma_f32_16x16x32_bf16(Bt[n][k], At[m][k], acc[ai][bj][m][n], 0, 0, 0); __builtin_amdgcn_s_setprio(0); } while (0)
#define PG8_WAIT_V(n) asm volatile("s_waitcnt vmcnt(" #n ")" ::: "memory")
#define PG8_WAIT_L(n) asm volatile("s_waitcnt lgkmcnt(" #n ")" ::: "memory")
#define PG8_BAR __builtin_amdgcn_s_barrier()
#define PG8_SCHED __builtin_amdgcn_sched_barrier(0)
    Unit cur, nxt; int ui = 0;
    if (!S.next(0, cur)) return;
    f32x4 acc[2][2][4][2];
#pragma unroll
    for (int a = 0; a < 2; ++a)
#pragma unroll
        for (int b = 0; b < 2; ++b)
#pragma unroll
            for (int m = 0; m < 4; ++m)
#pragma unroll
                for (int n = 0; n < 2; ++n) acc[a][b][m][n] = (f32x4){0.f, 0.f, 0.f, 0.f};
    bf16x8 At[4][2], B0[2][2], B1[2][2];
    const char* cA = (const char*)(cur.kind ? g.A2 : g.A) + (size_t)cur.pm * tstep; const char* cB = (const char*)(cur.kind ? g.B2 : g.Bt) + (size_t)cur.pn * tstep;
    S.a_ready(cur);
    if constexpr (SP2) {
        PG8_STAGE(PG8_SB(0, 0), cB, voffB); PG8_STAGE(PG8_SB(0, 1), cB + hstep, voffB); PG8_STAGE(PG8_SA(0, 0), cA, voffA); PG8_STAGE(PG8_SA(0, 1), cA + hstep, voffA);
        if (wr == 1) PG8_BAR;
        PG8_WAIT_V(2); PG8_BAR;
        PG8_STAGE(PG8_SB(1, 0), cB + kstep, voffB); PG8_STAGE(PG8_SA(1, 0), cA + kstep, voffA); PG8_STAGE(PG8_SB(1, 1), cB + hstep + kstep, voffB);
        PG8_WAIT_V(6); PG8_BAR;
    } else {
        PG8_STAGE(PG8_SB(0, 0), cB, voffB); PG8_STAGE(PG8_SA(0, 0), cA, voffA); PG8_STAGE(PG8_SB(0, 1), cB + hstep, voffB); PG8_STAGE(PG8_SA(0, 1), cA + hstep, voffA);
        if (wr == 1) PG8_BAR;
        PG8_WAIT_V(4); PG8_BAR;
        PG8_STAGE(PG8_SB(1, 0), cB + kstep, voffB); PG8_STAGE(PG8_SA(1, 0), cA + kstep, voffA); PG8_STAGE(PG8_SB(1, 1), cB + hstep + kstep, voffB);
        PG8_WAIT_V(6); PG8_BAR;
    }
    for (;;) {
        const bool has_next = S.next(ui + 1, nxt);
        const char* nA = has_next ? (const char*)(nxt.kind ? g.A2 : g.A) + (size_t)nxt.pm * tstep : cA; const char* nB = has_next ? (const char*)(nxt.kind ? g.B2 : g.Bt) + (size_t)nxt.pn * tstep : cB;
        for (int t = 0; t < nt; t += 2) {
            const bool last = (t == nt - 2);
            const char* a1 = cA + (size_t)(t + 1) * kstep;
            const char* a2 = last ? nA : cA + (size_t)(t + 2) * kstep; const char* b2 = last ? nB : cB + (size_t)(t + 2) * kstep;
            const char* a3 = a2 + kstep; const char* b3 = b2 + kstep;
            if (last && has_next) S.a_ready(nxt);
            if constexpr (SP2) {
            PG8_LDB(B0, 0, 0); PG8_LDB(B1, 0, 1); PG8_SCHED; PG8_LDA(At, 0, 0); PG8_STAGE(PG8_SA(1, 1), a1 + hstep, voffA);
            PG8_WAIT_V(8); PG8_WAIT_L(0); PG8_BAR; PG8_MMA(0, 0, At, B0); PG8_MMA(0, 1, At, B1); PG8_BAR; PG8_SCHED;
            PG8_LDA(At, 0, 1); PG8_STAGE(PG8_SB(0, 0), b2, voffB); PG8_STAGE(PG8_SB(0, 1), b2 + hstep, voffB); PG8_STAGE(PG8_SA(0, 0), a2, voffA);
            PG8_WAIT_V(8); PG8_WAIT_L(0); PG8_BAR; PG8_MMA(1, 0, At, B0); PG8_MMA(1, 1, At, B1); PG8_BAR; PG8_SCHED;
            PG8_LDB(B0, 1, 0); PG8_LDB(B1, 1, 1); PG8_SCHED; PG8_LDA(At, 1, 0); PG8_STAGE(PG8_SA(0, 1), a2 + hstep, voffA);
            PG8_WAIT_V(8); PG8_WAIT_L(0); PG8_BAR; PG8_MMA(0, 0, At, B0); PG8_MMA(0, 1, At, B1); PG8_BAR; PG8_SCHED;
            PG8_LDA(At, 1, 1); PG8_STAGE(PG8_SB(1, 0), b3, voffB); PG8_STAGE(PG8_SB(1, 1), b3 + hstep, voffB); PG8_STAGE(PG8_SA(1, 0), a3, voffA);
            PG8_WAIT_V(8); PG8_WAIT_L(0); PG8_BAR; PG8_MMA(1, 0, At, B0); PG8_MMA(1, 1, At, B1); PG8_BAR; PG8_SCHED;
            } else {
            PG8_LDB(B0, 0, 0); PG8_SCHED; PG8_LDA(At, 0, 0); PG8_STAGE(PG8_SA(1, 1), a1 + hstep, voffA);
            PG8_WAIT_L(8); PG8_BAR; PG8_WAIT_L(0); PG8_MMA(0, 0, At, B0); PG8_BAR; PG8_SCHED;
            PG8_LDB(B1, 0, 1); PG8_STAGE(PG8_SB(0, 0), b2, voffB);
            PG8_BAR; PG8_WAIT_L(0); PG8_MMA(0, 1, At, B1); PG8_BAR;
            PG8_LDA(At, 0, 1); PG8_STAGE(PG8_SA(0, 0), a2, voffA);
            PG8_BAR; PG8_WAIT_L(0); PG8_MMA(1, 0, At, B0); PG8_BAR; PG8_SCHED;
            PG8_STAGE(PG8_SB(0, 1), b2 + hstep, voffB);
            PG8_WAIT_V(6); PG8_BAR; PG8_MMA(1, 1, At, B1); PG8_BAR;
            PG8_LDB(B0, 1, 0); PG8_SCHED; PG8_LDA(At, 1, 0); PG8_STAGE(PG8_SA(0, 1), a2 + hstep, voffA);
            PG8_WAIT_L(8); PG8_BAR; PG8_WAIT_L(0); PG8_MMA(0, 0, At, B0); PG8_BAR; PG8_SCHED;
            PG8_LDB(B1, 1, 1); PG8_STAGE(PG8_SB(1, 0), b3, voffB);
            PG8_BAR; PG8_WAIT_L(0); PG8_MMA(0, 1, At, B1); PG8_BAR;
            PG8_LDA(At, 1, 1); PG8_STAGE(PG8_SA(1, 0), a3, voffA);
            PG8_BAR; PG8_WAIT_L(0); PG8_MMA(1, 0, At, B0); PG8_BAR; PG8_SCHED;
            PG8_STAGE(PG8_SB(1, 1), b3 + hstep, voffB);
            PG8_WAIT_V(6); PG8_BAR; PG8_MMA(1, 1, At, B1); PG8_BAR;
            }
        }
        if constexpr (ALIGN_EPI) { if (wr == 0) PG8_BAR; }
        if constexpr (!Epi::AFTER_DRAIN) { int fr_e = fr, fq_e = fq; asm volatile("" : "+v"(fr_e), "+v"(fq_e));
            E(acc, cur, wr, wc, fr_e, fq_e); S.done(cur); }
        if (!has_next) break;
#pragma unroll
        for (int a = 0; a < 2; ++a)
#pragma unroll
            for (int b = 0; b < 2; ++b)
#pragma unroll
                for (int m = 0; m < 4; ++m)
#pragma unroll
                    for (int n = 0; n < 2; ++n) acc[a][b][m][n] = (f32x4){0.f, 0.f, 0.f, 0.f};
        cur = nxt; cA = nA; cB = nB; ++ui;
        if constexpr (ALIGN_EPI) { if (wr == 1) PG8_BAR; }
    }
    PG8_WAIT_V(0);
    if constexpr (!ALIGN_EPI) { if (wr == 0) PG8_BAR; }
    PG8_BAR;
    if constexpr (Epi::AFTER_DRAIN) { E.fused(acc, cur, wr, wc, fr, fq, lds, wid, lane); S.done(cur); }
#undef PG8_SA
#undef PG8_SB
#undef PG8_STAGE
#undef PG8_LDA
#undef PG8_LDB
#undef PG8_MMA
#undef PG8_WAIT_V
#undef PG8_WAIT_L
#undef PG8_BAR
#undef PG8_SCHED
}
}
namespace at {
using bf16 = __hip_bfloat16;
constexpr int   D = 128, NW = 8, QBLK = 32, KVBLK = 64;
constexpr float SCALE = 0.088388347648318440f;
#ifndef ATTN_THR
#define ATTN_THR 8.f
#endif
constexpr float THR = ATTN_THR;
constexpr int SDEPTH = 2;
constexpr int LDQ = 5632, LDK = 128, LDO = 2048;
constexpr size_t SHM_V = KVBLK * D * 2, SHM_K = KVBLK * D * 2, SHM_ATTN = 2 * SHM_V + 2 * SHM_K + NW * 64 * 4;
using f32x4v = __attribute__((ext_vector_type(4))) float;
using bf16x8 = __attribute__((ext_vector_type(8))) short;
using s16x4  = __attribute__((ext_vector_type(4))) short;
using f32x16 = __attribute__((ext_vector_type(16))) float;
using f32x8  = __attribute__((ext_vector_type(8))) float;
using u32x4  = __attribute__((ext_vector_type(4))) unsigned;
#define KSWZ(row, colB) ((row) * 256 + ((colB) ^ (((row) & 7) << 4)))
#define SBAR() __builtin_amdgcn_sched_barrier(0)
__device__ __forceinline__ int crow(int r, int hi) { return (r & 3) + 8 * (r >> 2) + 4 * hi; }
__device__ __forceinline__ unsigned cvtpk(float lo, float hi) {
  unsigned r; asm volatile("v_cvt_pk_bf16_f32 %0, %1, %2" : "=v"(r) : "v"(lo), "v"(hi)); return r;
}
template <typename TIn> struct Stage;
template <> struct Stage<bf16>  { using T = bf16x8;
  __device__ static __forceinline__ T ld8(const bf16* p) { return *reinterpret_cast<const bf16x8*>(p); }
  __device__ static __forceinline__ bf16x8 tobf(T x) { return x; } };
template <> struct Stage<float> { using T = f32x8;
  __device__ static __forceinline__ T ld8(const float* p) { return *reinterpret_cast<const f32x8*>(p); }
  __device__ static __forceinline__ bf16x8 tobf(T x) {
    u32x4 w = {cvtpk(x[0], x[1]), cvtpk(x[2], x[3]), cvtpk(x[4], x[5]), cvtpk(x[6], x[7])}; return *reinterpret_cast<bf16x8*>(&w); } };

__device__ __forceinline__ void partialSM(f32x16& p0, f32x16& p1, float& m_reg, float& mn, float& alpha) {
  constexpr float C = SCALE * 1.4426950408889634f;
  float pmax = p0[0]; for (int r = 1; r < 16; ++r) pmax = fmaxf(pmax, p0[r]); for (int r = 0; r < 16; ++r) pmax = fmaxf(pmax, p1[r]);
  { auto rr = __builtin_amdgcn_permlane32_swap(__float_as_uint(pmax), __float_as_uint(pmax), false, false);
    pmax = fmaxf(__uint_as_float(rr[0]), __uint_as_float(rr[1])); }
  if (__builtin_expect(__all(pmax - m_reg <= THR / SCALE), 1)) { mn = m_reg; alpha = 1.f; }
  else { mn = fmaxf(m_reg, pmax); alpha = __builtin_amdgcn_exp2f((m_reg - mn) * C); m_reg = mn; }
  float mnC = -mn * C;
  for (int r = 0; r < 16; ++r) p0[r] = fmaf(p0[r], C, mnC); for (int r = 0; r < 16; ++r) p1[r] = fmaf(p1[r], C, mnC);
  for (int r = 0; r < 16; ++r) p0[r] = __builtin_amdgcn_exp2f(p0[r]);
}
__device__ __forceinline__ void finishSM(f32x16& p0, f32x16& p1, float alpha, float& l_reg, bf16x8& pa0, bf16x8& pa1, bf16x8& pa2, bf16x8& pa3) {
  for (int r = 0; r < 16; ++r) p1[r] = __builtin_amdgcn_exp2f(p1[r]);
  float ps = 0; for (int r = 0; r < 16; ++r) ps += p0[r]; for (int r = 0; r < 16; ++r) ps += p1[r];
  { auto rr = __builtin_amdgcn_permlane32_swap(__float_as_uint(ps), __float_as_uint(ps), false, false);
    ps = __uint_as_float(rr[0]) + __uint_as_float(rr[1]); }
  l_reg = l_reg * alpha + ps;
#define PK4(P, BASE, OUT) do { unsigned a0 = cvtpk(P[BASE + 0], P[BASE + 1]), a1 = cvtpk(P[BASE + 2], P[BASE + 3]);   \
    unsigned b0 = cvtpk(P[BASE + 4], P[BASE + 5]), b1 = cvtpk(P[BASE + 6], P[BASE + 7]);                              \
    auto r0 = __builtin_amdgcn_permlane32_swap(a0, b0, false, false); auto r1 = __builtin_amdgcn_permlane32_swap(a1, b1, false, false); \
    u32x4 w = {r0[0], r1[0], r0[1], r1[1]}; OUT = *reinterpret_cast<bf16x8*>(&w); } while (0)
  PK4(p0, 0, pa0); PK4(p0, 8, pa1); PK4(p1, 0, pa2); PK4(p1, 8, pa3);
#undef PK4
}
__device__ __forceinline__ void qkt(f32x16& p0, f32x16& p1, const bf16* Ks, const bf16x8* qr, int r32, int hi) {
  p0 = f32x16{}; p1 = f32x16{};
  for (int d0 = 0; d0 < 8; ++d0) { int cb = (d0 * 16 + hi * 8) * 2;
    bf16x8 b0 = *reinterpret_cast<const bf16x8*>((const char*)Ks + KSWZ(r32, cb));
    bf16x8 b1 = *reinterpret_cast<const bf16x8*>((const char*)Ks + KSWZ(32 + r32, cb));
    p0 = __builtin_amdgcn_mfma_f32_32x32x16_bf16(b0, qr[d0], p0, 0, 0, 0);
    p1 = __builtin_amdgcn_mfma_f32_32x32x16_bf16(b1, qr[d0], p1, 0, 0, 0); }
}
__device__ __forceinline__ int v_st(int k, int c) { const int kk = (k & ~0xC) | ((k & 4) << 1) | ((k & 8) >> 1); return ((kk >> 3) * 4 + (c >> 5)) * 512 + ((kk & 7) * 32 + (c & 31)) * 2; }
__device__ __forceinline__ int v_rd_base(int lane) { return ((lane & 3) << 3) | (((lane >> 2) & 3) << 6) | (((lane >> 4) & 1) << 5) | (((lane >> 5) & 1) << 8); }
constexpr int v_rd_off(int d0, int ks, int half) { return d0 * 512 + ks * 4096 + half * 2048; }
template <int OFF> __device__ __forceinline__ s16x4 tr_read(int vb) {
  s16x4 r; asm volatile("ds_read_b64_tr_b16 %0, %1 offset:%2" : "=&v"(r) : "v"(vb), "i"(OFF) : "memory"); return r;
}
template <int D0> __device__ __forceinline__ void pv_one(f32x16& od, int vb, bf16x8 pa0, bf16x8 pa1, bf16x8 pa2, bf16x8 pa3) {
  const s16x4 l0 = tr_read<v_rd_off(D0, 0, 0)>(vb), h0 = tr_read<v_rd_off(D0, 0, 1)>(vb), l1 = tr_read<v_rd_off(D0, 1, 0)>(vb), h1 = tr_read<v_rd_off(D0, 1, 1)>(vb);
  const s16x4 l2 = tr_read<v_rd_off(D0, 2, 0)>(vb), h2 = tr_read<v_rd_off(D0, 2, 1)>(vb), l3 = tr_read<v_rd_off(D0, 3, 0)>(vb), h3 = tr_read<v_rd_off(D0, 3, 1)>(vb);
  asm volatile("s_waitcnt lgkmcnt(0)" ::: "memory"); SBAR();
#define PK(L, H) (bf16x8){L[0], L[1], L[2], L[3], H[0], H[1], H[2], H[3]}
  od = __builtin_amdgcn_mfma_f32_32x32x16_bf16(pa0, PK(l0, h0), od, 0, 0, 0);
  od = __builtin_amdgcn_mfma_f32_32x32x16_bf16(pa1, PK(l1, h1), od, 0, 0, 0);
  od = __builtin_amdgcn_mfma_f32_32x32x16_bf16(pa2, PK(l2, h2), od, 0, 0, 0);
  od = __builtin_amdgcn_mfma_f32_32x32x16_bf16(pa3, PK(l3, h3), od, 0, 0, 0);
#undef PK
}
__device__ __forceinline__ void pv_d0(f32x16* o, int vb, bf16x8 pa0, bf16x8 pa1, bf16x8 pa2, bf16x8 pa3) {
  pv_one<0>(o[0], vb, pa0, pa1, pa2, pa3); pv_one<1>(o[1], vb, pa0, pa1, pa2, pa3); pv_one<2>(o[2], vb, pa0, pa1, pa2, pa3); pv_one<3>(o[3], vb, pa0, pa1, pa2, pa3);
}

__device__ __forceinline__ void attn_dense_body(const bf16* __restrict__ Qb, const bf16* __restrict__ Kh, const bf16* __restrict__ Vh,
                                                const bf16* __restrict__ Zb, bf16* __restrict__ Ob, int seq, char* lds) {
  using TQ = bf16; using St = Stage<bf16>; using SQ = Stage<TQ>;
  int tid_ = threadIdx.x; asm volatile("" : "+v"(tid_));
  const int tid = tid_, wid = tid >> 6, lane = tid & 63, r32 = lane & 31, hi = lane >> 5;
  bf16* V_lds = (bf16*)lds; bf16* K_lds = (bf16*)(lds + 2 * SHM_V);
  float* ws = (float*)(lds + 2 * SHM_V + 2 * SHM_K) + wid * 64; float* li_l = ws; float* al_l = ws + 32;
  float m_reg = -1e30f, l_reg = 0; f32x16 o[4] = {}; bf16x8 qr[8];
  const TQ* Qw = Qb + (long)(wid * QBLK + r32) * LDQ + hi * 8;
#pragma unroll
  for (int d0 = 0; d0 < 8; ++d0) qr[d0] = SQ::tobf(SQ::ld8(Qw + d0 * 16));
  const int sr = tid >> 4, sc = (tid & 15) * 8, vst0 = v_st(sr, sc), vst1 = v_st(32 + sr, sc);
  const int vb0 = (int)(uintptr_t)V_lds + v_rd_base(lane);
  struct { typename St::T vs0, vs1, ks0, ks1; } sr_[SDEPTH];
#define SLOAD(i, k0) do { sr_[i].vs0 = St::ld8(&Vh[(long)((k0) + sr) * LDK + sc]); sr_[i].vs1 = St::ld8(&Vh[(long)((k0) + 32 + sr) * LDK + sc]); \
    sr_[i].ks0 = St::ld8(&Kh[(long)((k0) + sr) * LDK + sc]); sr_[i].ks1 = St::ld8(&Kh[(long)((k0) + 32 + sr) * LDK + sc]); } while (0)
#define SWRITE(b, i) do { *(bf16x8*)((char*)V_lds + (b) * SHM_V + vst0) = St::tobf(sr_[i].vs0);          \
    *(bf16x8*)((char*)V_lds + (b) * SHM_V + vst1) = St::tobf(sr_[i].vs1); int kc = sc * 2;               \
    *(bf16x8*)((char*)K_lds + (b) * SHM_K + KSWZ(sr, kc)) = St::tobf(sr_[i].ks0);                       \
    *(bf16x8*)((char*)K_lds + (b) * SHM_K + KSWZ(32 + sr, kc)) = St::tobf(sr_[i].ks1); } while (0)
#define SWAIT() do { if constexpr (SDEPTH == 2) asm volatile("s_waitcnt vmcnt(4)" ::: "memory"); else asm volatile("s_waitcnt vmcnt(0)" ::: "memory"); } while (0)
#define RESC(a) do { if (__any((a) < 1.f)) { if (hi == 0) al_l[r32] = (a); asm volatile("s_waitcnt lgkmcnt(0)" ::: "memory"); \
    for (int d = 0; d < 4; ++d) for (int r = 0; r < 16; ++r) o[d][r] *= al_l[crow(r, hi)]; } } while (0)
  f32x16 pA0, pA1, pB0, pB1; float mnA, mnB, alA, alB; bf16x8 pa0, pa1, pa2, pa3; const int NT = seq / KVBLK;
  constexpr int SE = 0, SO = SDEPTH - 1;
  SLOAD(SE, 0); asm volatile("s_waitcnt vmcnt(0)" ::: "memory"); SWRITE(0, SE); __syncthreads();
  qkt(pA0, pA1, K_lds, qr, r32, hi); partialSM(pA0, pA1, m_reg, mnA, alA);
  SLOAD(SO, KVBLK); if constexpr (SDEPTH == 2) { if (2 < NT) SLOAD(SE, 2 * KVBLK); }
  SWAIT(); SWRITE(1, SO); __syncthreads();
  for (int j = 1; j + 1 < NT; j += 2) {
    SBAR(); qkt(pB0, pB1, (bf16*)((char*)K_lds + SHM_K), qr, r32, hi);
    finishSM(pA0, pA1, alA, l_reg, pa0, pa1, pa2, pa3); SBAR();
    SLOAD(SO, (j + SDEPTH) * KVBLK); SBAR();
    pv_d0(o, vb0, pa0, pa1, pa2, pa3); partialSM(pB0, pB1, m_reg, mnB, alB);
    __syncthreads(); SWAIT(); SWRITE(0, SE);
    RESC(alB); __syncthreads();
    SBAR(); qkt(pA0, pA1, K_lds, qr, r32, hi);
    finishSM(pB0, pB1, alB, l_reg, pa0, pa1, pa2, pa3); SBAR();
    if (SDEPTH == 1 || j + 3 < NT) SLOAD(SE, (j + 1 + SDEPTH) * KVBLK); SBAR();
    pv_d0(o, vb0 + (int)SHM_V, pa0, pa1, pa2, pa3); partialSM(pA0, pA1, m_reg, mnA, alA);
    __syncthreads(); SWAIT(); SWRITE(1, SO);
    RESC(alA); __syncthreads();
  }
  SBAR(); qkt(pB0, pB1, (bf16*)((char*)K_lds + SHM_K), qr, r32, hi);
  finishSM(pA0, pA1, alA, l_reg, pa0, pa1, pa2, pa3); SBAR();
  pv_d0(o, vb0, pa0, pa1, pa2, pa3); partialSM(pB0, pB1, m_reg, mnB, alB);
  __syncthreads(); RESC(alB);
  finishSM(pB0, pB1, alB, l_reg, pa0, pa1, pa2, pa3); SBAR();
  pv_d0(o, vb0 + (int)SHM_V, pa0, pa1, pa2, pa3);
  if (hi == 0) li_l[r32] = l_reg; asm volatile("s_waitcnt lgkmcnt(0)" ::: "memory");
  float rli[16];
#pragma unroll
  for (int r = 0; r < 16; ++r) rli[r] = __builtin_amdgcn_rcpf(li_l[crow(r, hi)]);
  bf16* Ow = Ob + (long)(wid * QBLK) * LDO; const bf16* Zw = Zb + (long)(wid * QBLK) * LDQ;
  char* stg = lds + (2 * SHM_V + 2 * SHM_K + NW * 64 * 4) + wid * (32 * 272);
#pragma unroll
  for (int r = 0; r < 16; ++r) { const int orow = crow(r, hi);
#pragma unroll
    for (int d0 = 0; d0 < 4; ++d0) *(unsigned short*)(stg + orow * 272 + (d0 * 32 + r32) * 2) = (unsigned short)cvtpk(o[d0][r] * rli[r], 0.f); }
  asm volatile("s_waitcnt lgkmcnt(0)" ::: "memory");
  { const int c8 = (lane & 15) * 8, rq = lane >> 4;
#pragma unroll
    for (int i = 0; i < 8; ++i) { const int row = rq + 4 * i;
      const u32x4 ov = *reinterpret_cast<const u32x4*>(stg + row * 272 + c8 * 2);
      const u32x4 zv = *reinterpret_cast<const u32x4*>(Zw + (long)row * LDQ + c8);
      u32x4 w;
#define OZ(k) cvtpk(__uint_as_float(ov[k] << 16) * __uint_as_float(zv[k] << 16), __uint_as_float(ov[k] & 0xffff0000u) * __uint_as_float(zv[k] & 0xffff0000u))
      w[0] = OZ(0); w[1] = OZ(1); w[2] = OZ(2); w[3] = OZ(3);
#undef OZ
      *reinterpret_cast<u32x4*>(Ow + (long)row * LDO + c8) = w; } }
#undef SLOAD
#undef SWRITE
#undef SWAIT
#undef RESC
}
template <int D0> __device__ __forceinline__ void sgu_one(f32x16& od, int vb, bf16x8 w0, bf16x8 w1, bf16x8 w2, bf16x8 w3) {
  const s16x4 l0 = tr_read<v_rd_off(D0, 0, 0)>(vb), h0 = tr_read<v_rd_off(D0, 0, 1)>(vb), l1 = tr_read<v_rd_off(D0, 1, 0)>(vb), h1 = tr_read<v_rd_off(D0, 1, 1)>(vb);
  const s16x4 l2 = tr_read<v_rd_off(D0, 2, 0)>(vb), h2 = tr_read<v_rd_off(D0, 2, 1)>(vb), l3 = tr_read<v_rd_off(D0, 3, 0)>(vb), h3 = tr_read<v_rd_off(D0, 3, 1)>(vb);
  asm volatile("s_waitcnt lgkmcnt(0)" ::: "memory"); SBAR();
#define PK(L, H) (bf16x8){L[0], L[1], L[2], L[3], H[0], H[1], H[2], H[3]}
  od = __builtin_amdgcn_mfma_f32_32x32x16_bf16(PK(l0, h0), w0, od, 0, 0, 0);
  od = __builtin_amdgcn_mfma_f32_32x32x16_bf16(PK(l1, h1), w1, od, 0, 0, 0);
  od = __builtin_amdgcn_mfma_f32_32x32x16_bf16(PK(l2, h2), w2, od, 0, 0, 0);
  od = __builtin_amdgcn_mfma_f32_32x32x16_bf16(PK(l3, h3), w3, od, 0, 0, 0);
#undef PK
}
__device__ __forceinline__ float bf_lo(unsigned w) { return __uint_as_float(w << 16); }
__device__ __forceinline__ float bf_hi(unsigned w) { return __uint_as_float(w & 0xffff0000u); }
constexpr int SGU_S_OFF = 2 * (int)SHM_V, SGU_S_LD = 132;
struct SguRegs { bf16x8 t00, t01, t10, t11; u32x4 uu[4], zz[4]; };
__device__ __forceinline__ void sgu_load(SguRegs& R, const bf16* __restrict__ Pb, int item, int sr, int sc, int lat) {
  const int ci = item >> 3, g = item & 7; const int chunk = lat ? (ci >> 5) * 34 + 2 + (ci & 31) : ci;     const long R0 = (long)chunk * 128;
  const bf16* vsrc = Pb + R0 * LDQ + 1024 + g * 128 + sc;
  R.t00 = *reinterpret_cast<const bf16x8*>(vsrc + (long)(sr) * LDQ); R.t01 = *reinterpret_cast<const bf16x8*>(vsrc + (long)(32 + sr) * LDQ);
  R.t10 = *reinterpret_cast<const bf16x8*>(vsrc + (long)(64 + sr) * LDQ); R.t11 = *reinterpret_cast<const bf16x8*>(vsrc + (long)(96 + sr) * LDQ);
  const bf16* urow = Pb + (R0 + sr) * LDQ + g * 128 + sc;
#pragma unroll
  for (int k = 0; k < 4; ++k) { R.uu[k] = *reinterpret_cast<const u32x4*>(urow + (long)(32 * k) * LDQ); R.zz[k] = *reinterpret_cast<const u32x4*>(urow + (long)(32 * k) * LDQ + 2048); }
}
__device__ __forceinline__ void sgu_phase(const bf16* __restrict__ Pb, bf16* __restrict__ YC, const bf16* __restrict__ Wf  ,
                                          const float* __restrict__ bsgu  , int first, int stride, int nitems, char* lds, int lat) {
  int tid_ = threadIdx.x; asm volatile("" : "+v"(tid_));
  const int tid = tid_, wid = tid >> 6, lane = tid & 63, r32 = lane & 31, hi = lane >> 5;
  bf16* V_lds = (bf16*)lds; float* S_lds = (float*)(lds + SGU_S_OFF);
  const int sr = tid >> 4, sc = (tid & 15) * 8, vst0 = v_st(sr, sc), vst1 = v_st(32 + sr, sc);
  const int pb = wid & 3, P0 = 32 * pb, DB = 2 * (wid >> 2);
  const int vb = (int)(uintptr_t)V_lds + v_rd_base(lane) + DB * 512;
  if (first >= nitems) return;
  SguRegs C, N;
  sgu_load(C, Pb, first, sr, sc, lat);
  for (int item = first; item < nitems; item += stride) {
    const int ci = item >> 3, g = item & 7; const int chunk = lat ? (ci >> 5) * 34 + 2 + (ci & 31) : ci; const long R0 = (long)chunk * 128;
    *(bf16x8*)((char*)V_lds + vst0) = C.t00; *(bf16x8*)((char*)V_lds + vst1) = C.t01;
    *(bf16x8*)((char*)V_lds + SHM_V + vst0) = C.t10; *(bf16x8*)((char*)V_lds + SHM_V + vst1) = C.t11;
    const bf16x8* wfp = reinterpret_cast<const bf16x8*>(Wf) + ((long)(g * 4 + pb) * 8) * 64 + lane;
    bf16x8 wf[2][4];
#pragma unroll
    for (int T = 0; T < 2; ++T)
#pragma unroll
      for (int s = 0; s < 4; ++s) wf[T][s] = wfp[(T * 4 + s) * 64];
    const bool has_next = item + stride < nitems;
    if (has_next) sgu_load(N, Pb, item + stride, sr, sc, lat);
    __syncthreads();
    f32x16 o0 = {}, o1 = {};
    sgu_one<0>(o0, vb, wf[0][0], wf[0][1], wf[0][2], wf[0][3]); sgu_one<1>(o1, vb, wf[0][0], wf[0][1], wf[0][2], wf[0][3]);
    sgu_one<0>(o0, vb + (int)SHM_V, wf[1][0], wf[1][1], wf[1][2], wf[1][3]); sgu_one<1>(o1, vb + (int)SHM_V, wf[1][0], wf[1][1], wf[1][2], wf[1][3]);
#pragma unroll
    for (int dd = 0; dd < 2; ++dd)
#pragma unroll
      for (int g4 = 0; g4 < 4; ++g4) { const int d = 32 * (DB + dd) + 8 * g4 + 4 * hi; const f32x16& o = dd ? o1 : o0;
        *reinterpret_cast<f32x4v*>(S_lds + (P0 + r32) * SGU_S_LD + d) = (f32x4v){o[4 * g4 + 0], o[4 * g4 + 1], o[4 * g4 + 2], o[4 * g4 + 3]}; }
    __syncthreads();
#pragma unroll
    for (int k = 0; k < 4; ++k) { const int row = sr + 32 * k; const float bias = bsgu[g * 128 + row];
      const f32x4v s0 = *reinterpret_cast<const f32x4v*>(S_lds + row * SGU_S_LD + sc), s1 = *reinterpret_cast<const f32x4v*>(S_lds + row * SGU_S_LD + sc + 4);
      const u32x4 u = C.uu[k], z = C.zz[k]; u32x4 w;
      w.x = cvtpk(bf_lo(u.x) * (s0[0] + bias) * bf_lo(z.x), bf_hi(u.x) * (s0[1] + bias) * bf_hi(z.x));
      w.y = cvtpk(bf_lo(u.y) * (s0[2] + bias) * bf_lo(z.y), bf_hi(u.y) * (s0[3] + bias) * bf_hi(z.y));
      w.z = cvtpk(bf_lo(u.z) * (s1[0] + bias) * bf_lo(z.z), bf_hi(u.z) * (s1[1] + bias) * bf_hi(z.z));
      w.w = cvtpk(bf_lo(u.w) * (s1[2] + bias) * bf_lo(z.w), bf_hi(u.w) * (s1[3] + bias) * bf_hi(z.w));
      *reinterpret_cast<u32x4*>(YC + (R0 + row) * LDO + g * 128 + sc) = w; }
    if (has_next) C = N;
    __syncthreads();
  }
}
}
typedef float f32x4 __attribute__((ext_vector_type(4)));
typedef unsigned v4u __attribute__((ext_vector_type(4)));
typedef unsigned short bf16_t;
#define LDS_WAIT() asm volatile("s_waitcnt lgkmcnt(0)" ::: "memory")
__device__ __forceinline__ unsigned f2bf(float f) { unsigned u = __builtin_bit_cast(unsigned, f); return (u + 0x7fffu + ((u >> 16) & 1u)) >> 16; }
__device__ __forceinline__ unsigned pk2(float lo, float hi) { return f2bf(lo) | (f2bf(hi) << 16); }
__device__ __forceinline__ float wave_sum(float v) {
#pragma unroll
    for (int o = 1; o < 64; o <<= 1) v += __shfl_xor(v, o);
    return v;
}
__device__ __forceinline__ int physrow_in(int c) {
    if (c < C_Q || c >= C_VA) return c;
    const int d = c & 127; const int p = (d & 0x40) | ((d & 0x10) << 1) | ((d & 0xC) << 1) | ((d & 0x20) >> 3) | (d & 3);
    return (c & ~127) | p;
}
__device__ __forceinline__ void p0_transpose_item(const float* W, int K, int N, bf16_t* WT, bool perm, LAS float* scr, int item, int lane) {
    const int nblk = N / 32, kb = item / nblk, nb = item % nblk, k0 = 64 * kb, n0 = 32 * nb;
#pragma unroll 8
    for (int i = 0; i < 32; ++i) { const int kk = 2 * i + (lane >> 5); scr[kk * 33 + (lane & 31)] = W[(size_t)(k0 + kk) * N + n0 + (lane & 31)]; }
    LDS_WAIT(); asm volatile("" ::: "memory");
    const int c = lane & 7;
#pragma unroll
    for (int j = 0; j < 4; ++j) { const int n = (lane >> 3) + 8 * j; const LAS float* s = scr + (8 * c) * 33 + n;
        v4u o; o.x = pk2(s[0 * 33], s[1 * 33]); o.y = pk2(s[2 * 33], s[3 * 33]); o.z = pk2(s[4 * 33], s[5 * 33]); o.w = pk2(s[6 * 33], s[7 * 33]);
        const int rown = perm ? physrow_in(n0 + n) : (n0 + n);
        *(v4u*)(WT + (size_t)rown * K + k0 + 8 * c) = o; }
    LDS_WAIT(); asm volatile("" ::: "memory");
}
__device__ __forceinline__ void p0_prologue(const Args& a, LAS unsigned char* lds, int tid, int lane, int wave, int vcu, int G) {
    float* mod = (float*)(a.ws + WS_MOD);
    {
        LAS float* sl = (LAS float*)lds; LAS float* red = (LAS float*)(lds + 40960);
        for (int i = tid; i < 5 * 2048; i += 512) { const float v = (i < 4 * 2048) ? a.in[1][i] : a.in[3][i - 4 * 2048]; sl[i] = v / (1.f + __expf(-v)); }
        __syncthreads();
        const int cgp = tid % 12, kl = tid / 12;
        for (int item = vcu; item < 256; item += G) {
            const int l = item >> 7, j0 = (item & 127) * 48;
            if (kl < 42) {
                f32x4 acc[5];
#pragma unroll
                for (int r = 0; r < 5; ++r) acc[r] = (f32x4){0.f, 0.f, 0.f, 0.f};
                const float* wp = a.in[5] + (size_t)l * 2048 * 6144 + j0 + cgp * 4;
#pragma unroll 4
                for (int k = kl; k < 2048; k += 42) { const f32x4 w = *(const f32x4*)(wp + (size_t)k * 6144);
#pragma unroll
                    for (int r = 0; r < 5; ++r) acc[r] += sl[r * 2048 + k] * w; }
#pragma unroll
                for (int r = 0; r < 5; ++r) *(LAS f32x4*)(red + (kl * 5 + r) * 48 + cgp * 4) = acc[r];
            }
            __syncthreads();
            if (tid < 240) { const int r = tid / 48, c = tid % 48; float s = 0.f;
                for (int q = 0; q < 42; ++q) s += red[(q * 5 + r) * 48 + c];
                mod[(l * 5 + r) * 6144 + j0 + c] = s + a.in[6][l * 6144 + j0 + c]; }
            __syncthreads();
        }
    }
    if (vcu == G - 1) {
        float* rc = (float*)(a.ws + WS_ROPE); float* rs = rc + 2048;
        for (int idx = tid; idx < 2048; idx += 512) { const int pos = idx >> 5, i = idx & 31;
            const float inv = exp2f(-(float)(2 * i) * (1.f / 64.f) * 13.287712379549449f);
            const float ang = (float)pos * inv; rc[idx] = cosf(ang); rs[idx] = sinf(ang); }
    }
    {
        v4u* Wf = (v4u*)(a.ws + WS_WSGU);
        for (int idx = vcu * 512 + tid; idx < 2 * 8 * 4 * 8 * 64; idx += G * 512) { const int ln = idx & 63, ts = (idx >> 6) & 7, pbb = (idx >> 9) & 3, lg = idx >> 11;
            const float* q = a.in[8] + ((size_t)lg * 128 + 32 * pbb + (ln & 31)) * 128 + 16 * ts + 8 * (ln >> 5);
            const f32x4 lo = *(const f32x4*)q, hh = *(const f32x4*)(q + 4);
            v4u o; o.x = pk2(lo[0], lo[1]); o.y = pk2(lo[2], lo[3]); o.z = pk2(hh[0], hh[1]); o.w = pk2(hh[2], hh[3]); Wf[idx] = o; }
    }
    {
        LAS float* scr = (LAS float*)(lds + wave * 16384);
        const int gw = vcu * 8 + wave, NGW = G * 8;
        bf16_t* WinT = (bf16_t*)(a.ws + WS_WIN); bf16_t* WoutT = (bf16_t*)(a.ws + WS_WOUT);
        constexpr int I_IN = 32 * (DIN / 32), I_OUT = 32 * (DM / 32), I_L = I_IN + I_OUT;
        for (int it = gw; it < 2 * I_L; it += NGW) { const int l = it / I_L; const int r = it - l * I_L;
            if (r < I_IN) p0_transpose_item(a.in[7] + (size_t)l * DM * DIN, DM, DIN, WinT + (size_t)l * DIN * DM, true, scr, r, lane);
            else p0_transpose_item(a.in[13] + (size_t)l * DM * DM, DM, DM, WoutT + (size_t)l * DM * DM, false, scr, r - I_IN, lane); }
    }
}
__device__ __forceinline__ void pA_norm(const Args& a, int l, int gw, int NGW, int lane_) {
    int lane = lane_; asm volatile("" : "+v"(lane));
    const float* mod = (const float*)(a.ws + WS_MOD) + (size_t)l * 5 * 6144;
    const float* nw = a.in[4] + l * DM;
    const float* xc1 = (const float*)(a.ws + WS_XC1);
    bf16_t* H = (bf16_t*)(a.ws + WS_H);
    const int rpw = (MROWS + NGW - 1) / NGW;
    const int R0 = gw * rpw, R1 = (R0 + rpw < MROWS) ? R0 + rpw : MROWS;
    int cur = -1; f32x4 g[8], sh[8];
    for (int R = R0; R < R1; ++R) {
        const int b = R / RPB, rb = R - b * RPB; const bool isctx = rb < CTX; const int rm = isctx ? 4 : b;
        if (l == 1 && isctx && NGW == 2048) continue;
        const float* src = (l == 0) ? (isctx ? a.in[2] + (size_t)(b * CTX + rb) * DM : a.in[0] + (size_t)(b * SEQ + rb - CTX) * DM)
                                    : (isctx ? xc1 + (size_t)(b * CTX + rb) * DM : a.out + (size_t)(b * SEQ + rb - CTX) * DM);
        if (rm != cur) { cur = rm;
#pragma unroll
            for (int j = 0; j < 8; ++j) { const int c = 4 * lane + 256 * j; const f32x4 w = *(const f32x4*)(nw + c), sc = *(const f32x4*)(mod + rm * 6144 + 2048 + c);
                g[j] = w * (1.f + sc); sh[j] = *(const f32x4*)(mod + rm * 6144 + c); } }
        f32x4 v[8]; float s = 0.f;
#pragma unroll
        for (int j = 0; j < 8; ++j) { v[j] = *(const f32x4*)(src + 4 * lane + 256 * j); s += (v[j][0] * v[j][0] + v[j][1] * v[j][1]) + (v[j][2] * v[j][2] + v[j][3] * v[j][3]); }
        const float rstd = 1.f / sqrtf(wave_sum(s) * (1.f / DM) + EPS);
        unsigned long long* o8 = (unsigned long long*)(H + (size_t)R * DM) + lane;
#pragma unroll
        for (int j = 0; j < 8; ++j) { const f32x4 y = v[j] * rstd * g[j] + sh[j]; o8[64 * j] = (unsigned long long)pk2(y[0], y[1]) | ((unsigned long long)pk2(y[2], y[3]) << 32); }
    }
}

#define RLX_AGENT __ATOMIC_RELAXED, __HIP_MEMORY_SCOPE_AGENT
#define XB_TMO      128
#define XB_XCNT(j)  (256  + 64 * (j))
#define XB_XSUB(j)  (1280 + 64 * (j))
#define XB_XGEN(j)  (2304 + 64 * (j))
#define XB_TOP      3328
#define XB_TOPGEN   3392
#define XCD_BAR_WORDS 3456
#define XB_SPIN_CAP (1u << 18)

__device__ __forceinline__ unsigned xb_ld(unsigned* p)              { return __hip_atomic_load(p, __ATOMIC_RELAXED, __HIP_MEMORY_SCOPE_AGENT); }
__device__ __forceinline__ unsigned xb_add(unsigned* p, unsigned v) { return __hip_atomic_fetch_add(p, v, __ATOMIC_RELAXED, __HIP_MEMORY_SCOPE_AGENT); }
__device__ __forceinline__ unsigned xb_xcc_id() { return (unsigned)__builtin_amdgcn_s_getreg((3 << 11) | 20) & 0xFu; }
#define XB_SPIN(cond, bar) do { unsigned _sp = 0; while (cond) { __builtin_amdgcn_s_sleep(1); \
    if ((++_sp & 255u) == 0u) { if (xb_ld(&(bar)[XB_TMO])) break; if (_sp > XB_SPIN_CAP) { atomicAdd(&(bar)[XB_TMO], 1u); break; } } } } while (0)

struct XcdBarrier {
    unsigned* bar; unsigned x;
    volatile LAS unsigned* st;
};

__device__ __forceinline__ XcdBarrier xcd_barrier_post(unsigned* bar, volatile LAS unsigned* st) {
    XcdBarrier b; b.bar = bar; b.x = xb_xcc_id(); b.st = st;
    if (threadIdx.x == 0) (void)xb_add(&bar[XB_XCNT(b.x)], 1u);
    return b;
}
__device__ __forceinline__ void xcd_barrier_complete(unsigned* bar, unsigned x, unsigned& nloc, unsigned& nx) {
    const unsigned G = gridDim.x * gridDim.y * gridDim.z;
    unsigned sum, cnt, mine, sp = 0u;
    for (;;) {
        sum = 0u; cnt = 0u; mine = 0u;
#pragma unroll
        for (unsigned j = 0; j < 16; ++j) { const unsigned c = xb_ld(&bar[XB_XCNT(j)]); sum += c; cnt += (c > 0u) ? 1u : 0u; mine = (j == x) ? c : mine; }
        if (sum == G) break;
        __builtin_amdgcn_s_sleep(1);
        if ((++sp & 255u) == 0u) { if (xb_ld(&bar[XB_TMO])) break; if (sp > XB_SPIN_CAP) { atomicAdd(&bar[XB_TMO], 1u); break; } }
    }
    nloc = mine > 0u ? mine : 1u; nx = cnt > 0u ? cnt : 1u;
}

__device__ __forceinline__ void xcd_barrier(const XcdBarrier& b) {
    asm volatile("s_waitcnt vmcnt(0)" ::: "memory");
    __syncthreads();
    if (threadIdx.x == 0) {
        unsigned* bar = b.bar;
        __builtin_amdgcn_s_waitcnt(0);
        unsigned nloc = b.st[0], nx = b.st[1];
        if (nloc == 0u) { xcd_barrier_complete(bar, b.x, nloc, nx); b.st[0] = nloc; b.st[1] = nx; }
        const unsigned old = xb_add(&bar[XB_XSUB(b.x)], 1u);
        const unsigned gen = old / nloc;
        if (old + 1u == (gen + 1u) * nloc) {
            __builtin_amdgcn_fence(__ATOMIC_RELEASE, "agent");
            asm volatile("s_waitcnt vmcnt(0)" ::: "memory");
            const unsigned og = xb_add(&bar[XB_TOP], 1u);
            const unsigned tg = og / nx;
            if (og + 1u == (tg + 1u) * nx) xb_add(&bar[XB_TOPGEN], 1u);
            else XB_SPIN(xb_ld(&bar[XB_TOPGEN]) == tg, bar);
            __builtin_amdgcn_fence(__ATOMIC_ACQUIRE, "agent");
            xb_add(&bar[XB_XGEN(b.x)], 1u);
            asm volatile("s_waitcnt vmcnt(0)" ::: "memory");
        } else {
            XB_SPIN(xb_ld(&bar[XB_XGEN(b.x)]) == gen, bar);
            __builtin_amdgcn_fence(__ATOMIC_ACQUIRE, "agent");
            asm volatile("s_waitcnt vmcnt(0)" ::: "memory");
        }
    }
    __syncthreads();
}

__global__ void __launch_bounds__(512, 2) mk_fwd(Args a) {
    extern __shared__ __attribute__((aligned(16))) unsigned char lds[];
    cg::grid_group grid = cg::this_grid();
    LAS unsigned char* L = (LAS unsigned char*)lds;
    const int tid = threadIdx.x, lane = tid & 63, wave = __builtin_amdgcn_readfirstlane(tid >> 6);
    const int G = gridDim.x, bx = blockIdx.x; const int vcu = (G % 8 == 0) ? (bx % 8) * (G / 8) + bx / 8 : bx;
    const int lo = a.ph_lo, hi = a.ph_hi;
#define IN(k) (lo <= (k) && (k) < hi)
#define SEAM(k) do { if (IN(k) && IN((k) + 1)) { if (a.coop == 2) grid.sync(); else xcd_barrier(xbar); } } while (0)
    volatile LAS unsigned* xst = (volatile LAS unsigned*)(L + XCH_OFF + 8192);
    if (tid < 2) xst[tid] = 0u;
    __syncthreads();
    XcdBarrier xbar; xbar.bar = (unsigned*)(a.ws + WS_BAR); xbar.x = 0; xbar.st = xst;
    if (a.coop) xbar = xcd_barrier_post((unsigned*)(a.ws + WS_BAR), xst);

    bf16_t* Hb = (bf16_t*)(a.ws + WS_H); bf16_t* Pb = (bf16_t*)(a.ws + WS_P);
    if (IN(0)) { p0_prologue(a, L, tid, lane, wave, vcu, G); }
    SEAM(0);
#pragma nounroll
    for (int l = 0; l < 2; ++l) {
        const int pb = 1 + 4 * l;
        if (IN(pb)) { pA_norm(a, l, vcu * 8 + wave, G * 8, lane); }
        SEAM(pb);
        if (IN(pb + 1)) {
            const int m2 = (G == 256) ? 1 : 0;
            pg8::Gemm g{Hb, (const bf16_t*)(a.ws + WS_WIN) + (size_t)l * DIN * DM, MROWS, DIN, DM, Hb, (const bf16_t*)(a.ws + WS_WOUT)};
            pg8::SchedX S; if (l == 0) S.init(68, 22, G, bx, 0, 0); else S.init(64, 22, G, bx, 1, m2 ? 0 : 8, m2, (unsigned*)(a.ws + WS_BAR) + 3584);
            pg8::EpiIn E{Pb, a.in[10] + l * 1024, a.in[11] + l * 128, a.in[12] + l * 128, (const float*)(a.ws + WS_ROPE), (const float*)(a.ws + WS_ROPE) + 2048, (LAS float*)(L + XCH_OFF), (bf16_t*)(a.ws + WS_KC), (bf16_t*)(a.ws + WS_VC),
                         a.in[2], (const float*)(a.ws + WS_MOD) + 4 * 6144 + 4096, (float*)(a.ws + WS_XC1), a.in[4] + DM, (const float*)(a.ws + WS_MOD) + (5 + 4) * 6144, Hb, (unsigned*)(a.ws + WS_BAR) + 3584};
            pg8::gemm_phase<pg8::EpiIn, pg8::SchedX, true, true>(L, g, S, E);
        }
        SEAM(pb + 1);
        if (IN(pb + 2)) {
            const at::bf16* P = (const at::bf16*)Pb; at::bf16* YC = (at::bf16*)Hb;
#pragma nounroll
            for (int st = 0; st < 2; ++st) {
            const bool do_sgu = (((st ^ vcu) & 1) == 0);
            if (do_sgu) { if (a.sub & 1)
            at::sgu_phase(P, YC, (const at::bf16*)(a.ws + WS_WSGU) + (size_t)l * 8 * 128 * 128, a.in[9] + l * 8 * 128, vcu, G, l == 0 ? 136 * 8 : 128 * 8, (char*)lds, l); }
            else {
            const int ntot = (a.sub & 2) ? 512 + (l == 0 ? 32 : 0) : 0;
            for (int i = 0;; ++i) { int Li = i * G + vcu; if (Li >= 512) Li -= 64;
                if (Li >= ntot || (i >= 2 && Li < 512)) break;
                int b, h, qrow, seq;
                if (Li < 512) { const int qb = Li & 15; h = (Li >> 4) & 7; b = Li >> 7; qrow = b * RPB + CTX + qb * 256; seq = RPB; }
                else { const int c = Li - 512; b = c >> 3; h = c & 7; qrow = b * RPB; seq = CTX; }
                const long krow = (long)b * RPB; const int kvh = h >> 2;
                const long kvo = ((long)(b * 2 + kvh) * RPB) * 128;
                at::attn_dense_body(P + (long)qrow * DIN + C_Q + h * 128, (const at::bf16*)(a.ws + WS_KC) + kvo, (const at::bf16*)(a.ws + WS_VC) + kvo,
                                    P + (long)qrow * DIN + C_ZB + h * 128, YC + (long)qrow * DM + 1024 + h * 128, seq, (char*)lds);
                __syncthreads(); } }
            __syncthreads(); }
        }
        SEAM(pb + 2);
        if (IN(pb + 3)) {
            pg8::Gemm g{Hb, (const bf16_t*)(a.ws + WS_WOUT) + (size_t)l * DM * DM, MROWS, DM, DM};
            pg8::SchedX S; if (l == 0 && G != 256) S.init(68, 8, G, bx, 0, 0); else S.init(64, 8, G, bx, 1, 0);
            pg8::EpiOut E{l == 0 ? a.in[0] : a.out, a.in[2], a.out, (float*)(a.ws + WS_XC1), (const float*)(a.ws + WS_MOD) + (size_t)l * 5 * 6144 + 4096};
            pg8::gemm_phase<pg8::EpiOut, pg8::SchedX, false, true>(L, g, S, E);
        }
        SEAM(pb + 3);
    }
#undef IN
#undef SEAM
}

extern "C" void kernel_launch(void* const* d_in, const int* in_sizes, int n_in, void* d_out, int out_size, void* d_ws, size_t ws_size, hipStream_t stream) {
    static int grid = 0;
    if (grid == 0) {
        if (n_in != 14 || in_sizes[0] != NB * SEQ * DM || out_size != NB * SEQ * DM || ws_size < WS_END) {
            fprintf(stderr, "kernel_launch: shape mismatch (n_in %d, in0 %d, out %d, ws %zu; need ws >= %zu); nothing launched\n", n_in, n_in > 0 ? in_sizes[0] : -1, out_size, ws_size, (size_t)WS_END); grid = -1; return; }
        int dev = 0, cus = 0, per_cu = 0;
        if (hipGetDevice(&dev) != hipSuccess || hipDeviceGetAttribute(&cus, hipDeviceAttributeMultiprocessorCount, dev) != hipSuccess) { fprintf(stderr, "kernel_launch: device query failed\n"); grid = -1; return; }
        if (hipFuncSetAttribute((const void*)mk_fwd, hipFuncAttributeMaxDynamicSharedMemorySize, LDS_BYTES) != hipSuccess) { fprintf(stderr, "kernel_launch: hipFuncSetAttribute failed\n"); grid = -1; return; }
        if (hipOccupancyMaxActiveBlocksPerMultiprocessor(&per_cu, (const void*)mk_fwd, 512, LDS_BYTES) != hipSuccess || per_cu < 1) { fprintf(stderr, "kernel_launch: occupancy query says %d blocks per CU\n", per_cu); per_cu = 1; }
        (void)hipGetLastError();
        grid = cus * 1;
    }
    if (grid < 0) return;
    Args a{};
    for (int i = 0; i < 14; ++i) a.in[i] = (const float*)d_in[i];
    a.out = (float*)d_out; a.ws = (unsigned char*)d_ws; a.sub = 3;
#if MK_MULTI
    for (int ph = 0; ph < NPHASE; ++ph) { a.ph_lo = ph; a.ph_hi = ph + 1; a.coop = 0;
        hipLaunchKernelGGL(mk_fwd, dim3(grid), dim3(512), LDS_BYTES, stream, a);
        const hipError_t le = hipPeekAtLastError(); if (le != hipSuccess) { fprintf(stderr, "kernel_launch: launch %d failed: %s\n", ph, hipGetErrorName(le)); break; }
#ifdef PROBE_PH
        if ((PROBE_PH >> ph) & 1) { a.sub = PROBE_SUB; hipLaunchKernelGGL(mk_fwd, dim3(grid), dim3(512), LDS_BYTES, stream, a); a.sub = 3; }
#endif
    }
#else
    a.ph_lo = 0; a.ph_hi = NPHASE; a.coop = 1;
    if (hipMemsetAsync((char*)d_ws + WS_BAR, 0, 16384, stream) != hipSuccess) { fprintf(stderr, "kernel_launch: hipMemsetAsync of the barrier words failed\n"); return; }
    void* args[] = {&a};
    const hipError_t e = hipLaunchCooperativeKernel((const void*)mk_fwd, dim3(grid), dim3(512), args, LDS_BYTES, stream);
    if (e != hipSuccess) fprintf(stderr, "kernel_launch: cooperative launch failed: %s (grid %d)\n", hipGetErrorString(e), grid);
#endif
}
```

```cpp
#include <hip/hip_runtime.h>
#include <hip/hip_cooperative_groups.h>
#include <hip/hip_bf16.h>
#include <cstdio>
#include <cstdint>
namespace cg = cooperative_groups;

#ifndef MK_MULTI
#define MK_MULTI 0
#endif

constexpr int DM = 2048, NB = 4, SEQ = 4096, CTX = 256, RPB = CTX + SEQ, MROWS = NB * RPB, DIN = 5632;
constexpr int C_U = 0, C_V = 1024, C_ZA = 2048, C_Q = 3072, C_K = 4096, C_VA = 4352, C_ZB = 4608;
constexpr int TPB = RPB / 256;
constexpr float EPS = 1e-6f;
constexpr int NPHASE = 9;
constexpr size_t MiB = 1u << 20;
constexpr size_t WS_MOD = 0;
constexpr size_t WS_ROPE = 1 * MiB;
constexpr size_t WS_WSGU = 2 * MiB;
constexpr size_t WS_BAR = 3 * MiB;
constexpr size_t WS_XC1 = 4 * MiB;
constexpr size_t WS_WIN = 16 * MiB;
constexpr size_t WS_WOUT = 64 * MiB;
constexpr size_t WS_H = 80 * MiB;
constexpr size_t WS_P = 160 * MiB;
constexpr size_t WS_KC = 352 * MiB;
constexpr size_t WS_VC = 368 * MiB;
constexpr size_t WS_END = 384 * MiB;
constexpr int LDS_BYTES = 147456;
constexpr int XCH_OFF = 131072;

struct Args { const float* in[14]; float* out; unsigned char* ws; int ph_lo, ph_hi, coop, sub; };
#define LAS __attribute__((address_space(3)))
namespace pg8 {
#define PG8_LAS __attribute__((address_space(3)))
typedef unsigned short bf16_t;
typedef short bf16x8 __attribute__((ext_vector_type(8)));
typedef float f32x4 __attribute__((ext_vector_type(4)));
typedef unsigned u32x4 __attribute__((ext_vector_type(4)));
constexpr int BM = 256, BK = 64, HALF = 128, HTB = HALF * BK * 2  , STAGE_BYTES = 8 * HTB, NXCD = 8, WGM = 8;

__host__ __device__ __forceinline__ int lds_byte(int r, int c) { const int st = (r >> 4) * 2 + (c >> 5), rr = r & 15, cc = c & 31, ob = rr * 64 + cc * 2; return st * 1024 + (ob ^ (((ob >> 9) & 1) << 5)); }
__host__ __device__ __forceinline__ void stage_rc(int b, int& R, int& C) { const int st = b / 1024, sb = b % 1024, swz = sb ^ (((sb >> 9) & 1) << 5); R = (st >> 1) * 16 + swz / 64; C = (st & 1) * 32 + (swz % 64) / 2; }
__host__ __device__ __forceinline__ int perm32(int rho) { const int n = rho >> 4, i = rho & 15; return 8 * (i >> 2) + 4 * n + (i & 3); }

struct Unit { int pm, pn, kind; };
struct Gemm { const bf16_t* A; const bf16_t* Bt; int M, N, K; const bf16_t* A2; const bf16_t* B2; };

struct StaticOrder {
    int nM, nN, nwg, G, c;
    __host__ __device__ void init(int M, int N, int G_, int c_) { nM = M / BM; nN = N / BM; nwg = nM * nN; G = G_; c = c_; }
    __host__ __device__ bool next(int i, Unit& u) const {
        const long L = (long)i * G + c; if (L >= nwg) return false;
        int wgid = (int)L; { const int q = nwg / NXCD, r = nwg % NXCD, xcd = wgid % NXCD, off = wgid / NXCD; wgid = (xcd < r ? xcd * (q + 1) : r * (q + 1) + (xcd - r) * q) + off; }
        const int nig = WGM * nN, gid = wgid / nig, fm = gid * WGM, gsz = (nM - fm) < WGM ? (nM - fm) : WGM;
        u.pm = fm + ((wgid % nig) % gsz); u.pn = (wgid % nig) / gsz; return true;
    }
    __device__ __forceinline__ void a_ready(const Unit&) const {}
    __device__ __forceinline__ void done(const Unit&) const {}
};

__device__ __forceinline__ unsigned cvt_pk_bf16(float lo, float hi) { unsigned r; asm volatile("v_cvt_pk_bf16_f32 %0, %1, %2" : "=v"(r) : "v"(lo), "v"(hi)); return r; }
typedef float f32x2 __attribute__((ext_vector_type(2)));
__device__ __forceinline__ f32x4 gelu4(f32x4 x) {
    f32x4 o;
#pragma unroll
    for (int i = 0; i < 4; ++i) { const float v = x[i], t = v * (1.f + 0.044715f * v * v); const float e = __builtin_amdgcn_exp2f(-2.3022081981f * t); o[i] = v * __builtin_amdgcn_rcpf(1.f + e); }
    return o;
}
__device__ __forceinline__ f32x4 silu4(f32x4 x) {
    f32x4 o;
#pragma unroll
    for (int i = 0; i < 4; ++i) { const float v = x[i]; const float e = __builtin_amdgcn_exp2f(-1.4426950409f * v); o[i] = v * __builtin_amdgcn_rcpf(1.f + e); }
    return o;
}
__device__ __forceinline__ void store8(bf16_t* p, f32x4 v0, f32x4 v1) {
    u32x4 w; w.x = cvt_pk_bf16(v0[0], v0[1]); w.y = cvt_pk_bf16(v0[2], v0[3]); w.z = cvt_pk_bf16(v1[0], v1[1]); w.w = cvt_pk_bf16(v1[2], v1[3]); *(u32x4*)p = w;
}
struct EpiIn {
    static constexpr bool PERM = true, AFTER_DRAIN = false;
    bf16_t* P; const float* vnw; const float* qnw; const float* knw; const float* ropec; const float* ropes; PG8_LAS float* xch; bf16_t* Kc; bf16_t* Vc;
    const float* cx_in; const float* cx_gate; float* xc1; const float* nrm_w; const float* nrm_mod; bf16_t* Hout; unsigned* cnt;
    __device__ __forceinline__ void operator()(f32x4 (&acc)[2][2][4][2], const Unit& u, int wr, int wc, int fr, int fq) const {
        if (u.kind == 1) { ctx_out(acc, u, wr, wc, fr, fq); return; }
        const int pn = u.pn;
        const int colw = wc * 32 + 8 * fq;
        bf16_t* base = P + (size_t)(u.pm * 256 + wr * 64 + fr) * 5632 + pn * 256 + colw;
        if (pn == 17) {
            const int b = u.pm / 17, rb = (u.pm % 17) * 256 + wr * 64 + fr;
            bf16_t* vb_ = Vc + ((size_t)(b * 2) * 4352 + rb) * 128 + colw;
#pragma unroll
            for (int ai = 0; ai < 2; ++ai)
#pragma unroll
                for (int m = 0; m < 4; ++m)
#pragma unroll
                    for (int bj = 0; bj < 2; ++bj) store8(vb_ + ((size_t)bj * 4352 + ai * 128 + m * 16) * 128, acc[ai][bj][m][0], acc[ai][bj][m][1]);
            return;
        }
        if (pn < 4 || (pn >= 8 && pn < 12) || pn >= 17) {
            const int act = pn < 4 ? 0 : (pn == 17 ? 2 : 1);
#pragma unroll
            for (int ai = 0; ai < 2; ++ai)
#pragma unroll
                for (int m = 0; m < 4; ++m) { bf16_t* rp = base + (size_t)(ai * 128 + m * 16) * 5632;
#pragma unroll
                    for (int bj = 0; bj < 2; ++bj) { f32x4 v0 = acc[ai][bj][m][0], v1 = acc[ai][bj][m][1];
                        if (act == 0) { v0 = gelu4(v0); v1 = gelu4(v1); } else if (act == 1) { v0 = silu4(v0); v1 = silu4(v1); }
                        store8(rp + bj * 128, v0, v1); } }
            return;
        }
        if (pn < 8) gn_path<true>(acc, u, wr, wc, fr, fq, base, colw); else gn_path<false>(acc, u, wr, wc, fr, fq, base, colw);
    }
    __device__ __forceinline__ void ctx_out(const f32x4 (&acc)[2][2][4][2], const Unit& u, int wr, int wc, int fr, int fq) const {
        const int b = u.pm / 17;
        const int col0 = u.pn * 256 + wc * 32 + 8 * fq;
        f32x4 gv[2][2];
#pragma unroll
        for (int bj = 0; bj < 2; ++bj)
#pragma unroll
            for (int n = 0; n < 2; ++n) gv[bj][n] = *(const f32x4*)(cx_gate + col0 + bj * 128 + 4 * n);
        const size_t rbase = (size_t)(b * 256 + wr * 64 + fr) * 2048 + col0;
#pragma unroll
        for (int ai = 0; ai < 2; ++ai)
#pragma unroll
            for (int m = 0; m < 4; ++m) { const size_t ro = rbase + (size_t)(ai * 128 + m * 16) * 2048;
                f32x4 xs[2][2];
#pragma unroll
                for (int bj = 0; bj < 2; ++bj)
#pragma unroll
                    for (int n = 0; n < 2; ++n) xs[bj][n] = *(const f32x4*)(cx_in + ro + bj * 128 + 4 * n);
#pragma unroll
                for (int bj = 0; bj < 2; ++bj)
#pragma unroll
                    for (int n = 0; n < 2; ++n) { const f32x4 o = xs[bj][n] + gv[bj][n] * acc[ai][bj][m][n]; float* dp = xc1 + ro + bj * 128 + 4 * n;
                        asm volatile("global_store_dwordx4 %0, %1, off sc1\n\ts_nop 1" :: "v"(dp), "v"(o) : "memory"); }
                if (m & 1) asm volatile("" ::: "memory"); }
        const bool t0 = (wr == 0 && wc == 0 && fr == 0 && fq == 0);
        asm volatile("s_waitcnt vmcnt(0)" ::: "memory"); __builtin_amdgcn_s_barrier(); asm volatile("" ::: "memory");
        if (t0) { __hip_atomic_fetch_add(cnt + 64 * b, 1u, __ATOMIC_RELAXED, __HIP_MEMORY_SCOPE_AGENT);
            unsigned sp = 0; while (__hip_atomic_load(cnt + 64 * b, __ATOMIC_RELAXED, __HIP_MEMORY_SCOPE_AGENT) < 8u && ++sp < (1u << 18)) __builtin_amdgcn_s_sleep(2);
            __builtin_amdgcn_fence(__ATOMIC_ACQUIRE, "agent"); asm volatile("s_waitcnt vmcnt(0)" ::: "memory"); }
        __builtin_amdgcn_s_barrier(); asm volatile("" ::: "memory");
        { const int w8 = wr * 4 + wc, lane = fr + 16 * fq;
          f32x4 g[8], sh[8];
#pragma unroll
          for (int j = 0; j < 8; ++j) { const int c = 4 * lane + 256 * j; const f32x4 w = *(const f32x4*)(nrm_w + c), sc = *(const f32x4*)(nrm_mod + 2048 + c); g[j] = w * (1.f + sc); sh[j] = *(const f32x4*)(nrm_mod + c); }
          for (int rr = 0; rr < 4; ++rr) { const int rb = u.pn * 32 + w8 * 4 + rr;
              const float* src = xc1 + (size_t)(b * 256 + rb) * 2048;
              f32x4 v[8]; float ss = 0.f;
#pragma unroll
              for (int j = 0; j < 8; ++j) { v[j] = *(const f32x4*)(src + 4 * lane + 256 * j); ss += (v[j][0] * v[j][0] + v[j][1] * v[j][1]) + (v[j][2] * v[j][2] + v[j][3] * v[j][3]); }
#pragma unroll
              for (int o = 1; o < 64; o <<= 1) ss += __shfl_xor(ss, o);
              const float rstd = 1.f / sqrtf(ss * (1.f / 2048.f) + 1e-6f);
              unsigned long long* o8 = (unsigned long long*)(Hout + (size_t)(b * 4352 + rb) * 2048) + lane;
#pragma unroll
              for (int j = 0; j < 8; ++j) { const f32x4 y = v[j] * rstd * g[j] + sh[j]; __hip_atomic_store(o8 + 64 * j, (unsigned long long)cvt_pk_bf16(y[0], y[1]) | ((unsigned long long)cvt_pk_bf16(y[2], y[3]) << 32), __ATOMIC_RELAXED, __HIP_MEMORY_SCOPE_AGENT); } } }
        asm volatile("s_waitcnt vmcnt(0)" ::: "memory"); __builtin_amdgcn_s_barrier(); asm volatile("" ::: "memory");
        if (t0) { __hip_atomic_fetch_add(cnt + 256 + 64 * b, 1u, __ATOMIC_RELAXED, __HIP_MEMORY_SCOPE_AGENT); }
    }
    template <bool ISV>
    __device__ __forceinline__ void gn_path(const f32x4 (&acc)[2][2][4][2], const Unit& u, int wr, int wc, int fr, int fq, bf16_t* base, int colw) const {
        const int pn = u.pn;
#pragma unroll
        for (int ai = 0; ai < 2; ++ai)
#pragma unroll
            for (int m = 0; m < 4; ++m)
#pragma unroll
                for (int bj = 0; bj < 2; ++bj) { f32x4 a = acc[ai][bj][m][0], b = acc[ai][bj][m][1];
                    if (ISV) { a = gelu4(a); b = gelu4(b); }
                    float s = (a[0] * a[0] + a[1] * a[1]) + (a[2] * a[2] + a[3] * a[3]) + (b[0] * b[0] + b[1] * b[1]) + (b[2] * b[2] + b[3] * b[3]);
                    s += __shfl_xor(s, 16); s += __shfl_xor(s, 32);
                    if (fq == 0) xch[(ai * 128 + wr * 64 + m * 16 + fr) * 8 + bj * 4 + wc] = s;
                    if (ISV) __builtin_amdgcn_sched_barrier(0); }
        asm volatile("s_waitcnt lgkmcnt(0)" ::: "memory"); __builtin_amdgcn_s_barrier(); asm volatile("" ::: "memory");
        f32x4 w[2][2];
        if (ISV) {
#pragma unroll
            for (int bj = 0; bj < 2; ++bj)
#pragma unroll
                for (int n = 0; n < 2; ++n) w[bj][n] = *(const f32x4*)(vnw + ((pn - 4) * 2 + bj) * 128 + colw + 4 * n);
        } else {
            const float* nwp = pn < 16 ? qnw : knw; const int dlo = 64 * (wc >> 1) + 16 * (wc & 1) + 4 * fq;
            w[0][0] = *(const f32x4*)(nwp + dlo); w[0][1] = *(const f32x4*)(nwp + dlo + 32); w[1][0] = w[0][0]; w[1][1] = w[0][1];
        }
        const int jt = u.pm % 17;
        const bool rope = !ISV && jt != 0;
#pragma unroll
        for (int ai = 0; ai < 2; ++ai)
#pragma unroll
            for (int m = 0; m < 4; ++m) { const int rl = ai * 128 + wr * 64 + m * 16 + fr; bf16_t* rp = base + (size_t)(ai * 128 + m * 16) * 5632; size_t bjs = 128;
                if (!ISV) { if (pn == 16) { rp = Kc + ((size_t)((u.pm / 17) * 2) * 4352 + jt * 256 + rl) * 128 + colw; bjs = (size_t)4352 * 128; } }
                f32x4 cs = {1.f, 1.f, 1.f, 1.f}, sn = {0.f, 0.f, 0.f, 0.f};
                if (!ISV) { if (rope) { const int t = jt * 256 + rl - 256; const int pos = (wc >> 1) ? (t & 63) : (t >> 6); const int fi = pos * 32 + 16 * (wc & 1) + 4 * fq;
                    cs = *(const f32x4*)(ropec + fi); sn = *(const f32x4*)(ropes + fi); } }
#pragma unroll
                for (int bj = 0; bj < 2; ++bj) { const f32x4 pr = *(const PG8_LAS f32x4*)(xch + rl * 8 + bj * 4);
                    const float rstd = __builtin_amdgcn_rsqf(((pr[0] + pr[1]) + (pr[2] + pr[3])) * (1.f / 128.f) + 1e-6f);
                    f32x4 a0 = acc[ai][bj][m][0], a1 = acc[ai][bj][m][1];
                    if (ISV) { asm volatile("" : "+v"(a0), "+v"(a1));
                        a0 = gelu4(a0); a1 = gelu4(a1); }
                    a0 = a0 * rstd * w[bj][0]; a1 = a1 * rstd * w[bj][1];
                    if (!ISV) { const f32x4 o0 = a0 * cs - a1 * sn, o1 = a1 * cs + a0 * sn; a0 = o0; a1 = o1; }
                    store8(rp + bj * bjs, a0, a1); }
                asm volatile("" ::: "memory"); }
    }
};
struct EpiOut {
    static constexpr bool PERM = false, AFTER_DRAIN = false;
    const float* xsrc; const float* csrc; float* xdst; float* cdst; const float* gate;
    __device__ __forceinline__ void operator()(f32x4 (&acc)[2][2][4][2], const Unit& u, int wr, int wc, int fr, int fq) const {
        const int b = u.pm / 17, jt = u.pm % 17;
        const float* src; float* dst; int grow;
        if (jt == 0) { const size_t off = (size_t)(b * 256) * 2048; src = csrc + off; dst = cdst + off; grow = 4; }
        else { const size_t off = (size_t)(b * 4096 + (jt - 1) * 256) * 2048; src = xsrc + off; dst = xdst + off; grow = b; }
        const int col0 = u.pn * 256 + wc * 32 + 4 * fq;
        f32x4 gv[2][2];
#pragma unroll
        for (int bj = 0; bj < 2; ++bj)
#pragma unroll
            for (int n = 0; n < 2; ++n) gv[bj][n] = *(const f32x4*)(gate + grow * 6144 + col0 + bj * 128 + n * 16);
#pragma unroll
        for (int ai = 0; ai < 2; ++ai)
#pragma unroll
            for (int m = 0; m < 4; ++m) { const size_t ro = (size_t)(wr * 64 + fr + ai * 128 + m * 16) * 2048 + col0;
                f32x4 xs[2][2];
#pragma unroll
                for (int bj = 0; bj < 2; ++bj)
#pragma unroll
                    for (int n = 0; n < 2; ++n) xs[bj][n] = *(const f32x4*)(src + ro + bj * 128 + n * 16);
#pragma unroll
                for (int bj = 0; bj < 2; ++bj)
#pragma unroll
                    for (int n = 0; n < 2; ++n) *(f32x4*)(dst + ro + bj * 128 + n * 16) = xs[bj][n] + gv[bj][n] * acc[ai][bj][m][n];
                if (m & 1) asm volatile("" ::: "memory"); }
    }
};
struct SchedX {
    int nM, nN, nwg, G, c, lat, extra, m2; unsigned* cnt;
    __device__ void init(int nM_, int nN_, int G_, int c_, int lat_, int extra_, int m2_ = 0, unsigned* cnt_ = nullptr) { nM = nM_; nN = nN_; nwg = nM_ * nN_; G = G_; c = c_; lat = lat_; extra = extra_; m2 = m2_; cnt = cnt_; }
    __device__ __forceinline__ void map(int wgid0, Unit& u) const {
        int wgid = wgid0; { const int q = nwg / NXCD, r = nwg % NXCD, xcd = wgid % NXCD, off = wgid / NXCD; wgid = (xcd < r ? xcd * (q + 1) : r * (q + 1) + (xcd - r) * q) + off; }
        const int nig = WGM * nN, gid = wgid / nig, fm = gid * WGM, gsz = (nM - fm) < WGM ? (nM - fm) : WGM;
        const int pmq = fm + ((wgid % nig) % gsz); u.pn = (wgid % nig) / gsz;
        u.pm = lat ? (pmq / 16) * 17 + 1 + (pmq % 16) : pmq;
    }
    __device__ bool next(int i, Unit& u) const {
        u.kind = 0;
        if (m2) {
            int ir = i;
            if (c >= 128 && c < 160) { if (i == 0) { const int j = c - 128; u.kind = 1; u.pm = (j >> 3) * 17; u.pn = j & 7; return true; }
                ir = i - 1; if (ir >= 4) return false; }
            if (c >= 168 && c < 200 && ir == 5) { map(4 * G + (c - 40), u); return true; }
            const long L2 = (long)ir * G + c;
            if (L2 < nwg) { map((int)L2, u); return true; }
            if (c >= 160 && c < 168 && ir == 5) { const int j = c - 160, b = j >> 1; unsigned sp = 0;
                while (__hip_atomic_load(cnt + 256 + 64 * b, __ATOMIC_RELAXED, __HIP_MEMORY_SCOPE_AGENT) < 8u && ++sp < (1u << 18)) __builtin_amdgcn_s_sleep(2);
                __builtin_amdgcn_fence(__ATOMIC_ACQUIRE, "agent");
                u.pm = b * 17; u.pn = 16 + (j & 1); return true; }
            return false;
        }
        long L = (long)i * G + c;
        if (L < nwg) { map((int)L, u); return true; }
        L -= nwg; if (L < extra) { u.pm = (int)(L >> 1) * 17; u.pn = 16 + (int)(L & 1); return true; }
        return false;
    }
    __device__ __forceinline__ void a_ready(const Unit&) const {}
    __device__ __forceinline__ void done(const Unit&) const {}
};
template <class Epi, class Sched, bool ALIGN_EPI = false, bool SP2 = false>
__device__ __forceinline__ void gemm_phase(PG8_LAS unsigned char* lds, const Gemm g, const Sched& S, const Epi& E) {
    int tid_ = threadIdx.x; asm volatile("" : "+v"(tid_));
    const int tid = tid_, wid = __builtin_amdgcn_readfirstlane(tid >> 6), lane = tid & 63, wr = wid >> 2, wc = wid & 3, fr = lane & 15, fq = lane >> 4;
    const int K = g.K, nt = K / BK;
    unsigned voffA[2], voffB[2];
#pragma unroll
    for (int i = 0; i < 2; ++i) { int R, C; stage_rc(tid * 16 + i * 8192, R, C); const int Rb = Epi::PERM ? ((R & ~31) + perm32(R & 31)) : R;
        voffA[i] = (unsigned)(R * K + C) * 2u; voffB[i] = (unsigned)(Rb * K + C) * 2u; }
    const size_t kstep = (size_t)(BK * 2);
    const size_t hstep = (size_t)HALF * K * 2;
    const size_t tstep = 2 * hstep;
    const unsigned ldsw = (unsigned)wid * 1024u;
    const int aoff = lds_byte(wr * 64 + fr, fq * 8), boff = lds_byte(wc * 32 + fr, fq * 8);
#define PG8_SA(b, h) (((b) * 2 + (h)) * HTB)
#define PG8_SB(b, h) ((4 + (b) * 2 + (h)) * HTB)
#define PG8_STAGE(bufoff, gbase, voff) do { _Pragma("unroll") for (int _i = 0; _i < 2; ++_i) \
        __builtin_amdgcn_global_load_lds((const unsigned*)((const char*)(gbase) + (voff)[_i]), (PG8_LAS unsigned*)(lds + (bufoff) + ldsw + _i * 8192), 16, 0, 0); } while (0)
#define PG8_LDA(dst, b, h) do { _Pragma("unroll") for (int m = 0; m < 4; ++m) _Pragma("unroll") for (int k = 0; k < 2; ++k) dst[m][k] = *(const PG8_LAS bf16x8*)(lds + PG8_SA(b, h) + aoff + m * 2048 + k * 1024); } while (0)
#define PG8_LDB(dst, b, h) do { _Pragma("unroll") for (int n = 0; n < 2; ++n) _Pragma("unroll") for (int k = 0; k < 2; ++k) dst[n][k] = *(const PG8_LAS bf16x8*)(lds + PG8_SB(b, h) + boff + n * 2048 + k * 1024); } while (0)
#define PG8_MMA(ai, bj, At, Bt) do { __builtin_amdgcn_s_setprio(1); _Pragma("unroll") for (int m = 0; m < 4; ++m) _Pragma("unroll") for (int n = 0; n < 2; ++n) _Pragma("unroll") for (int k = 0; k < 2; ++k) \
        acc[ai][bj][m][n] = __builtin_amdgcn_mfma_f32_16x16x32_bf16(Bt[n][k], At[m][k], acc[ai][bj][m][n], 0, 0, 0); __builtin_amdgcn_s_setprio(0); } while (0)
#define PG8_WAIT_V(n) asm volatile("s_waitcnt vmcnt(" #n ")" ::: "memory")
#define PG8_WAIT_L(n) asm volatile("s_waitcnt lgkmcnt(" #n ")" ::: "memory")
#define PG8_BAR __builtin_amdgcn_s_barrier()
#define PG8_SCHED __builtin_amdgcn_sched_barrier(0)
    Unit cur, nxt; int ui = 0;
    if (!S.next(0, cur)) return;
    f32x4 acc[2][2][4][2];
#pragma unroll
    for (int a = 0; a < 2; ++a)
#pragma unroll
        for (int b = 0; b < 2; ++b)
#pragma unroll
            for (int m = 0; m < 4; ++m)
#pragma unroll
                for (int n = 0; n < 2; ++n) acc[a][b][m][n] = (f32x4){0.f, 0.f, 0.f, 0.f};
    bf16x8 At[4][2], B0[2][2], B1[2][2];
    const char* cA = (const char*)(cur.kind ? g.A2 : g.A) + (size_t)cur.pm * tstep; const char* cB = (const char*)(cur.kind ? g.B2 : g.Bt) + (size_t)cur.pn * tstep;
    S.a_ready(cur);
    if constexpr (SP2) {
        PG8_STAGE(PG8_SB(0, 0), cB, voffB); PG8_STAGE(PG8_SB(0, 1), cB + hstep, voffB); PG8_STAGE(PG8_SA(0, 0), cA, voffA); PG8_STAGE(PG8_SA(0, 1), cA + hstep, voffA);
        if (wr == 1) PG8_BAR;
        PG8_WAIT_V(2); PG8_BAR;
        PG8_STAGE(PG8_SB(1, 0), cB + kstep, voffB); PG8_STAGE(PG8_SA(1, 0), cA + kstep, voffA); PG8_STAGE(PG8_SB(1, 1), cB + hstep + kstep, voffB);
        PG8_WAIT_V(6); PG8_BAR;
    } else {
        PG8_STAGE(PG8_SB(0, 0), cB, voffB); PG8_STAGE(PG8_SA(0, 0), cA, voffA); PG8_STAGE(PG8_SB(0, 1), cB + hstep, voffB); PG8_STAGE(PG8_SA(0, 1), cA + hstep, voffA);
        if (wr == 1) PG8_BAR;
        PG8_WAIT_V(4); PG8_BAR;
        PG8_STAGE(PG8_SB(1, 0), cB + kstep, voffB); PG8_STAGE(PG8_SA(1, 0), cA + kstep, voffA); PG8_STAGE(PG8_SB(1, 1), cB + hstep + kstep, voffB);
        PG8_WAIT_V(6); PG8_BAR;
    }
    for (;;) {
        const bool has_next = S.next(ui + 1, nxt);
        const char* nA = has_next ? (const char*)(nxt.kind ? g.A2 : g.A) + (size_t)nxt.pm * tstep : cA; const char* nB = has_next ? (const char*)(nxt.kind ? g.B2 : g.Bt) + (size_t)nxt.pn * tstep : cB;
        for (int t = 0; t < nt; t += 2) {
            const bool last = (t == nt - 2);
            const char* a1 = cA + (size_t)(t + 1) * kstep;
            const char* a2 = last ? nA : cA + (size_t)(t + 2) * kstep; const char* b2 = last ? nB : cB + (size_t)(t + 2) * kstep;
            const char* a3 = a2 + kstep; const char* b3 = b2 + kstep;
            if (last && has_next) S.a_ready(nxt);
            if constexpr (SP2) {
            PG8_LDB(B0, 0, 0); PG8_LDB(B1, 0, 1); PG8_SCHED; PG8_LDA(At, 0, 0); PG8_STAGE(PG8_SA(1, 1), a1 + hstep, voffA);
            PG8_WAIT_V(8); PG8_WAIT_L(0); PG8_BAR; PG8_MMA(0, 0, At, B0); PG8_MMA(0, 1, At, B1); PG8_BAR; PG8_SCHED;
            PG8_LDA(At, 0, 1); PG8_STAGE(PG8_SB(0, 0), b2, voffB); PG8_STAGE(PG8_SB(0, 1), b2 + hstep, voffB); PG8_STAGE(PG8_SA(0, 0), a2, voffA);
            PG8_WAIT_V(8); PG8_WAIT_L(0); PG8_BAR; PG8_MMA(1, 0, At, B0); PG8_MMA(1, 1, At, B1); PG8_BAR; PG8_SCHED;
            PG8_LDB(B0, 1, 0); PG8_LDB(B1, 1, 1); PG8_SCHED; PG8_LDA(At, 1, 0); PG8_STAGE(PG8_SA(0, 1), a2 + hstep, voffA);
            PG8_WAIT_V(8); PG8_WAIT_L(0); PG8_BAR; PG8_MMA(0, 0, At, B0); PG8_MMA(0, 1, At, B1); PG8_BAR; PG8_SCHED;
            PG8_LDA(At, 1, 1); PG8_STAGE(PG8_SB(1, 0), b3, voffB); PG8_STAGE(PG8_SB(1, 1), b3 + hstep, voffB); PG8_STAGE(PG8_SA(1, 0), a3, voffA);
            PG8_WAIT_V(8); PG8_WAIT_L(0); PG8_BAR; PG8_MMA(1, 0, At, B0); PG8_MMA(1, 1, At, B1); PG8_BAR; PG8_SCHED;
            } else {
            PG8_LDB(B0, 0, 0); PG8_SCHED; PG8_LDA(At, 0, 0); PG8_STAGE(PG8_SA(1, 1), a1 + hstep, voffA);
            PG8_WAIT_L(8); PG8_BAR; PG8_WAIT_L(0); PG8_MMA(0, 0, At, B0); PG8_BAR; PG8_SCHED;
            PG8_LDB(B1, 0, 1); PG8_STAGE(PG8_SB(0, 0), b2, voffB);
            PG8_BAR; PG8_WAIT_L(0); PG8_MMA(0, 1, At, B1); PG8_BAR;
            PG8_LDA(At, 0, 1); PG8_STAGE(PG8_SA(0, 0), a2, voffA);
            PG8_BAR; PG8_WAIT_L(0); PG8_MMA(1, 0, At, B0); PG8_BAR; PG8_SCHED;
            PG8_STAGE(PG8_SB(0, 1), b2 + hstep, voffB);
            PG8_WAIT_V(6); PG8_BAR; PG8_MMA(1, 1, At, B1); PG8_BAR;
            PG8_LDB(B0, 1, 0); PG8_SCHED; PG8_LDA(At, 1, 0); PG8_STAGE(PG8_SA(0, 1), a2 + hstep, voffA);
            PG8_WAIT_L(8); PG8_BAR; PG8_WAIT_L(0); PG8_MMA(0, 0, At, B0); PG8_BAR; PG8_SCHED;
            PG8_LDB(B1, 1, 1); PG8_STAGE(PG8_SB(1, 0), b3, voffB);
            PG8_BAR; PG8_WAIT_L(0); PG8_MMA(0, 1, At, B1); PG8_BAR;
            PG8_LDA(At, 1, 1); PG8_STAGE(PG8_SA(1, 0), a3, voffA);
            PG8_BAR; PG8_WAIT_L(0); PG8_MMA(1, 0, At, B0); PG8_BAR; PG8_SCHED;
            PG8_STAGE(PG8_SB(1, 1), b3 + hstep, voffB);
            PG8_WAIT_V(6); PG8_BAR; PG8_MMA(1, 1, At, B1); PG8_BAR;
            }
        }
        if constexpr (ALIGN_EPI) { if (wr == 0) PG8_BAR; }
        if constexpr (!Epi::AFTER_DRAIN) { int fr_e = fr, fq_e = fq; asm volatile("" : "+v"(fr_e), "+v"(fq_e));
            E(acc, cur, wr, wc, fr_e, fq_e); S.done(cur); }
        if (!has_next) break;
#pragma unroll
        for (int a = 0; a < 2; ++a)
#pragma unroll
            for (int b = 0; b < 2; ++b)
#pragma unroll
                for (int m = 0; m < 4; ++m)
#pragma unroll
                    for (int n = 0; n < 2; ++n) acc[a][b][m][n] = (f32x4){0.f, 0.f, 0.f, 0.f};
        cur = nxt; cA = nA; cB = nB; ++ui;
        if constexpr (ALIGN_EPI) { if (wr == 1) PG8_BAR; }
    }
    PG8_WAIT_V(0);
    if constexpr (!ALIGN_EPI) { if (wr == 0) PG8_BAR; }
    PG8_BAR;
    if constexpr (Epi::AFTER_DRAIN) { E.fused(acc, cur, wr, wc, fr, fq, lds, wid, lane); S.done(cur); }
#undef PG8_SA
#undef PG8_SB
#undef PG8_STAGE
#undef PG8_LDA
#undef PG8_LDB
#undef PG8_MMA
#undef PG8_WAIT_V
#undef PG8_WAIT_L
#undef PG8_BAR
#undef PG8_SCHED
}
}
namespace at {
using bf16 = __hip_bfloat16;
constexpr int   D = 128, NW = 8, QBLK = 32, KVBLK = 64;
constexpr float SCALE = 0.088388347648318440f;
#ifndef ATTN_THR
#define ATTN_THR 8.f
#endif
constexpr float THR = ATTN_THR;
constexpr int SDEPTH = 2;
constexpr int LDQ = 5632, LDK = 128, LDO = 2048;
constexpr size_t SHM_V = KVBLK * D * 2, SHM_K = KVBLK * D * 2, SHM_ATTN = 2 * SHM_V + 2 * SHM_K + NW * 64 * 4;
using f32x4v = __attribute__((ext_vector_type(4))) float;
using bf16x8 = __attribute__((ext_vector_type(8))) short;
using s16x4  = __attribute__((ext_vector_type(4))) short;
using f32x16 = __attribute__((ext_vector_type(16))) float;
using f32x8  = __attribute__((ext_vector_type(8))) float;
using u32x4  = __attribute__((ext_vector_type(4))) unsigned;
#define KSWZ(row, colB) ((row) * 256 + ((colB) ^ (((row) & 7) << 4)))
#define SBAR() __builtin_amdgcn_sched_barrier(0)
__device__ __forceinline__ int crow(int r, int hi) { return (r & 3) + 8 * (r >> 2) + 4 * hi; }
__device__ __forceinline__ unsigned cvtpk(float lo, float hi) {
  unsigned r; asm volatile("v_cvt_pk_bf16_f32 %0, %1, %2" : "=v"(r) : "v"(lo), "v"(hi)); return r;
}
template <typename TIn> struct Stage;
template <> struct Stage<bf16>  { using T = bf16x8;
  __device__ static __forceinline__ T ld8(const bf16* p) { return *reinterpret_cast<const bf16x8*>(p); }
  __device__ static __forceinline__ bf16x8 tobf(T x) { return x; } };
template <> struct Stage<float> { using T = f32x8;
  __device__ static __forceinline__ T ld8(const float* p) { return *reinterpret_cast<const f32x8*>(p); }
  __device__ static __forceinline__ bf16x8 tobf(T x) {
    u32x4 w = {cvtpk(x[0], x[1]), cvtpk(x[2], x[3]), cvtpk(x[4], x[5]), cvtpk(x[6], x[7])}; return *reinterpret_cast<bf16x8*>(&w); } };

__device__ __forceinline__ void partialSM(f32x16& p0, f32x16& p1, float& m_reg, float& mn, float& alpha) {
  constexpr float C = SCALE * 1.4426950408889634f;
  float pmax = p0[0]; for (int r = 1; r < 16; ++r) pmax = fmaxf(pmax, p0[r]); for (int r = 0; r < 16; ++r) pmax = fmaxf(pmax, p1[r]);
  { auto rr = __builtin_amdgcn_permlane32_swap(__float_as_uint(pmax), __float_as_uint(pmax), false, false);
    pmax = fmaxf(__uint_as_float(rr[0]), __uint_as_float(rr[1])); }
  if (__builtin_expect(__all(pmax - m_reg <= THR / SCALE), 1)) { mn = m_reg; alpha = 1.f; }
  else { mn = fmaxf(m_reg, pmax); alpha = __builtin_amdgcn_exp2f((m_reg - mn) * C); m_reg = mn; }
  float mnC = -mn * C;
  for (int r = 0; r < 16; ++r) p0[r] = fmaf(p0[r], C, mnC); for (int r = 0; r < 16; ++r) p1[r] = fmaf(p1[r], C, mnC);
  for (int r = 0; r < 16; ++r) p0[r] = __builtin_amdgcn_exp2f(p0[r]);
}
__device__ __forceinline__ void finishSM(f32x16& p0, f32x16& p1, float alpha, float& l_reg, bf16x8& pa0, bf16x8& pa1, bf16x8& pa2, bf16x8& pa3) {
  for (int r = 0; r < 16; ++r) p1[r] = __builtin_amdgcn_exp2f(p1[r]);
  float ps = 0; for (int r = 0; r < 16; ++r) ps += p0[r]; for (int r = 0; r < 16; ++r) ps += p1[r];
  { auto rr = __builtin_amdgcn_permlane32_swap(__float_as_uint(ps), __float_as_uint(ps), false, false);
    ps = __uint_as_float(rr[0]) + __uint_as_float(rr[1]); }
  l_reg = l_reg * alpha + ps;
#define PK4(P, BASE, OUT) do { unsigned a0 = cvtpk(P[BASE + 0], P[BASE + 1]), a1 = cvtpk(P[BASE + 2], P[BASE + 3]);   \
    unsigned b0 = cvtpk(P[BASE + 4], P[BASE + 5]), b1 = cvtpk(P[BASE + 6], P[BASE + 7]);                              \
    auto r0 = __builtin_amdgcn_permlane32_swap(a0, b0, false, false); auto r1 = __builtin_amdgcn_permlane32_swap(a1, b1, false, false); \
    u32x4 w = {r0[0], r1[0], r0[1], r1[1]}; OUT = *reinterpret_cast<bf16x8*>(&w); } while (0)
  PK4(p0, 0, pa0); PK4(p0, 8, pa1); PK4(p1, 0, pa2); PK4(p1, 8, pa3);
#undef PK4
}
__device__ __forceinline__ void qkt(f32x16& p0, f32x16& p1, const bf16* Ks, const bf16x8* qr, int r32, int hi) {
  p0 = f32x16{}; p1 = f32x16{};
  for (int d0 = 0; d0 < 8; ++d0) { int cb = (d0 * 16 + hi * 8) * 2;
    bf16x8 b0 = *reinterpret_cast<const bf16x8*>((const char*)Ks + KSWZ(r32, cb));
    bf16x8 b1 = *reinterpret_cast<const bf16x8*>((const char*)Ks + KSWZ(32 + r32, cb));
    p0 = __builtin_amdgcn_mfma_f32_32x32x16_bf16(b0, qr[d0], p0, 0, 0, 0);
    p1 = __builtin_amdgcn_mfma_f32_32x32x16_bf16(b1, qr[d0], p1, 0, 0, 0); }
}
__device__ __forceinline__ int v_st(int k, int c) { const int kk = (k & ~0xC) | ((k & 4) << 1) | ((k & 8) >> 1); return ((kk >> 3) * 4 + (c >> 5)) * 512 + ((kk & 7) * 32 + (c & 31)) * 2; }
__device__ __forceinline__ int v_rd_base(int lane) { return ((lane & 3) << 3) | (((lane >> 2) & 3) << 6) | (((lane >> 4) & 1) << 5) | (((lane >> 5) & 1) << 8); }
constexpr int v_rd_off(int d0, int ks, int half) { return d0 * 512 + ks * 4096 + half * 2048; }
template <int OFF> __device__ __forceinline__ s16x4 tr_read(int vb) {
  s16x4 r; asm volatile("ds_read_b64_tr_b16 %0, %1 offset:%2" : "=&v"(r) : "v"(vb), "i"(OFF) : "memory"); return r;
}
template <int D0> __device__ __forceinline__ void pv_one(f32x16& od, int vb, bf16x8 pa0, bf16x8 pa1, bf16x8 pa2, bf16x8 pa3) {
  const s16x4 l0 = tr_read<v_rd_off(D0, 0, 0)>(vb), h0 = tr_read<v_rd_off(D0, 0, 1)>(vb), l1 = tr_read<v_rd_off(D0, 1, 0)>(vb), h1 = tr_read<v_rd_off(D0, 1, 1)>(vb);
  const s16x4 l2 = tr_read<v_rd_off(D0, 2, 0)>(vb), h2 = tr_read<v_rd_off(D0, 2, 1)>(vb), l3 = tr_read<v_rd_off(D0, 3, 0)>(vb), h3 = tr_read<v_rd_off(D0, 3, 1)>(vb);
  asm volatile("s_waitcnt lgkmcnt(0)" ::: "memory"); SBAR();
#define PK(L, H) (bf16x8){L[0], L[1], L[2], L[3], H[0], H[1], H[2], H[3]}
  od = __builtin_amdgcn_mfma_f32_32x32x16_bf16(pa0, PK(l0, h0), od, 0, 0, 0);
  od = __builtin_amdgcn_mfma_f32_32x32x16_bf16(pa1, PK(l1, h1), od, 0, 0, 0);
  od = __builtin_amdgcn_mfma_f32_32x32x16_bf16(pa2, PK(l2, h2), od, 0, 0, 0);
  od = __builtin_amdgcn_mfma_f32_32x32x16_bf16(pa3, PK(l3, h3), od, 0, 0, 0);
#undef PK
}
__device__ __forceinline__ void pv_d0(f32x16* o, int vb, bf16x8 pa0, bf16x8 pa1, bf16x8 pa2, bf16x8 pa3) {
  pv_one<0>(o[0], vb, pa0, pa1, pa2, pa3); pv_one<1>(o[1], vb, pa0, pa1, pa2, pa3); pv_one<2>(o[2], vb, pa0, pa1, pa2, pa3); pv_one<3>(o[3], vb, pa0, pa1, pa2, pa3);
}

__device__ __forceinline__ void attn_dense_body(const bf16* __restrict__ Qb, const bf16* __restrict__ Kh, const bf16* __restrict__ Vh,
                                                const bf16* __restrict__ Zb, bf16* __restrict__ Ob, int seq, char* lds) {
  using TQ = bf16; using St = Stage<bf16>; using SQ = Stage<TQ>;
  int tid_ = threadIdx.x; asm volatile("" : "+v"(tid_));
  const int tid = tid_, wid = tid >> 6, lane = tid & 63, r32 = lane & 31, hi = lane >> 5;
  bf16* V_lds = (bf16*)lds; bf16* K_lds = (bf16*)(lds + 2 * SHM_V);
  float* ws = (float*)(lds + 2 * SHM_V + 2 * SHM_K) + wid * 64; float* li_l = ws; float* al_l = ws + 32;
  float m_reg = -1e30f, l_reg = 0; f32x16 o[4] = {}; bf16x8 qr[8];
  const TQ* Qw = Qb + (long)(wid * QBLK + r32) * LDQ + hi * 8;
#pragma unroll
  for (int d0 = 0; d0 < 8; ++d0) qr[d0] = SQ::tobf(SQ::ld8(Qw + d0 * 16));
  const int sr = tid >> 4, sc = (tid & 15) * 8, vst0 = v_st(sr, sc), vst1 = v_st(32 + sr, sc);
  const int vb0 = (int)(uintptr_t)V_lds + v_rd_base(lane);
  struct { typename St::T vs0, vs1, ks0, ks1; } sr_[SDEPTH];
#define SLOAD(i, k0) do { sr_[i].vs0 = St::ld8(&Vh[(long)((k0) + sr) * LDK + sc]); sr_[i].vs1 = St::ld8(&Vh[(long)((k0) + 32 + sr) * LDK + sc]); \
    sr_[i].ks0 = St::ld8(&Kh[(long)((k0) + sr) * LDK + sc]); sr_[i].ks1 = St::ld8(&Kh[(long)((k0) + 32 + sr) * LDK + sc]); } while (0)
#define SWRITE(b, i) do { *(bf16x8*)((char*)V_lds + (b) * SHM_V + vst0) = St::tobf(sr_[i].vs0);          \
    *(bf16x8*)((char*)V_lds + (b) * SHM_V + vst1) = St::tobf(sr_[i].vs1); int kc = sc * 2;               \
    *(bf16x8*)((char*)K_lds + (b) * SHM_K + KSWZ(sr, kc)) = St::tobf(sr_[i].ks0);                       \
    *(bf16x8*)((char*)K_lds + (b) * SHM_K + KSWZ(32 + sr, kc)) = St::tobf(sr_[i].ks1); } while (0)
#define SWAIT() do { if constexpr (SDEPTH == 2) asm volatile("s_waitcnt vmcnt(4)" ::: "memory"); else asm volatile("s_waitcnt vmcnt(0)" ::: "memory"); } while (0)
#define RESC(a) do { if (__any((a) < 1.f)) { if (hi == 0) al_l[r32] = (a); asm volatile("s_waitcnt lgkmcnt(0)" ::: "memory"); \
    for (int d = 0; d < 4; ++d) for (int r = 0; r < 16; ++r) o[d][r] *= al_l[crow(r, hi)]; } } while (0)
  f32x16 pA0, pA1, pB0, pB1; float mnA, mnB, alA, alB; bf16x8 pa0, pa1, pa2, pa3; const int NT = seq / KVBLK;
  constexpr int SE = 0, SO = SDEPTH - 1;
  SLOAD(SE, 0); asm volatile("s_waitcnt vmcnt(0)" ::: "memory"); SWRITE(0, SE); __syncthreads();
  qkt(pA0, pA1, K_lds, qr, r32, hi); partialSM(pA0, pA1, m_reg, mnA, alA);
  SLOAD(SO, KVBLK); if constexpr (SDEPTH == 2) { if (2 < NT) SLOAD(SE, 2 * KVBLK); }
  SWAIT(); SWRITE(1, SO); __syncthreads();
  for (int j = 1; j + 1 < NT; j += 2) {
    SBAR(); qkt(pB0, pB1, (bf16*)((char*)K_lds + SHM_K), qr, r32, hi);
    finishSM(pA0, pA1, alA, l_reg, pa0, pa1, pa2, pa3); SBAR();
    SLOAD(SO, (j + SDEPTH) * KVBLK); SBAR();
    pv_d0(o, vb0, pa0, pa1, pa2, pa3); partialSM(pB0, pB1, m_reg, mnB, alB);
    __syncthreads(); SWAIT(); SWRITE(0, SE);
    RESC(alB); __syncthreads();
    SBAR(); qkt(pA0, pA1, K_lds, qr, r32, hi);
    finishSM(pB0, pB1, alB, l_reg, pa0, pa1, pa2, pa3); SBAR();
    if (SDEPTH == 1 || j + 3 < NT) SLOAD(SE, (j + 1 + SDEPTH) * KVBLK); SBAR();
    pv_d0(o, vb0 + (int)SHM_V, pa0, pa1, pa2, pa3); partialSM(pA0, pA1, m_reg, mnA, alA);
    __syncthreads(); SWAIT(); SWRITE(1, SO);
    RESC(alA); __syncthreads();
  }
  SBAR(); qkt(pB0, pB1, (bf16*)((char*)K_lds + SHM_K), qr, r32, hi);
  finishSM(pA0, pA1, alA, l_reg, pa0, pa1, pa2, pa3); SBAR();
  pv_d0(o, vb0, pa0, pa1, pa2, pa3); partialSM(pB0, pB1, m_reg, mnB, alB);
  __syncthreads(); RESC(alB);
  finishSM(pB0, pB1, alB, l_reg, pa0, pa1, pa2, pa3); SBAR();
  pv_d0(o, vb0 + (int)SHM_V, pa0, pa1, pa2, pa3);
  if (hi == 0) li_l[r32] = l_reg; asm volatile("s_waitcnt lgkmcnt(0)" ::: "memory");
  float rli[16];
#pragma unroll
  for (int r = 0; r < 16; ++r) rli[r] = __builtin_amdgcn_rcpf(li_l[crow(r, hi)]);
  bf16* Ow = Ob + (long)(wid * QBLK) * LDO; const bf16* Zw = Zb + (long)(wid * QBLK) * LDQ;
  char* stg = lds + (2 * SHM_V + 2 * SHM_K + NW * 64 * 4) + wid * (32 * 272);
#pragma unroll
  for (int r = 0; r < 16; ++r) { const int orow = crow(r, hi);
#pragma unroll
    for (int d0 = 0; d0 < 4; ++d0) *(unsigned short*)(stg + orow * 272 + (d0 * 32 + r32) * 2) = (unsigned short)cvtpk(o[d0][r] * rli[r], 0.f); }
  asm volatile("s_waitcnt lgkmcnt(0)" ::: "memory");
  { const int c8 = (lane & 15) * 8, rq = lane >> 4;
#pragma unroll
    for (int i = 0; i < 8; ++i) { const int row = rq + 4 * i;
      const u32x4 ov = *reinterpret_cast<const u32x4*>(stg + row * 272 + c8 * 2);
      const u32x4 zv = *reinterpret_cast<const u32x4*>(Zw + (long)row * LDQ + c8);
      u32x4 w;
#define OZ(k) cvtpk(__uint_as_float(ov[k] << 16) * __uint_as_float(zv[k] << 16), __uint_as_float(ov[k] & 0xffff0000u) * __uint_as_float(zv[k] & 0xffff0000u))
      w[0] = OZ(0); w[1] = OZ(1); w[2] = OZ(2); w[3] = OZ(3);
#undef OZ
      *reinterpret_cast<u32x4*>(Ow + (long)row * LDO + c8) = w; } }
#undef SLOAD
#undef SWRITE
#undef SWAIT
#undef RESC
}
template <int D0> __device__ __forceinline__ void sgu_one(f32x16& od, int vb, bf16x8 w0, bf16x8 w1, bf16x8 w2, bf16x8 w3) {
  const s16x4 l0 = tr_read<v_rd_off(D0, 0, 0)>(vb), h0 = tr_read<v_rd_off(D0, 0, 1)>(vb), l1 = tr_read<v_rd_off(D0, 1, 0)>(vb), h1 = tr_read<v_rd_off(D0, 1, 1)>(vb);
  const s16x4 l2 = tr_read<v_rd_off(D0, 2, 0)>(vb), h2 = tr_read<v_rd_off(D0, 2, 1)>(vb), l3 = tr_read<v_rd_off(D0, 3, 0)>(vb), h3 = tr_read<v_rd_off(D0, 3, 1)>(vb);
  asm volatile("s_waitcnt lgkmcnt(0)" ::: "memory"); SBAR();
#define PK(L, H) (bf16x8){L[0], L[1], L[2], L[3], H[0], H[1], H[2], H[3]}
  od = __builtin_amdgcn_mfma_f32_32x32x16_bf16(PK(l0, h0), w0, od, 0, 0, 0);
  od = __builtin_amdgcn_mfma_f32_32x32x16_bf16(PK(l1, h1), w1, od, 0, 0, 0);
  od = __builtin_amdgcn_mfma_f32_32x32x16_bf16(PK(l2, h2), w2, od, 0, 0, 0);
  od = __builtin_amdgcn_mfma_f32_32x32x16_bf16(PK(l3, h3), w3, od, 0, 0, 0);
#undef PK
}
__device__ __forceinline__ float bf_lo(unsigned w) { return __uint_as_float(w << 16); }
__device__ __forceinline__ float bf_hi(unsigned w) { return __uint_as_float(w & 0xffff0000u); }
constexpr int SGU_S_OFF = 2 * (int)SHM_V, SGU_S_LD = 132;
struct SguRegs { bf16x8 t00, t01, t10, t11; u32x4 uu[4], zz[4]; };
__device__ __forceinline__ void sgu_load(SguRegs& R, const bf16* __restrict__ Pb, int item, int sr, int sc, int lat) {
  const int ci = item >> 3, g = item & 7; const int chunk = lat ? (ci >> 5) * 34 + 2 + (ci & 31) : ci;     const long R0 = (long)chunk * 128;
  const bf16* vsrc = Pb + R0 * LDQ + 1024 + g * 128 + sc;
  R.t00 = *reinterpret_cast<const bf16x8*>(vsrc + (long)(sr) * LDQ); R.t01 = *reinterpret_cast<const bf16x8*>(vsrc + (long)(32 + sr) * LDQ);
  R.t10 = *reinterpret_cast<const bf16x8*>(vsrc + (long)(64 + sr) * LDQ); R.t11 = *reinterpret_cast<const bf16x8*>(vsrc + (long)(96 + sr) * LDQ);
  const bf16* urow = Pb + (R0 + sr) * LDQ + g * 128 + sc;
#pragma unroll
  for (int k = 0; k < 4; ++k) { R.uu[k] = *reinterpret_cast<const u32x4*>(urow + (long)(32 * k) * LDQ); R.zz[k] = *reinterpret_cast<const u32x4*>(urow + (long)(32 * k) * LDQ + 2048); }
}
__device__ __forceinline__ void sgu_phase(const bf16* __restrict__ Pb, bf16* __restrict__ YC, const bf16* __restrict__ Wf  ,
                                          const float* __restrict__ bsgu  , int first, int stride, int nitems, char* lds, int lat) {
  int tid_ = threadIdx.x; asm volatile("" : "+v"(tid_));
  const int tid = tid_, wid = tid >> 6, lane = tid & 63, r32 = lane & 31, hi = lane >> 5;
  bf16* V_lds = (bf16*)lds; float* S_lds = (float*)(lds + SGU_S_OFF);
  const int sr = tid >> 4, sc = (tid & 15) * 8, vst0 = v_st(sr, sc), vst1 = v_st(32 + sr, sc);
  const int pb = wid & 3, P0 = 32 * pb, DB = 2 * (wid >> 2);
  const int vb = (int)(uintptr_t)V_lds + v_rd_base(lane) + DB * 512;
  if (first >= nitems) return;
  SguRegs C, N;
  sgu_load(C, Pb, first, sr, sc, lat);
  for (int item = first; item < nitems; item += stride) {
    const int ci = item >> 3, g = item & 7; const int chunk = lat ? (ci >> 5) * 34 + 2 + (ci & 31) : ci; const long R0 = (long)chunk * 128;
    *(bf16x8*)((char*)V_lds + vst0) = C.t00; *(bf16x8*)((char*)V_lds + vst1) = C.t01;
    *(bf16x8*)((char*)V_lds + SHM_V + vst0) = C.t10; *(bf16x8*)((char*)V_lds + SHM_V + vst1) = C.t11;
    const bf16x8* wfp = reinterpret_cast<const bf16x8*>(Wf) + ((long)(g * 4 + pb) * 8) * 64 + lane;
    bf16x8 wf[2][4];
#pragma unroll
    for (int T = 0; T < 2; ++T)
#pragma unroll
      for (int s = 0; s < 4; ++s) wf[T][s] = wfp[(T * 4 + s) * 64];
    const bool has_next = item + stride < nitems;
    if (has_next) sgu_load(N, Pb, item + stride, sr, sc, lat);
    __syncthreads();
    f32x16 o0 = {}, o1 = {};
    sgu_one<0>(o0, vb, wf[0][0], wf[0][1], wf[0][2], wf[0][3]); sgu_one<1>(o1, vb, wf[0][0], wf[0][1], wf[0][2], wf[0][3]);
    sgu_one<0>(o0, vb + (int)SHM_V, wf[1][0], wf[1][1], wf[1][2], wf[1][3]); sgu_one<1>(o1, vb + (int)SHM_V, wf[1][0], wf[1][1], wf[1][2], wf[1][3]);
#pragma unroll
    for (int dd = 0; dd < 2; ++dd)
#pragma unroll
      for (int g4 = 0; g4 < 4; ++g4) { const int d = 32 * (DB + dd) + 8 * g4 + 4 * hi; const f32x16& o = dd ? o1 : o0;
        *reinterpret_cast<f32x4v*>(S_lds + (P0 + r32) * SGU_S_LD + d) = (f32x4v){o[4 * g4 + 0], o[4 * g4 + 1], o[4 * g4 + 2], o[4 * g4 + 3]}; }
    __syncthreads();
#pragma unroll
    for (int k = 0; k < 4; ++k) { const int row = sr + 32 * k; const float bias = bsgu[g * 128 + row];
      const f32x4v s0 = *reinterpret_cast<const f32x4v*>(S_lds + row * SGU_S_LD + sc), s1 = *reinterpret_cast<const f32x4v*>(S_lds + row * SGU_S_LD + sc + 4);
      const u32x4 u = C.uu[k], z = C.zz[k]; u32x4 w;
      w.x = cvtpk(bf_lo(u.x) * (s0[0] + bias) * bf_lo(z.x), bf_hi(u.x) * (s0[1] + bias) * bf_hi(z.x));
      w.y = cvtpk(bf_lo(u.y) * (s0[2] + bias) * bf_lo(z.y), bf_hi(u.y) * (s0[3] + bias) * bf_hi(z.y));
      w.z = cvtpk(bf_lo(u.z) * (s1[0] + bias) * bf_lo(z.z), bf_hi(u.z) * (s1[1] + bias) * bf_hi(z.z));
      w.w = cvtpk(bf_lo(u.w) * (s1[2] + bias) * bf_lo(z.w), bf_hi(u.w) * (s1[3] + bias) * bf_hi(z.w));
      *reinterpret_cast<u32x4*>(YC + (R0 + row) * LDO + g * 128 + sc) = w; }
    if (has_next) C = N;
    __syncthreads();
  }
}
}
typedef float f32x4 __attribute__((ext_vector_type(4)));
typedef unsigned v4u __attribute__((ext_vector_type(4)));
typedef unsigned short bf16_t;
#define LDS_WAIT() asm volatile("s_waitcnt lgkmcnt(0)" ::: "memory")
__device__ __forceinline__ unsigned f2bf(float f) { unsigned u = __builtin_bit_cast(unsigned, f); return (u + 0x7fffu + ((u >> 16) & 1u)) >> 16; }
__device__ __forceinline__ unsigned pk2(float lo, float hi) { return f2bf(lo) | (f2bf(hi) << 16); }
__device__ __forceinline__ float wave_sum(float v) {
#pragma unroll
    for (int o = 1; o < 64; o <<= 1) v += __shfl_xor(v, o);
    return v;
}
__device__ __forceinline__ int physrow_in(int c) {
    if (c < C_Q || c >= C_VA) return c;
    const int d = c & 127; const int p = (d & 0x40) | ((d & 0x10) << 1) | ((d & 0xC) << 1) | ((d & 0x20) >> 3) | (d & 3);
    return (c & ~127) | p;
}
__device__ __forceinline__ void p0_transpose_item(const float* W, int K, int N, bf16_t* WT, bool perm, LAS float* scr, int item, int lane) {
    const int nblk = N / 32, kb = item / nblk, nb = item % nblk, k0 = 64 * kb, n0 = 32 * nb;
#pragma unroll 8
    for (int i = 0; i < 32; ++i) { const int kk = 2 * i + (lane >> 5); scr[kk * 33 + (lane & 31)] = W[(size_t)(k0 + kk) * N + n0 + (lane & 31)]; }
    LDS_WAIT(); asm volatile("" ::: "memory");
    const int c = lane & 7;
#pragma unroll
    for (int j = 0; j < 4; ++j) { const int n = (lane >> 3) + 8 * j; const LAS float* s = scr + (8 * c) * 33 + n;
        v4u o; o.x = pk2(s[0 * 33], s[1 * 33]); o.y = pk2(s[2 * 33], s[3 * 33]); o.z = pk2(s[4 * 33], s[5 * 33]); o.w = pk2(s[6 * 33], s[7 * 33]);
        const int rown = perm ? physrow_in(n0 + n) : (n0 + n);
        *(v4u*)(WT + (size_t)rown * K + k0 + 8 * c) = o; }
    LDS_WAIT(); asm volatile("" ::: "memory");
}
__device__ __forceinline__ void p0_prologue(const Args& a, LAS unsigned char* lds, int tid, int lane, int wave, int vcu, int G) {
    float* mod = (float*)(a.ws + WS_MOD);
    {
        LAS float* sl = (LAS float*)lds; LAS float* red = (LAS float*)(lds + 40960);
        for (int i = tid; i < 5 * 2048; i += 512) { const float v = (i < 4 * 2048) ? a.in[1][i] : a.in[3][i - 4 * 2048]; sl[i] = v / (1.f + __expf(-v)); }
        __syncthreads();
        const int cgp = tid % 12, kl = tid / 12;
        for (int item = vcu; item < 256; item += G) {
            const int l = item >> 7, j0 = (item & 127) * 48;
            if (kl < 42) {
                f32x4 acc[5];
#pragma unroll
                for (int r = 0; r < 5; ++r) acc[r] = (f32x4){0.f, 0.f, 0.f, 0.f};
                const float* wp = a.in[5] + (size_t)l * 2048 * 6144 + j0 + cgp * 4;
#pragma unroll 4
                for (int k = kl; k < 2048; k += 42) { const f32x4 w = *(const f32x4*)(wp + (size_t)k * 6144);
#pragma unroll
                    for (int r = 0; r < 5; ++r) acc[r] += sl[r * 2048 + k] * w; }
#pragma unroll
                for (int r = 0; r < 5; ++r) *(LAS f32x4*)(red + (kl * 5 + r) * 48 + cgp * 4) = acc[r];
            }
            __syncthreads();
            if (tid < 240) { const int r = tid / 48, c = tid % 48; float s = 0.f;
                for (int q = 0; q < 42; ++q) s += red[(q * 5 + r) * 48 + c];
                mod[(l * 5 + r) * 6144 + j0 + c] = s + a.in[6][l * 6144 + j0 + c]; }
            __syncthreads();
        }
    }
    if (vcu == G - 1) {
        float* rc = (float*)(a.ws + WS_ROPE); float* rs = rc + 2048;
        for (int idx = tid; idx < 2048; idx += 512) { const int pos = idx >> 5, i = idx & 31;
            const float inv = exp2f(-(float)(2 * i) * (1.f / 64.f) * 13.287712379549449f);
            const float ang = (float)pos * inv; rc[idx] = cosf(ang); rs[idx] = sinf(ang); }
    }
    {
        v4u* Wf = (v4u*)(a.ws + WS_WSGU);
        for (int idx = vcu * 512 + tid; idx < 2 * 8 * 4 * 8 * 64; idx += G * 512) { const int ln = idx & 63, ts = (idx >> 6) & 7, pbb = (idx >> 9) & 3, lg = idx >> 11;
            const float* q = a.in[8] + ((size_t)lg * 128 + 32 * pbb + (ln & 31)) * 128 + 16 * ts + 8 * (ln >> 5);
            const f32x4 lo = *(const f32x4*)q, hh = *(const f32x4*)(q + 4);
            v4u o; o.x = pk2(lo[0], lo[1]); o.y = pk2(lo[2], lo[3]); o.z = pk2(hh[0], hh[1]); o.w = pk2(hh[2], hh[3]); Wf[idx] = o; }
    }
    {
        LAS float* scr = (LAS float*)(lds + wave * 16384);
        const int gw = vcu * 8 + wave, NGW = G * 8;
        bf16_t* WinT = (bf16_t*)(a.ws + WS_WIN); bf16_t* WoutT = (bf16_t*)(a.ws + WS_WOUT);
        constexpr int I_IN = 32 * (DIN / 32), I_OUT = 32 * (DM / 32), I_L = I_IN + I_OUT;
        for (int it = gw; it < 2 * I_L; it += NGW) { const int l = it / I_L; const int r = it - l * I_L;
            if (r < I_IN) p0_transpose_item(a.in[7] + (size_t)l * DM * DIN, DM, DIN, WinT + (size_t)l * DIN * DM, true, scr, r, lane);
            else p0_transpose_item(a.in[13] + (size_t)l * DM * DM, DM, DM, WoutT + (size_t)l * DM * DM, false, scr, r - I_IN, lane); }
    }
}
__device__ __forceinline__ void pA_norm(const Args& a, int l, int gw, int NGW, int lane_) {
    int lane = lane_; asm volatile("" : "+v"(lane));
    const float* mod = (const float*)(a.ws + WS_MOD) + (size_t)l * 5 * 6144;
    const float* nw = a.in[4] + l * DM;
    const float* xc1 = (const float*)(a.ws + WS_XC1);
    bf16_t* H = (bf16_t*)(a.ws + WS_H);
    const int rpw = (MROWS + NGW - 1) / NGW;
    const int R0 = gw * rpw, R1 = (R0 + rpw < MROWS) ? R0 + rpw : MROWS;
    int cur = -1; f32x4 g[8], sh[8];
    for (int R = R0; R < R1; ++R) {
        const int b = R / RPB, rb = R - b * RPB; const bool isctx = rb < CTX; const int rm = isctx ? 4 : b;
        if (l == 1 && isctx && NGW == 2048) continue;
        const float* src = (l == 0) ? (isctx ? a.in[2] + (size_t)(b * CTX + rb) * DM : a.in[0] + (size_t)(b * SEQ + rb - CTX) * DM)
                                    : (isctx ? xc1 + (size_t)(b * CTX + rb) * DM : a.out + (size_t)(b * SEQ + rb - CTX) * DM);
        if (rm != cur) { cur = rm;
#pragma unroll
            for (int j = 0; j < 8; ++j) { const int c = 4 * lane + 256 * j; const f32x4 w = *(const f32x4*)(nw + c), sc = *(const f32x4*)(mod + rm * 6144 + 2048 + c);
                g[j] = w * (1.f + sc); sh[j] = *(const f32x4*)(mod + rm * 6144 + c); } }
        f32x4 v[8]; float s = 0.f;
#pragma unroll
        for (int j = 0; j < 8; ++j) { v[j] = *(const f32x4*)(src + 4 * lane + 256 * j); s += (v[j][0] * v[j][0] + v[j][1] * v[j][1]) + (v[j][2] * v[j][2] + v[j][3] * v[j][3]); }
        const float rstd = 1.f / sqrtf(wave_sum(s) * (1.f / DM) + EPS);
        unsigned long long* o8 = (unsigned long long*)(H + (size_t)R * DM) + lane;
#pragma unroll
        for (int j = 0; j < 8; ++j) { const f32x4 y = v[j] * rstd * g[j] + sh[j]; o8[64 * j] = (unsigned long long)pk2(y[0], y[1]) | ((unsigned long long)pk2(y[2], y[3]) << 32); }
    }
}

#define RLX_AGENT __ATOMIC_RELAXED, __HIP_MEMORY_SCOPE_AGENT
#define XB_TMO      128
#define XB_XCNT(j)  (256  + 64 * (j))
#define XB_XSUB(j)  (1280 + 64 * (j))
#define XB_XGEN(j)  (2304 + 64 * (j))
#define XB_TOP      3328
#define XB_TOPGEN   3392
#define XCD_BAR_WORDS 3456
#define XB_SPIN_CAP (1u << 18)

__device__ __forceinline__ unsigned xb_ld(unsigned* p)              { return __hip_atomic_load(p, __ATOMIC_RELAXED, __HIP_MEMORY_SCOPE_AGENT); }
__device__ __forceinline__ unsigned xb_add(unsigned* p, unsigned v) { return __hip_atomic_fetch_add(p, v, __ATOMIC_RELAXED, __HIP_MEMORY_SCOPE_AGENT); }
__device__ __forceinline__ unsigned xb_xcc_id() { return (unsigned)__builtin_amdgcn_s_getreg((3 << 11) | 20) & 0xFu; }
#define XB_SPIN(cond, bar) do { unsigned _sp = 0; while (cond) { __builtin_amdgcn_s_sleep(1); \
    if ((++_sp & 255u) == 0u) { if (xb_ld(&(bar)[XB_TMO])) break; if (_sp > XB_SPIN_CAP) { atomicAdd(&(bar)[XB_TMO], 1u); break; } } } } while (0)

struct XcdBarrier {
    unsigned* bar; unsigned x;
    volatile LAS unsigned* st;
};

__device__ __forceinline__ XcdBarrier xcd_barrier_post(unsigned* bar, volatile LAS unsigned* st) {
    XcdBarrier b; b.bar = bar; b.x = xb_xcc_id(); b.st = st;
    if (threadIdx.x == 0) (void)xb_add(&bar[XB_XCNT(b.x)], 1u);
    return b;
}
__device__ __forceinline__ void xcd_barrier_complete(unsigned* bar, unsigned x, unsigned& nloc, unsigned& nx) {
    const unsigned G = gridDim.x * gridDim.y * gridDim.z;
    unsigned sum, cnt, mine, sp = 0u;
    for (;;) {
        sum = 0u; cnt = 0u; mine = 0u;
#pragma unroll
        for (unsigned j = 0; j < 16; ++j) { const unsigned c = xb_ld(&bar[XB_XCNT(j)]); sum += c; cnt += (c > 0u) ? 1u : 0u; mine = (j == x) ? c : mine; }
        if (sum == G) break;
        __builtin_amdgcn_s_sleep(1);
        if ((++sp & 255u) == 0u) { if (xb_ld(&bar[XB_TMO])) break; if (sp > XB_SPIN_CAP) { atomicAdd(&bar[XB_TMO], 1u); break; } }
    }
    nloc = mine > 0u ? mine : 1u; nx = cnt > 0u ? cnt : 1u;
}

__device__ __forceinline__ void xcd_barrier(const XcdBarrier& b) {
    asm volatile("s_waitcnt vmcnt(0)" ::: "memory");
    __syncthreads();
    if (threadIdx.x == 0) {
        unsigned* bar = b.bar;
        __builtin_amdgcn_s_waitcnt(0);
        unsigned nloc = b.st[0], nx = b.st[1];
        if (nloc == 0u) { xcd_barrier_complete(bar, b.x, nloc, nx); b.st[0] = nloc; b.st[1] = nx; }
        const unsigned old = xb_add(&bar[XB_XSUB(b.x)], 1u);
        const unsigned gen = old / nloc;
        if (old + 1u == (gen + 1u) * nloc) {
            __builtin_amdgcn_fence(__ATOMIC_RELEASE, "agent");
            asm volatile("s_waitcnt vmcnt(0)" ::: "memory");
            const unsigned og = xb_add(&bar[XB_TOP], 1u);
            const unsigned tg = og / nx;
            if (og + 1u == (tg + 1u) * nx) xb_add(&bar[XB_TOPGEN], 1u);
            else XB_SPIN(xb_ld(&bar[XB_TOPGEN]) == tg, bar);
            __builtin_amdgcn_fence(__ATOMIC_ACQUIRE, "agent");
            xb_add(&bar[XB_XGEN(b.x)], 1u);
            asm volatile("s_waitcnt vmcnt(0)" ::: "memory");
        } else {
            XB_SPIN(xb_ld(&bar[XB_XGEN(b.x)]) == gen, bar);
            __builtin_amdgcn_fence(__ATOMIC_ACQUIRE, "agent");
            asm volatile("s_waitcnt vmcnt(0)" ::: "memory");
        }
    }
    __syncthreads();
}

__global__ void __launch_bounds__(512, 2) mk_fwd(Args a) {
    extern __shared__ __attribute__((aligned(16))) unsigned char lds[];
    cg::grid_group grid = cg::this_grid();
    LAS unsigned char* L = (LAS unsigned char*)lds;
    const int tid = threadIdx.x, lane = tid & 63, wave = __builtin_amdgcn_readfirstlane(tid >> 6);
    const int G = gridDim.x, bx = blockIdx.x; const int vcu = (G % 8 == 0) ? (bx % 8) * (G / 8) + bx / 8 : bx;
    const int lo = a.ph_lo, hi = a.ph_hi;
#define IN(k) (lo <= (k) && (k) < hi)
#define SEAM(k) do { if (IN(k) && IN((k) + 1)) { if (a.coop == 2) grid.sync(); else xcd_barrier(xbar); } } while (0)
    volatile LAS unsigned* xst = (volatile LAS unsigned*)(L + XCH_OFF + 8192);
    if (tid < 2) xst[tid] = 0u;
    __syncthreads();
    XcdBarrier xbar; xbar.bar = (unsigned*)(a.ws + WS_BAR); xbar.x = 0; xbar.st = xst;
    if (a.coop) xbar = xcd_barrier_post((unsigned*)(a.ws + WS_BAR), xst);

    bf16_t* Hb = (bf16_t*)(a.ws + WS_H); bf16_t* Pb = (bf16_t*)(a.ws + WS_P);
    if (IN(0)) { p0_prologue(a, L, tid, lane, wave, vcu, G); }
    SEAM(0);
#pragma nounroll
    for (int l = 0; l < 2; ++l) {
        const int pb = 1 + 4 * l;
        if (IN(pb)) { pA_norm(a, l, vcu * 8 + wave, G * 8, lane); }
        SEAM(pb);
        if (IN(pb + 1)) {
            const int m2 = (G == 256) ? 1 : 0;
            pg8::Gemm g{Hb, (const bf16_t*)(a.ws + WS_WIN) + (size_t)l * DIN * DM, MROWS, DIN, DM, Hb, (const bf16_t*)(a.ws + WS_WOUT)};
            pg8::SchedX S; if (l == 0) S.init(68, 22, G, bx, 0, 0); else S.init(64, 22, G, bx, 1, m2 ? 0 : 8, m2, (unsigned*)(a.ws + WS_BAR) + 3584);
            pg8::EpiIn E{Pb, a.in[10] + l * 1024, a.in[11] + l * 128, a.in[12] + l * 128, (const float*)(a.ws + WS_ROPE), (const float*)(a.ws + WS_ROPE) + 2048, (LAS float*)(L + XCH_OFF), (bf16_t*)(a.ws + WS_KC), (bf16_t*)(a.ws + WS_VC),
                         a.in[2], (const float*)(a.ws + WS_MOD) + 4 * 6144 + 4096, (float*)(a.ws + WS_XC1), a.in[4] + DM, (const float*)(a.ws + WS_MOD) + (5 + 4) * 6144, Hb, (unsigned*)(a.ws + WS_BAR) + 3584};
            pg8::gemm_phase<pg8::EpiIn, pg8::SchedX, true, true>(L, g, S, E);
        }
        SEAM(pb + 1);
        if (IN(pb + 2)) {
            const at::bf16* P = (const at::bf16*)Pb; at::bf16* YC = (at::bf16*)Hb;
#pragma nounroll
            for (int st = 0; st < 2; ++st) {
            const bool do_sgu = (((st ^ vcu) & 1) == 0);
            if (do_sgu) { if (a.sub & 1)
            at::sgu_phase(P, YC, (const at::bf16*)(a.ws + WS_WSGU) + (size_t)l * 8 * 128 * 128, a.in[9] + l * 8 * 128, vcu, G, l == 0 ? 136 * 8 : 128 * 8, (char*)lds, l); }
            else {
            const int ntot = (a.sub & 2) ? 512 + (l == 0 ? 32 : 0) : 0;
            for (int i = 0;; ++i) { int Li = i * G + vcu; if (Li >= 512) Li -= 64;
                if (Li >= ntot || (i >= 2 && Li < 512)) break;
                int b, h, qrow, seq;
                if (Li < 512) { const int qb = Li & 15; h = (Li >> 4) & 7; b = Li >> 7; qrow = b * RPB + CTX + qb * 256; seq = RPB; }
                else { const int c = Li - 512; b = c >> 3; h = c & 7; qrow = b * RPB; seq = CTX; }
                const long krow = (long)b * RPB; const int kvh = h >> 2;
                const long kvo = ((long)(b * 2 + kvh) * RPB) * 128;
                at::attn_dense_body(P + (long)qrow * DIN + C_Q + h * 128, (const at::bf16*)(a.ws + WS_KC) + kvo, (const at::bf16*)(a.ws + WS_VC) + kvo,
                                    P + (long)qrow * DIN + C_ZB + h * 128, YC + (long)qrow * DM + 1024 + h * 128, seq, (char*)lds);
                __syncthreads(); } }
            __syncthreads(); }
        }
        SEAM(pb + 2);
        if (IN(pb + 3)) {
            pg8::Gemm g{Hb, (const bf16_t*)(a.ws + WS_WOUT) + (size_t)l * DM * DM, MROWS, DM, DM};
            pg8::SchedX S; if (l == 0 && G != 256) S.init(68, 8, G, bx, 0, 0); else S.init(64, 8, G, bx, 1, 0);
            pg8::EpiOut E{l == 0 ? a.in[0] : a.out, a.in[2], a.out, (float*)(a.ws + WS_XC1), (const float*)(a.ws + WS_MOD) + (size_t)l * 5 * 6144 + 4096};
            pg8::gemm_phase<pg8::EpiOut, pg8::SchedX, false, true>(L, g, S, E);
        }
        SEAM(pb + 3);
    }
#undef IN
#undef SEAM
}

extern "C" void kernel_launch(void* const* d_in, const int* in_sizes, int n_in, void* d_out, int out_size, void* d_ws, size_t ws_size, hipStream_t stream) {
    static int grid = 0;
    if (grid == 0) {
        if (n_in != 14 || in_sizes[0] != NB * SEQ * DM || out_size != NB * SEQ * DM || ws_size < WS_END) {
            fprintf(stderr, "kernel_launch: shape mismatch (n_in %d, in0 %d, out %d, ws %zu; need ws >= %zu); nothing launched\n", n_in, n_in > 0 ? in_sizes[0] : -1, out_size, ws_size, (size_t)WS_END); grid = -1; return; }
        int dev = 0, cus = 0, per_cu = 0;
        if (hipGetDevice(&dev) != hipSuccess || hipDeviceGetAttribute(&cus, hipDeviceAttributeMultiprocessorCount, dev) != hipSuccess) { fprintf(stderr, "kernel_launch: device query failed\n"); grid = -1; return; }
        if (hipFuncSetAttribute((const void*)mk_fwd, hipFuncAttributeMaxDynamicSharedMemorySize, LDS_BYTES) != hipSuccess) { fprintf(stderr, "kernel_launch: hipFuncSetAttribute failed\n"); grid = -1; return; }
        if (hipOccupancyMaxActiveBlocksPerMultiprocessor(&per_cu, (const void*)mk_fwd, 512, LDS_BYTES) != hipSuccess || per_cu < 1) { fprintf(stderr, "kernel_launch: occupancy query says %d blocks per CU\n", per_cu); per_cu = 1; }
        (void)hipGetLastError();
        grid = cus * 1;
    }
    if (grid < 0) return;
    Args a{};
    for (int i = 0; i < 14; ++i) a.in[i] = (const float*)d_in[i];
    a.out = (float*)d_out; a.ws = (unsigned char*)d_ws; a.sub = 3;
#if MK_MULTI
    for (int ph = 0; ph < NPHASE; ++ph) { a.ph_lo = ph; a.ph_hi = ph + 1; a.coop = 0;
        hipLaunchKernelGGL(mk_fwd, dim3(grid), dim3(512), LDS_BYTES, stream, a);
        const hipError_t le = hipPeekAtLastError(); if (le != hipSuccess) { fprintf(stderr, "kernel_launch: launch %d failed: %s\n", ph, hipGetErrorName(le)); break; }
#ifdef PROBE_PH
        if ((PROBE_PH >> ph) & 1) { a.sub = PROBE_SUB; hipLaunchKernelGGL(mk_fwd, dim3(grid), dim3(512), LDS_BYTES, stream, a); a.sub = 3; }
#endif
    }
#else
    a.ph_lo = 0; a.ph_hi = NPHASE; a.coop = 1;
    if (hipMemsetAsync((char*)d_ws + WS_BAR, 0, 16384, stream) != hipSuccess) { fprintf(stderr, "kernel_launch: hipMemsetAsync of the barrier words failed\n"); return; }
    void* args[] = {&a};
    const hipError_t e = hipLaunchCooperativeKernel((const void*)mk_fwd, dim3(grid), dim3(512), args, LDS_BYTES, stream);
    if (e != hipSuccess) fprintf(stderr, "kernel_launch: cooperative launch failed: %s (grid %d)\n", hipGetErrorString(e), grid);
#endif
}
```

```cpp
#include <hip/hip_runtime.h>
#include <hip/hip_cooperative_groups.h>
#include <hip/hip_bf16.h>
#include <cstdio>
#include <cstdint>
namespace cg = cooperative_groups;

#ifndef MK_MULTI
#define MK_MULTI 0
#endif

constexpr int DM = 2048, NB = 4, SEQ = 4096, CTX = 256, RPB = CTX + SEQ, MROWS = NB * RPB, DIN = 5632;
constexpr int C_U = 0, C_V = 1024, C_ZA = 2048, C_Q = 3072, C_K = 4096, C_VA = 4352, C_ZB = 4608;
constexpr int TPB = RPB / 256;
constexpr float EPS = 1e-6f;
constexpr int NPHASE = 9;
constexpr size_t MiB = 1u << 20;
constexpr size_t WS_MOD = 0;
constexpr size_t WS_ROPE = 1 * MiB;
constexpr size_t WS_WSGU = 2 * MiB;
constexpr size_t WS_BAR = 3 * MiB;
constexpr size_t WS_XC1 = 4 * MiB;
constexpr size_t WS_WIN = 16 * MiB;
constexpr size_t WS_WOUT = 64 * MiB;
constexpr size_t WS_H = 80 * MiB;
constexpr size_t WS_P = 160 * MiB;
constexpr size_t WS_KC = 352 * MiB;
constexpr size_t WS_VC = 368 * MiB;
constexpr size_t WS_END = 384 * MiB;
constexpr int LDS_BYTES = 147456;
constexpr int XCH_OFF = 131072;

struct Args { const float* in[14]; float* out; unsigned char* ws; int ph_lo, ph_hi, coop, sub; };
#define LAS __attribute__((address_space(3)))
namespace pg8 {
#define PG8_LAS __attribute__((address_space(3)))
typedef unsigned short bf16_t;
typedef short bf16x8 __attribute__((ext_vector_type(8)));
typedef float f32x4 __attribute__((ext_vector_type(4)));
typedef unsigned u32x4 __attribute__((ext_vector_type(4)));
constexpr int BM = 256, BK = 64, HALF = 128, HTB = HALF * BK * 2  , STAGE_BYTES = 8 * HTB, NXCD = 8, WGM = 8;

__host__ __device__ __forceinline__ int lds_byte(int r, int c) { const int st = (r >> 4) * 2 + (c >> 5), rr = r & 15, cc = c & 31, ob = rr * 64 + cc * 2; return st * 1024 + (ob ^ (((ob >> 9) & 1) << 5)); }
__host__ __device__ __forceinline__ void stage_rc(int b, int& R, int& C) { const int st = b / 1024, sb = b % 1024, swz = sb ^ (((sb >> 9) & 1) << 5); R = (st >> 1) * 16 + swz / 64; C = (st & 1) * 32 + (swz % 64) / 2; }
__host__ __device__ __forceinline__ int perm32(int rho) { const int n = rho >> 4, i = rho & 15; return 8 * (i >> 2) + 4 * n + (i & 3); }

struct Unit { int pm, pn, kind; };
struct Gemm { const bf16_t* A; const bf16_t* Bt; int M, N, K; const bf16_t* A2; const bf16_t* B2; };

struct StaticOrder {
    int nM, nN, nwg, G, c;
    __host__ __device__ void init(int M, int N, int G_, int c_) { nM = M / BM; nN = N / BM; nwg = nM * nN; G = G_; c = c_; }
    __host__ __device__ bool next(int i, Unit& u) const {
        const long L = (long)i * G + c; if (L >= nwg) return false;
        int wgid = (int)L; { const int q = nwg / NXCD, r = nwg % NXCD, xcd = wgid % NXCD, off = wgid / NXCD; wgid = (xcd < r ? xcd * (q + 1) : r * (q + 1) + (xcd - r) * q) + off; }
        const int nig = WGM * nN, gid = wgid / nig, fm = gid * WGM, gsz = (nM - fm) < WGM ? (nM - fm) : WGM;
        u.pm = fm + ((wgid % nig) % gsz); u.pn = (wgid % nig) / gsz; return true;
    }
    __device__ __forceinline__ void a_ready(const Unit&) const {}
    __device__ __forceinline__ void done(const Unit&) const {}
};

__device__ __forceinline__ unsigned cvt_pk_bf16(float lo, float hi) { unsigned r; asm volatile("v_cvt_pk_bf16_f32 %0, %1, %2" : "=v"(r) : "v"(lo), "v"(hi)); return r; }
typedef float f32x2 __attribute__((ext_vector_type(2)));
__device__ __forceinline__ f32x4 gelu4(f32x4 x) {
    f32x4 o;
#pragma unroll
    for (int i = 0; i < 4; ++i) { const float v = x[i], t = v * (1.f + 0.044715f * v * v); const float e = __builtin_amdgcn_exp2f(-2.3022081981f * t); o[i] = v * __builtin_amdgcn_rcpf(1.f + e); }
    return o;
}
__device__ __forceinline__ f32x4 silu4(f32x4 x) {
    f32x4 o;
#pragma unroll
    for (int i = 0; i < 4; ++i) { const float v = x[i]; const float e = __builtin_amdgcn_exp2f(-1.4426950409f * v); o[i] = v * __builtin_amdgcn_rcpf(1.f + e); }
    return o;
}
__device__ __forceinline__ void store8(bf16_t* p, f32x4 v0, f32x4 v1) {
    u32x4 w; w.x = cvt_pk_bf16(v0[0], v0[1]); w.y = cvt_pk_bf16(v0[2], v0[3]); w.z = cvt_pk_bf16(v1[0], v1[1]); w.w = cvt_pk_bf16(v1[2], v1[3]); *(u32x4*)p = w;
}
struct EpiIn {
    static constexpr bool PERM = true, AFTER_DRAIN = false;
    bf16_t* P; const float* vnw; const float* qnw; const float* knw; const float* ropec; const float* ropes; PG8_LAS float* xch; bf16_t* Kc; bf16_t* Vc;
    const float* cx_in; const float* cx_gate; float* xc1; const float* nrm_w; const float* nrm_mod; bf16_t* Hout; unsigned* cnt;
    __device__ __forceinline__ void operator()(f32x4 (&acc)[2][2][4][2], const Unit& u, int wr, int wc, int fr, int fq) const {
        if (u.kind == 1) { ctx_out(acc, u, wr, wc, fr, fq); return; }
        const int pn = u.pn;
        const int colw = wc * 32 + 8 * fq;
        bf16_t* base = P + (size_t)(u.pm * 256 + wr * 64 + fr) * 5632 + pn * 256 + colw;
        if (pn == 17) {
            const int b = u.pm / 17, rb = (u.pm % 17) * 256 + wr * 64 + fr;
            bf16_t* vb_ = Vc + ((size_t)(b * 2) * 4352 + rb) * 128 + colw;
#pragma unroll
            for (int ai = 0; ai < 2; ++ai)
#pragma unroll
                for (int m = 0; m < 4; ++m)
#pragma unroll
                    for (int bj = 0; bj < 2; ++bj) store8(vb_ + ((size_t)bj * 4352 + ai * 128 + m * 16) * 128, acc[ai][bj][m][0], acc[ai][bj][m][1]);
            return;
        }
        if (pn < 4 || (pn >= 8 && pn < 12) || pn >= 17) {
            const int act = pn < 4 ? 0 : (pn == 17 ? 2 : 1);
#pragma unroll
            for (int ai = 0; ai < 2; ++ai)
#pragma unroll
                for (int m = 0; m < 4; ++m) { bf16_t* rp = base + (size_t)(ai * 128 + m * 16) * 5632;
#pragma unroll
                    for (int bj = 0; bj < 2; ++bj) { f32x4 v0 = acc[ai][bj][m][0], v1 = acc[ai][bj][m][1];
                        if (act == 0) { v0 = gelu4(v0); v1 = gelu4(v1); } else if (act == 1) { v0 = silu4(v0); v1 = silu4(v1); }
                        store8(rp + bj * 128, v0, v1); } }
            return;
        }
        if (pn < 8) gn_path<true>(acc, u, wr, wc, fr, fq, base, colw); else gn_path<false>(acc, u, wr, wc, fr, fq, base, colw);
    }
    __device__ __forceinline__ void ctx_out(const f32x4 (&acc)[2][2][4][2], const Unit& u, int wr, int wc, int fr, int fq) const {
        const int b = u.pm / 17;
        const int col0 = u.pn * 256 + wc * 32 + 8 * fq;
        f32x4 gv[2][2];
#pragma unroll
        for (int bj = 0; bj < 2; ++bj)
#pragma unroll
            for (int n = 0; n < 2; ++n) gv[bj][n] = *(const f32x4*)(cx_gate + col0 + bj * 128 + 4 * n);
        const size_t rbase = (size_t)(b * 256 + wr * 64 + fr) * 2048 + col0;
#pragma unroll
        for (int ai = 0; ai < 2; ++ai)
#pragma unroll
            for (int m = 0; m < 4; ++m) { const size_t ro = rbase + (size_t)(ai * 128 + m * 16) * 2048;
                f32x4 xs[2][2];
#pragma unroll
                for (int bj = 0; bj < 2; ++bj)
#pragma unroll
                    for (int n = 0; n < 2; ++n) xs[bj][n] = *(const f32x4*)(cx_in + ro + bj * 128 + 4 * n);
#pragma unroll
                for (int bj = 0; bj < 2; ++bj)
#pragma unroll
                    for (int n = 0; n < 2; ++n) { const f32x4 o = xs[bj][n] + gv[bj][n] * acc[ai][bj][m][n]; float* dp = xc1 + ro + bj * 128 + 4 * n;
                        asm volatile("global_store_dwordx4 %0, %1, off sc1\n\ts_nop 1" :: "v"(dp), "v"(o) : "memory"); }
                if (m & 1) asm volatile("" ::: "memory"); }
        const bool t0 = (wr == 0 && wc == 0 && fr == 0 && fq == 0);
        asm volatile("s_waitcnt vmcnt(0)" ::: "memory"); __builtin_amdgcn_s_barrier(); asm volatile("" ::: "memory");
        if (t0) { __hip_atomic_fetch_add(cnt + 64 * b, 1u, __ATOMIC_RELAXED, __HIP_MEMORY_SCOPE_AGENT);
            unsigned sp = 0; while (__hip_atomic_load(cnt + 64 * b, __ATOMIC_RELAXED, __HIP_MEMORY_SCOPE_AGENT) < 8u && ++sp < (1u << 18)) __builtin_amdgcn_s_sleep(2);
            __builtin_amdgcn_fence(__ATOMIC_ACQUIRE, "agent"); asm volatile("s_waitcnt vmcnt(0)" ::: "memory"); }
        __builtin_amdgcn_s_barrier(); asm volatile("" ::: "memory");
        { const int w8 = wr * 4 + wc, lane = fr + 16 * fq;
          f32x4 g[8], sh[8];
#pragma unroll
          for (int j = 0; j < 8; ++j) { const int c = 4 * lane + 256 * j; const f32x4 w = *(const f32x4*)(nrm_w + c), sc = *(const f32x4*)(nrm_mod + 2048 + c); g[j] = w * (1.f + sc); sh[j] = *(const f32x4*)(nrm_mod + c); }
          for (int rr = 0; rr < 4; ++rr) { const int rb = u.pn * 32 + w8 * 4 + rr;
              const float* src = xc1 + (size_t)(b * 256 + rb) * 2048;
              f32x4 v[8]; float ss = 0.f;
#pragma unroll
              for (int j = 0; j < 8; ++j) { v[j] = *(const f32x4*)(src + 4 * lane + 256 * j); ss += (v[j][0] * v[j][0] + v[j][1] * v[j][1]) + (v[j][2] * v[j][2] + v[j][3] * v[j][3]); }
#pragma unroll
              for (int o = 1; o < 64; o <<= 1) ss += __shfl_xor(ss, o);
              const float rstd = 1.f / sqrtf(ss * (1.f / 2048.f) + 1e-6f);
              unsigned long long* o8 = (unsigned long long*)(Hout + (size_t)(b * 4352 + rb) * 2048) + lane;
#pragma unroll
              for (int j = 0; j < 8; ++j) { const f32x4 y = v[j] * rstd * g[j] + sh[j]; __hip_atomic_store(o8 + 64 * j, (unsigned long long)cvt_pk_bf16(y[0], y[1]) | ((unsigned long long)cvt_pk_bf16(y[2], y[3]) << 32), __ATOMIC_RELAXED, __HIP_MEMORY_SCOPE_AGENT); } } }
        asm volatile("s_waitcnt vmcnt(0)" ::: "memory"); __builtin_amdgcn_s_barrier(); asm volatile("" ::: "memory");
        if (t0) { __hip_atomic_fetch_add(cnt + 256 + 64 * b, 1u, __ATOMIC_RELAXED, __HIP_MEMORY_SCOPE_AGENT); }
    }
    template <bool ISV>
    __device__ __forceinline__ void gn_path(const f32x4 (&acc)[2][2][4][2], const Unit& u, int wr, int wc, int fr, int fq, bf16_t* base, int colw) const {
        const int pn = u.pn;
#pragma unroll
        for (int ai = 0; ai < 2; ++ai)
#pragma unroll
            for (int m = 0; m < 4; ++m)
#pragma unroll
                for (int bj = 0; bj < 2; ++bj) { f32x4 a = acc[ai][bj][m][0], b = acc[ai][bj][m][1];
                    if (ISV) { a = gelu4(a); b = gelu4(b); }
                    float s = (a[0] * a[0] + a[1] * a[1]) + (a[2] * a[2] + a[3] * a[3]) + (b[0] * b[0] + b[1] * b[1]) + (b[2] * b[2] + b[3] * b[3]);
                    s += __shfl_xor(s, 16); s += __shfl_xor(s, 32);
                    if (fq == 0) xch[(ai * 128 + wr * 64 + m * 16 + fr) * 8 + bj * 4 + wc] = s;
                    if (ISV) __builtin_amdgcn_sched_barrier(0); }
        asm volatile("s_waitcnt lgkmcnt(0)" ::: "memory"); __builtin_amdgcn_s_barrier(); asm volatile("" ::: "memory");
        f32x4 w[2][2];
        if (ISV) {
#pragma unroll
            for (int bj = 0; bj < 2; ++bj)
#pragma unroll
                for (int n = 0; n < 2; ++n) w[bj][n] = *(const f32x4*)(vnw + ((pn - 4) * 2 + bj) * 128 + colw + 4 * n);
        } else {
            const float* nwp = pn < 16 ? qnw : knw; const int dlo = 64 * (wc >> 1) + 16 * (wc & 1) + 4 * fq;
            w[0][0] = *(const f32x4*)(nwp + dlo); w[0][1] = *(const f32x4*)(nwp + dlo + 32); w[1][0] = w[0][0]; w[1][1] = w[0][1];
        }
        const int jt = u.pm % 17;
        const bool rope = !ISV && jt != 0;
#pragma unroll
        for (int ai = 0; ai < 2; ++ai)
#pragma unroll
            for (int m = 0; m < 4; ++m) { const int rl = ai * 128 + wr * 64 + m * 16 + fr; bf16_t* rp = base + (size_t)(ai * 128 + m * 16) * 5632; size_t bjs = 128;
                if (!ISV) { if (pn == 16) { rp = Kc + ((size_t)((u.pm / 17) * 2) * 4352 + jt * 256 + rl) * 128 + colw; bjs = (size_t)4352 * 128; } }
                f32x4 cs = {1.f, 1.f, 1.f, 1.f}, sn = {0.f, 0.f, 0.f, 0.f};
                if (!ISV) { if (rope) { const int t = jt * 256 + rl - 256; const int pos = (wc >> 1) ? (t & 63) : (t >> 6); const int fi = pos * 32 + 16 * (wc & 1) + 4 * fq;
                    cs = *(const f32x4*)(ropec + fi); sn = *(const f32x4*)(ropes + fi); } }
#pragma unroll
                for (int bj = 0; bj < 2; ++bj) { const f32x4 pr = *(const PG8_LAS f32x4*)(xch + rl * 8 + bj * 4);
                    const float rstd = __builtin_amdgcn_rsqf(((pr[0] + pr[1]) + (pr[2] + pr[3])) * (1.f / 128.f) + 1e-6f);
                    f32x4 a0 = acc[ai][bj][m][0], a1 = acc[ai][bj][m][1];
                    if (ISV) { asm volatile("" : "+v"(a0), "+v"(a1));
                        a0 = gelu4(a0); a1 = gelu4(a1); }
                    a0 = a0 * rstd * w[bj][0]; a1 = a1 * rstd * w[bj][1];
                    if (!ISV) { const f32x4 o0 = a0 * cs - a1 * sn, o1 = a1 * cs + a0 * sn; a0 = o0; a1 = o1; }
                    store8(rp + bj * bjs, a0, a1); }
                asm volatile("" ::: "memory"); }
    }
};
struct EpiOut {
    static constexpr bool PERM = false, AFTER_DRAIN = false;
    const float* xsrc; const float* csrc; float* xdst; float* cdst; const float* gate;
    __device__ __forceinline__ void operator()(f32x4 (&acc)[2][2][4][2], const Unit& u, int wr, int wc, int fr, int fq) const {
        const int b = u.pm / 17, jt = u.pm % 17;
        const float* src; float* dst; int grow;
        if (jt == 0) { const size_t off = (size_t)(b * 256) * 2048; src = csrc + off; dst = cdst + off; grow = 4; }
        else { const size_t off = (size_t)(b * 4096 + (jt - 1) * 256) * 2048; src = xsrc + off; dst = xdst + off; grow = b; }
        const int col0 = u.pn * 256 + wc * 32 + 4 * fq;
        f32x4 gv[2][2];
#pragma unroll
        for (int bj = 0; bj < 2; ++bj)
#pragma unroll
            for (int n = 0; n < 2; ++n) gv[bj][n] = *(const f32x4*)(gate + grow * 6144 + col0 + bj * 128 + n * 16);
#pragma unroll
        for (int ai = 0; ai < 2; ++ai)
#pragma unroll
            for (int m = 0; m < 4; ++m) { const size_t ro = (size_t)(wr * 64 + fr + ai * 128 + m * 16) * 2048 + col0;
                f32x4 xs[2][2];
#pragma unroll
                for (int bj = 0; bj < 2; ++bj)
#pragma unroll
                    for (int n = 0; n < 2; ++n) xs[bj][n] = *(const f32x4*)(src + ro + bj * 128 + n * 16);
#pragma unroll
                for (int bj = 0; bj < 2; ++bj)
#pragma unroll
                    for (int n = 0; n < 2; ++n) *(f32x4*)(dst + ro + bj * 128 + n * 16) = xs[bj][n] + gv[bj][n] * acc[ai][bj][m][n];
                if (m & 1) asm volatile("" ::: "memory"); }
    }
};
struct SchedX {
    int nM, nN, nwg, G, c, lat, extra, m2; unsigned* cnt;
    __device__ void init(int nM_, int nN_, int G_, int c_, int lat_, int extra_, int m2_ = 0, unsigned* cnt_ = nullptr) { nM = nM_; nN = nN_; nwg = nM_ * nN_; G = G_; c = c_; lat = lat_; extra = extra_; m2 = m2_; cnt = cnt_; }
    __device__ __forceinline__ void map(int wgid0, Unit& u) const {
        int wgid = wgid0; { const int q = nwg / NXCD, r = nwg % NXCD, xcd = wgid % NXCD, off = wgid / NXCD; wgid = (xcd < r ? xcd * (q + 1) : r * (q + 1) + (xcd - r) * q) + off; }
        const int nig = WGM * nN, gid = wgid / nig, fm = gid * WGM, gsz = (nM - fm) < WGM ? (nM - fm) : WGM;
        const int pmq = fm + ((wgid % nig) % gsz); u.pn = (wgid % nig) / gsz;
        u.pm = lat ? (pmq / 16) * 17 + 1 + (pmq % 16) : pmq;
    }
    __device__ bool next(int i, Unit& u) const {
        u.kind = 0;
        if (m2) {
            int ir = i;
            if (c >= 128 && c < 160) { if (i == 0) { const int j = c - 128; u.kind = 1; u.pm = (j >> 3) * 17; u.pn = j & 7; return true; }
                ir = i - 1; if (ir >= 4) return false; }
            if (c >= 168 && c < 200 && ir == 5) { map(4 * G + (c - 40), u); return true; }
            const long L2 = (long)ir * G + c;
            if (L2 < nwg) { map((int)L2, u); return true; }
            if (c >= 160 && c < 168 && ir == 5) { const int j = c - 160, b = j >> 1; unsigned sp = 0;
                while (__hip_atomic_load(cnt + 256 + 64 * b, __ATOMIC_RELAXED, __HIP_MEMORY_SCOPE_AGENT) < 8u && ++sp < (1u << 18)) __builtin_amdgcn_s_sleep(2);
                __builtin_amdgcn_fence(__ATOMIC_ACQUIRE, "agent");
                u.pm = b * 17; u.pn = 16 + (j & 1); return true; }
            return false;
        }
        long L = (long)i * G + c;
        if (L < nwg) { map((int)L, u); return true; }
        L -= nwg; if (L < extra) { u.pm = (int)(L >> 1) * 17; u.pn = 16 + (int)(L & 1); return true; }
        return false;
    }
    __device__ __forceinline__ void a_ready(const Unit&) const {}
    __device__ __forceinline__ void done(const Unit&) const {}
};
template <class Epi, class Sched, bool ALIGN_EPI = false, bool SP2 = false>
__device__ __forceinline__ void gemm_phase(PG8_LAS unsigned char* lds, const Gemm g, const Sched& S, const Epi& E) {
    int tid_ = threadIdx.x; asm volatile("" : "+v"(tid_));
    const int tid = tid_, wid = __builtin_amdgcn_readfirstlane(tid >> 6), lane = tid & 63, wr = wid >> 2, wc = wid & 3, fr = lane & 15, fq = lane >> 4;
    const int K = g.K, nt = K / BK;
    unsigned voffA[2], voffB[2];
#pragma unroll
    for (int i = 0; i < 2; ++i) { int R, C; stage_rc(tid * 16 + i * 8192, R, C); const int Rb = Epi::PERM ? ((R & ~31) + perm32(R & 31)) : R;
        voffA[i] = (unsigned)(R * K + C) * 2u; voffB[i] = (unsigned)(Rb * K + C) * 2u; }
    const size_t kstep = (size_t)(BK * 2);
    const size_t hstep = (size_t)HALF * K * 2;
    const size_t tstep = 2 * hstep;
    const unsigned ldsw = (unsigned)wid * 1024u;
    const int aoff = lds_byte(wr * 64 + fr, fq * 8), boff = lds_byte(wc * 32 + fr, fq * 8);
#define PG8_SA(b, h) (((b) * 2 + (h)) * HTB)
#define PG8_SB(b, h) ((4 + (b) * 2 + (h)) * HTB)
#define PG8_STAGE(bufoff, gbase, voff) do { _Pragma("unroll") for (int _i = 0; _i < 2; ++_i) \
        __builtin_amdgcn_global_load_lds((const unsigned*)((const char*)(gbase) + (voff)[_i]), (PG8_LAS unsigned*)(lds + (bufoff) + ldsw + _i * 8192), 16, 0, 0); } while (0)
#define PG8_LDA(dst, b, h) do { _Pragma("unroll") for (int m = 0; m < 4; ++m) _Pragma("unroll") for (int k = 0; k < 2; ++k) dst[m][k] = *(const PG8_LAS bf16x8*)(lds + PG8_SA(b, h) + aoff + m * 2048 + k * 1024); } while (0)
#define PG8_LDB(dst, b, h) do { _Pragma("unroll") for (int n = 0; n < 2; ++n) _Pragma("unroll") for (int k = 0; k < 2; ++k) dst[n][k] = *(const PG8_LAS bf16x8*)(lds + PG8_SB(b, h) + boff + n * 2048 + k * 1024); } while (0)
#define PG8_MMA(ai, bj, At, Bt) do { __builtin_amdgcn_s_setprio(1); _Pragma("unroll") for (int m = 0; m < 4; ++m) _Pragma("unroll") for (int n = 0; n < 2; ++n) _Pragma("unroll") for (int k = 0; k < 2; ++k) \
        acc[ai][bj][m][n] = __builtin_amdgcn_mfma_f32_16x16x32_bf16(Bt[n][k], At[m][k], acc[ai][bj][m][n], 0, 0, 0); __builtin_amdgcn_s_setprio(0); } while (0)
#define PG8_WAIT_V(n) asm volatile("s_waitcnt vmcnt(" #n ")" ::: "memory")
#define PG8_WAIT_L(n) asm volatile("s_waitcnt lgkmcnt(" #n ")" ::: "memory")
#define PG8_BAR __builtin_amdgcn_s_barrier()
#define PG8_SCHED __builtin_amdgcn_sched_barrier(0)
    Unit cur, nxt; int ui = 0;
    if (!S.next(0, cur)) return;
    f32x4 acc[2][2][4][2];
#pragma unroll
    for (int a = 0; a < 2; ++a)
#pragma unroll
        for (int b = 0; b < 2; ++b)
#pragma unroll
            for (int m = 0; m < 4; ++m)
#pragma unroll
                for (int n = 0; n < 2; ++n) acc[a][b][m][n] = (f32x4){0.f, 0.f, 0.f, 0.f};
    bf16x8 At[4][2], B0[2][2], B1[2][2];
    const char* cA = (const char*)(cur.kind ? g.A2 : g.A) + (size_t)cur.pm * tstep; const char* cB = (const char*)(cur.kind ? g.B2 : g.Bt) + (size_t)cur.pn * tstep;
    S.a_ready(cur);
    if constexpr (SP2) {
        PG8_STAGE(PG8_SB(0, 0), cB, voffB); PG8_STAGE(PG8_SB(0, 1), cB + hstep, voffB); PG8_STAGE(PG8_SA(0, 0), cA, voffA); PG8_STAGE(PG8_SA(0, 1), cA + hstep, voffA);
        if (wr == 1) PG8_BAR;
        PG8_WAIT_V(2); PG8_BAR;
        PG8_STAGE(PG8_SB(1, 0), cB + kstep, voffB); PG8_STAGE(PG8_SA(1, 0), cA + kstep, voffA); PG8_STAGE(PG8_SB(1, 1), cB + hstep + kstep, voffB);
        PG8_WAIT_V(6); PG8_BAR;
    } else {
        PG8_STAGE(PG8_SB(0, 0), cB, voffB); PG8_STAGE(PG8_SA(0, 0), cA, voffA); PG8_STAGE(PG8_SB(0, 1), cB + hstep, voffB); PG8_STAGE(PG8_SA(0, 1), cA + hstep, voffA);
        if (wr == 1) PG8_BAR;
        PG8_WAIT_V(4); PG8_BAR;
        PG8_STAGE(PG8_SB(1, 0), cB + kstep, voffB); PG8_STAGE(PG8_SA(1, 0), cA + kstep, voffA); PG8_STAGE(PG8_SB(1, 1), cB + hstep + kstep, voffB);
        PG8_WAIT_V(6); PG8_BAR;
    }
    for (;;) {
        const bool has_next = S.next(ui + 1, nxt);
        const char* nA = has_next ? (const char*)(nxt.kind ? g.A2 : g.A) + (size_t)nxt.pm * tstep : cA; const char* nB = has_next ? (const char*)(nxt.kind ? g.B2 : g.Bt) + (size_t)nxt.pn * tstep : cB;
        for (int t = 0; t < nt; t += 2) {
            const bool last = (t == nt - 2);
            const char* a1 = cA + (size_t)(t + 1) * kstep;
            const char* a2 = last ? nA : cA + (size_t)(t + 2) * kstep; const char* b2 = last ? nB : cB + (size_t)(t + 2) * kstep;
            const char* a3 = a2 + kstep; const char* b3 = b2 + kstep;
            if (last && has_next) S.a_ready(nxt);
            if constexpr (SP2) {
            PG8_LDB(B0, 0, 0); PG8_LDB(B1, 0, 1); PG8_SCHED; PG8_LDA(At, 0, 0); PG8_STAGE(PG8_SA(1, 1), a1 + hstep, voffA);
            PG8_WAIT_V(8); PG8_WAIT_L(0); PG8_BAR; PG8_MMA(0, 0, At, B0); PG8_MMA(0, 1, At, B1); PG8_BAR; PG8_SCHED;
            PG8_LDA(At, 0, 1); PG8_STAGE(PG8_SB(0, 0), b2, voffB); PG8_STAGE(PG8_SB(0, 1), b2 + hstep, voffB); PG8_STAGE(PG8_SA(0, 0), a2, voffA);
            PG8_WAIT_V(8); PG8_WAIT_L(0); PG8_BAR; PG8_MMA(1, 0, At, B0); PG8_MMA(1, 1, At, B1); PG8_BAR; PG8_SCHED;
            PG8_LDB(B0, 1, 0); PG8_LDB(B1, 1, 1); PG8_SCHED; PG8_LDA(At, 1, 0); PG8_STAGE(PG8_SA(0, 1), a2 + hstep, voffA);
            PG8_WAIT_V(8); PG8_WAIT_L(0); PG8_BAR; PG8_MMA(0, 0, At, B0); PG8_MMA(0, 1, At, B1); PG8_BAR; PG8_SCHED;
            PG8_LDA(At, 1, 1); PG8_STAGE(PG8_SB(1, 0), b3, voffB); PG8_STAGE(PG8_SB(1, 1), b3 + hstep, voffB); PG8_STAGE(PG8_SA(1, 0), a3, voffA);
            PG8_WAIT_V(8); PG8_WAIT_L(0); PG8_BAR; PG8_MMA(1, 0, At, B0); PG8_MMA(1, 1, At, B1); PG8_BAR; PG8_SCHED;
            } else {
            PG8_LDB(B0, 0, 0); PG8_SCHED; PG8_LDA(At, 0, 0); PG8_STAGE(PG8_SA(1, 1), a1 + hstep, voffA);
            PG8_WAIT_L(8); PG8_BAR; PG8_WAIT_L(0); PG8_MMA(0, 0, At, B0); PG8_BAR; PG8_SCHED;
            PG8_LDB(B1, 0, 1); PG8_STAGE(PG8_SB(0, 0), b2, voffB);
            PG8_BAR; PG8_WAIT_L(0); PG8_MMA(0, 1, At, B1); PG8_BAR;
            PG8_LDA(At, 0, 1); PG8_STAGE(PG8_SA(0, 0), a2, voffA);
            PG8_BAR; PG8_WAIT_L(0); PG8_MMA(1, 0, At, B0); PG8_BAR; PG8_SCHED;
            PG8_STAGE(PG8_SB(0, 1), b2 + hstep, voffB);
            PG8_WAIT_V(6); PG8_BAR; PG8_MMA(1, 1, At, B1); PG8_BAR;
            PG8_LDB(B0, 1, 0); PG8_SCHED; PG8_LDA(At, 1, 0); PG8_STAGE(PG8_SA(0, 1), a2 + hstep, voffA);
            PG8_WAIT_L(8); PG8_BAR; PG8_WAIT_L(0); PG8_MMA(0, 0, At, B0); PG8_BAR; PG8_SCHED;
            PG8_LDB(B1, 1, 1); PG8_STAGE(PG8_SB(1, 0), b3, voffB);
            PG8_BAR; PG8_WAIT_L(0); PG8_MMA(0, 1, At, B1); PG8_BAR;
            PG8_LDA(At, 1, 1); PG8_STAGE(PG8_SA(1, 0), a3, voffA);
            PG8_BAR; PG8_WAIT_L(0); PG8_MMA(1, 0, At, B0); PG8_BAR; PG8_SCHED;
            PG8_STAGE(PG8_SB(1, 1), b3 + hstep, voffB);
            PG8_WAIT_V(6); PG8_BAR; PG8_MMA(1, 1, At, B1); PG8_BAR;
            }
        }
        if constexpr (ALIGN_EPI) { if (wr == 0) PG8_BAR; }
        if constexpr (!Epi::AFTER_DRAIN) { int fr_e = fr, fq_e = fq; asm volatile("" : "+v"(fr_e), "+v"(fq_e));
            E(acc, cur, wr, wc, fr_e, fq_e); S.done(cur); }
        if (!has_next) break;
#pragma unroll
        for (int a = 0; a < 2; ++a)
#pragma unroll
            for (int b = 0; b < 2; ++b)
#pragma unroll
                for (int m = 0; m < 4; ++m)
#pragma unroll
                    for (int n = 0; n < 2; ++n) acc[a][b][m][n] = (f32x4){0.f, 0.f, 0.f, 0.f};
        cur = nxt; cA = nA; cB = nB; ++ui;
        if constexpr (ALIGN_EPI) { if (wr == 1) PG8_BAR; }
    }
    PG8_WAIT_V(0);
    if constexpr (!ALIGN_EPI) { if (wr == 0) PG8_BAR; }
    PG8_BAR;
    if constexpr (Epi::AFTER_DRAIN) { E.fused(acc, cur, wr, wc, fr, fq, lds, wid, lane); S.done(cur); }
#undef PG8_SA
#undef PG8_SB
#undef PG8_STAGE
#undef PG8_LDA
#undef PG8_LDB
#undef PG8_MMA
#undef PG8_WAIT_V
#undef PG8_WAIT_L
#undef PG8_BAR
#undef PG8_SCHED
}
}
namespace at {
using bf16 = __hip_bfloat16;
constexpr int   D = 128, NW = 8, QBLK = 32, KVBLK = 64;
constexpr float SCALE = 0.088388347648318440f;
#ifndef ATTN_THR
#define ATTN_THR 8.f
#endif
constexpr float THR = ATTN_THR;
constexpr int SDEPTH = 2;
constexpr int LDQ = 5632, LDK = 128, LDO = 2048;
constexpr size_t SHM_V = KVBLK * D * 2, SHM_K = KVBLK * D * 2, SHM_ATTN = 2 * SHM_V + 2 * SHM_K + NW * 64 * 4;
using f32x4v = __attribute__((ext_vector_type(4))) float;
using bf16x8 = __attribute__((ext_vector_type(8))) short;
using s16x4  = __attribute__((ext_vector_type(4))) short;
using f32x16 = __attribute__((ext_vector_type(16))) float;
using f32x8  = __attribute__((ext_vector_type(8))) float;
using u32x4  = __attribute__((ext_vector_type(4))) unsigned;
#define KSWZ(row, colB) ((row) * 256 + ((colB) ^ (((row) & 7) << 4)))
#define SBAR() __builtin_amdgcn_sched_barrier(0)
__device__ __forceinline__ int crow(int r, int hi) { return (r & 3) + 8 * (r >> 2) + 4 * hi; }
__device__ __forceinline__ unsigned cvtpk(float lo, float hi) {
  unsigned r; asm volatile("v_cvt_pk_bf16_f32 %0, %1, %2" : "=v"(r) : "v"(lo), "v"(hi)); return r;
}
template <typename TIn> struct Stage;
template <> struct Stage<bf16>  { using T = bf16x8;
  __device__ static __forceinline__ T ld8(const bf16* p) { return *reinterpret_cast<const bf16x8*>(p); }
  __device__ static __forceinline__ bf16x8 tobf(T x) { return x; } };
template <> struct Stage<float> { using T = f32x8;
  __device__ static __forceinline__ T ld8(const float* p) { return *reinterpret_cast<const f32x8*>(p); }
  __device__ static __forceinline__ bf16x8 tobf(T x) {
    u32x4 w = {cvtpk(x[0], x[1]), cvtpk(x[2], x[3]), cvtpk(x[4], x[5]), cvtpk(x[6], x[7])}; return *reinterpret_cast<bf16x8*>(&w); } };

__device__ __forceinline__ void partialSM(f32x16& p0, f32x16& p1, float& m_reg, float& mn, float& alpha) {
  constexpr float C = SCALE * 1.4426950408889634f;
  float pmax = p0[0]; for (int r = 1; r < 16; ++r) pmax = fmaxf(pmax, p0[r]); for (int r = 0; r < 16; ++r) pmax = fmaxf(pmax, p1[r]);
  { auto rr = __builtin_amdgcn_permlane32_swap(__float_as_uint(pmax), __float_as_uint(pmax), false, false);
    pmax = fmaxf(__uint_as_float(rr[0]), __uint_as_float(rr[1])); }
  if (__builtin_expect(__all(pmax - m_reg <= THR / SCALE), 1)) { mn = m_reg; alpha = 1.f; }
  else { mn = fmaxf(m_reg, pmax); alpha = __builtin_amdgcn_exp2f((m_reg - mn) * C); m_reg = mn; }
  float mnC = -mn * C;
  for (int r = 0; r < 16; ++r) p0[r] = fmaf(p0[r], C, mnC); for (int r = 0; r < 16; ++r) p1[r] = fmaf(p1[r], C, mnC);
  for (int r = 0; r < 16; ++r) p0[r] = __builtin_amdgcn_exp2f(p0[r]);
}
__device__ __forceinline__ void finishSM(f32x16& p0, f32x16& p1, float alpha, float& l_reg, bf16x8& pa0, bf16x8& pa1, bf16x8& pa2, bf16x8& pa3) {
  for (int r = 0; r < 16; ++r) p1[r] = __builtin_amdgcn_exp2f(p1[r]);
  float ps = 0; for (int r = 0; r < 16; ++r) ps += p0[r]; for (int r = 0; r < 16; ++r) ps += p1[r];
  { auto rr = __builtin_amdgcn_permlane32_swap(__float_as_uint(ps), __float_as_uint(ps), false, false);
    ps = __uint_as_float(rr[0]) + __uint_as_float(rr[1]); }
  l_reg = l_reg * alpha + ps;
#define PK4(P, BASE, OUT) do { unsigned a0 = cvtpk(P[BASE + 0], P[BASE + 1]), a1 = cvtpk(P[BASE + 2], P[BASE + 3]);   \
    unsigned b0 = cvtpk(P[BASE + 4], P[BASE + 5]), b1 = cvtpk(P[BASE + 6], P[BASE + 7]);                              \
    auto r0 = __builtin_amdgcn_permlane32_swap(a0, b0, false, false); auto r1 = __builtin_amdgcn_permlane32_swap(a1, b1, false, false); \
    u32x4 w = {r0[0], r1[0], r0[1], r1[1]}; OUT = *reinterpret_cast<bf16x8*>(&w); } while (0)
  PK4(p0, 0, pa0); PK4(p0, 8, pa1); PK4(p1, 0, pa2); PK4(p1, 8, pa3);
#undef PK4
}
__device__ __forceinline__ void qkt(f32x16& p0, f32x16& p1, const bf16* Ks, const bf16x8* qr, int r32, int hi) {
  p0 = f32x16{}; p1 = f32x16{};
  for (int d0 = 0; d0 < 8; ++d0) { int cb = (d0 * 16 + hi * 8) * 2;
    bf16x8 b0 = *reinterpret_cast<const bf16x8*>((const char*)Ks + KSWZ(r32, cb));
    bf16x8 b1 = *reinterpret_cast<const bf16x8*>((const char*)Ks + KSWZ(32 + r32, cb));
    p0 = __builtin_amdgcn_mfma_f32_32x32x16_bf16(b0, qr[d0], p0, 0, 0, 0);
    p1 = __builtin_amdgcn_mfma_f32_32x32x16_bf16(b1, qr[d0], p1, 0, 0, 0); }
}
__device__ __forceinline__ int v_st(int k, int c) { const int kk = (k & ~0xC) | ((k & 4) << 1) | ((k & 8) >> 1); return ((kk >> 3) * 4 + (c >> 5)) * 512 + ((kk & 7) * 32 + (c & 31)) * 2; }
__device__ __forceinline__ int v_rd_base(int lane) { return ((lane & 3) << 3) | (((lane >> 2) & 3) << 6) | (((lane >> 4) & 1) << 5) | (((lane >> 5) & 1) << 8); }
constexpr int v_rd_off(int d0, int ks, int half) { return d0 * 512 + ks * 4096 + half * 2048; }
template <int OFF> __device__ __forceinline__ s16x4 tr_read(int vb) {
  s16x4 r; asm volatile("ds_read_b64_tr_b16 %0, %1 offset:%2" : "=&v"(r) : "v"(vb), "i"(OFF) : "memory"); return r;
}
template <int D0> __device__ __forceinline__ void pv_one(f32x16& od, int vb, bf16x8 pa0, bf16x8 pa1, bf16x8 pa2, bf16x8 pa3) {
  const s16x4 l0 = tr_read<v_rd_off(D0, 0, 0)>(vb), h0 = tr_read<v_rd_off(D0, 0, 1)>(vb), l1 = tr_read<v_rd_off(D0, 1, 0)>(vb), h1 = tr_read<v_rd_off(D0, 1, 1)>(vb);
  const s16x4 l2 = tr_read<v_rd_off(D0, 2, 0)>(vb), h2 = tr_read<v_rd_off(D0, 2, 1)>(vb), l3 = tr_read<v_rd_off(D0, 3, 0)>(vb), h3 = tr_read<v_rd_off(D0, 3, 1)>(vb);
  asm volatile("s_waitcnt lgkmcnt(0)" ::: "memory"); SBAR();
#define PK(L, H) (bf16x8){L[0], L[1], L[2], L[3], H[0], H[1], H[2], H[3]}
  od = __builtin_amdgcn_mfma_f32_32x32x16_bf16(pa0, PK(l0, h0), od, 0, 0, 0);
  od = __builtin_amdgcn_mfma_f32_32x32x16_bf16(pa1, PK(l1, h1), od, 0, 0, 0);
  od = __builtin_amdgcn_mfma_f32_32x32x16_bf16(pa2, PK(l2, h2), od, 0, 0, 0);
  od = __builtin_amdgcn_mfma_f32_32x32x16_bf16(pa3, PK(l3, h3), od, 0, 0, 0);
#undef PK
}
__device__ __forceinline__ void pv_d0(f32x16* o, int vb, bf16x8 pa0, bf16x8 pa1, bf16x8 pa2, bf16x8 pa3) {
  pv_one<0>(o[0], vb, pa0, pa1, pa2, pa3); pv_one<1>(o[1], vb, pa0, pa1, pa2, pa3); pv_one<2>(o[2], vb, pa0, pa1, pa2, pa3); pv_one<3>(o[3], vb, pa0, pa1, pa2, pa3);
}

__device__ __forceinline__ void attn_dense_body(const bf16* __restrict__ Qb, const bf16* __restrict__ Kh, const bf16* __restrict__ Vh,
                                                const bf16* __restrict__ Zb, bf16* __restrict__ Ob, int seq, char* lds) {
  using TQ = bf16; using St = Stage<bf16>; using SQ = Stage<TQ>;
  int tid_ = threadIdx.x; asm volatile("" : "+v"(tid_));
  const int tid = tid_, wid = tid >> 6, lane = tid & 63, r32 = lane & 31, hi = lane >> 5;
  bf16* V_lds = (bf16*)lds; bf16* K_lds = (bf16*)(lds + 2 * SHM_V);
  float* ws = (float*)(lds + 2 * SHM_V + 2 * SHM_K) + wid * 64; float* li_l = ws; float* al_l = ws + 32;
  float m_reg = -1e30f, l_reg = 0; f32x16 o[4] = {}; bf16x8 qr[8];
  const TQ* Qw = Qb + (long)(wid * QBLK + r32) * LDQ + hi * 8;
#pragma unroll
  for (int d0 = 0; d0 < 8; ++d0) qr[d0] = SQ::tobf(SQ::ld8(Qw + d0 * 16));
  const int sr = tid >> 4, sc = (tid & 15) * 8, vst0 = v_st(sr, sc), vst1 = v_st(32 + sr, sc);
  const int vb0 = (int)(uintptr_t)V_lds + v_rd_base(lane);
  struct { typename St::T vs0, vs1, ks0, ks1; } sr_[SDEPTH];
#define SLOAD(i, k0) do { sr_[i].vs0 = St::ld8(&Vh[(long)((k0) + sr) * LDK + sc]); sr_[i].vs1 = St::ld8(&Vh[(long)((k0) + 32 + sr) * LDK + sc]); \
    sr_[i].ks0 = St::ld8(&Kh[(long)((k0) + sr) * LDK + sc]); sr_[i].ks1 = St::ld8(&Kh[(long)((k0) + 32 + sr) * LDK + sc]); } while (0)
#define SWRITE(b, i) do { *(bf16x8*)((char*)V_lds + (b) * SHM_V + vst0) = St::tobf(sr_[i].vs0);          \
    *(bf16x8*)((char*)V_lds + (b) * SHM_V + vst1) = St::tobf(sr_[i].vs1); int kc = sc * 2;               \
    *(bf16x8*)((char*)K_lds + (b) * SHM_K + KSWZ(sr, kc)) = St::tobf(sr_[i].ks0);                       \
    *(bf16x8*)((char*)K_lds + (b) * SHM_K + KSWZ(32 + sr, kc)) = St::tobf(sr_[i].ks1); } while (0)
#define SWAIT() do { if constexpr (SDEPTH == 2) asm volatile("s_waitcnt vmcnt(4)" ::: "memory"); else asm volatile("s_waitcnt vmcnt(0)" ::: "memory"); } while (0)
#define RESC(a) do { if (__any((a) < 1.f)) { if (hi == 0) al_l[r32] = (a); asm volatile("s_waitcnt lgkmcnt(0)" ::: "memory"); \
    for (int d = 0; d < 4; ++d) for (int r = 0; r < 16; ++r) o[d][r] *= al_l[crow(r, hi)]; } } while (0)
  f32x16 pA0, pA1, pB0, pB1; float mnA, mnB, alA, alB; bf16x8 pa0, pa1, pa2, pa3; const int NT = seq / KVBLK;
  constexpr int SE = 0, SO = SDEPTH - 1;
  SLOAD(SE, 0); asm volatile("s_waitcnt vmcnt(0)" ::: "memory"); SWRITE(0, SE); __syncthreads();
  qkt(pA0, pA1, K_lds, qr, r32, hi); partialSM(pA0, pA1, m_reg, mnA, alA);
  SLOAD(SO, KVBLK); if constexpr (SDEPTH == 2) { if (2 < NT) SLOAD(SE, 2 * KVBLK); }
  SWAIT(); SWRITE(1, SO); __syncthreads();
  for (int j = 1; j + 1 < NT; j += 2) {
    SBAR(); qkt(pB0, pB1, (bf16*)((char*)K_lds + SHM_K), qr, r32, hi);
    finishSM(pA0, pA1, alA, l_reg, pa0, pa1, pa2, pa3); SBAR();
    SLOAD(SO, (j + SDEPTH) * KVBLK); SBAR();
    pv_d0(o, vb0, pa0, pa1, pa2, pa3); partialSM(pB0, pB1, m_reg, mnB, alB);
    __syncthreads(); SWAIT(); SWRITE(0, SE);
    RESC(alB); __syncthreads();
    SBAR(); qkt(pA0, pA1, K_lds, qr, r32, hi);
    finishSM(pB0, pB1, alB, l_reg, pa0, pa1, pa2, pa3); SBAR();
    if (SDEPTH == 1 || j + 3 < NT) SLOAD(SE, (j + 1 + SDEPTH) * KVBLK); SBAR();
    pv_d0(o, vb0 + (int)SHM_V, pa0, pa1, pa2, pa3); partialSM(pA0, pA1, m_reg, mnA, alA);
    __syncthreads(); SWAIT(); SWRITE(1, SO);
    RESC(alA); __syncthreads();
  }
  SBAR(); qkt(pB0, pB1, (bf16*)((char*)K_lds + SHM_K), qr, r32, hi);
  finishSM(pA0, pA1, alA, l_reg, pa0, pa1, pa2, pa3); SBAR();
  pv_d0(o, vb0, pa0, pa1, pa2, pa3); partialSM(pB0, pB1, m_reg, mnB, alB);
  __syncthreads(); RESC(alB);
  finishSM(pB0, pB1, alB, l_reg, pa0, pa1, pa2, pa3); SBAR();
  pv_d0(o, vb0 + (int)SHM_V, pa0, pa1, pa2, pa3);
  if (hi == 0) li_l[r32] = l_reg; asm volatile("s_waitcnt lgkmcnt(0)" ::: "memory");
  float rli[16];
#pragma unroll
  for (int r = 0; r < 16; ++r) rli[r] = __builtin_amdgcn_rcpf(li_l[crow(r, hi)]);
  bf16* Ow = Ob + (long)(wid * QBLK) * LDO; const bf16* Zw = Zb + (long)(wid * QBLK) * LDQ;
  char* stg = lds + (2 * SHM_V + 2 * SHM_K + NW * 64 * 4) + wid * (32 * 272);
#pragma unroll
  for (int r = 0; r < 16; ++r) { const int orow = crow(r, hi);
#pragma unroll
    for (int d0 = 0; d0 < 4; ++d0) *(unsigned short*)(stg + orow * 272 + (d0 * 32 + r32) * 2) = (unsigned short)cvtpk(o[d0][r] * rli[r], 0.f); }
  asm volatile("s_waitcnt lgkmcnt(0)" ::: "memory");
  { const int c8 = (lane & 15) * 8, rq = lane >> 4;
#pragma unroll
    for (int i = 0; i < 8; ++i) { const int row = rq + 4 * i;
      const u32x4 ov = *reinterpret_cast<const u32x4*>(stg + row * 272 + c8 * 2);
      const u32x4 zv = *reinterpret_cast<const u32x4*>(Zw + (long)row * LDQ + c8);
      u32x4 w;
#define OZ(k) cvtpk(__uint_as_float(ov[k] << 16) * __uint_as_float(zv[k] << 16), __uint_as_float(ov[k] & 0xffff0000u) * __uint_as_float(zv[k] & 0xffff0000u))
      w[0] = OZ(0); w[1] = OZ(1); w[2] = OZ(2); w[3] = OZ(3);
#undef OZ
      *reinterpret_cast<u32x4*>(Ow + (long)row * LDO + c8) = w; } }
#undef SLOAD
#undef SWRITE
#undef SWAIT
#undef RESC
}
template <int D0> __device__ __forceinline__ void sgu_one(f32x16& od, int vb, bf16x8 w0, bf16x8 w1, bf16x8 w2, bf16x8 w3) {
  const s16x4 l0 = tr_read<v_rd_off(D0, 0, 0)>(vb), h0 = tr_read<v_rd_off(D0, 0, 1)>(vb), l1 = tr_read<v_rd_off(D0, 1, 0)>(vb), h1 = tr_read<v_rd_off(D0, 1, 1)>(vb);
  const s16x4 l2 = tr_read<v_rd_off(D0, 2, 0)>(vb), h2 = tr_read<v_rd_off(D0, 2, 1)>(vb), l3 = tr_read<v_rd_off(D0, 3, 0)>(vb), h3 = tr_read<v_rd_off(D0, 3, 1)>(vb);
  asm volatile("s_waitcnt lgkmcnt(0)" ::: "memory"); SBAR();
#define PK(L, H) (bf16x8){L[0], L[1], L[2], L[3], H[0], H[1], H[2], H[3]}
  od = __builtin_amdgcn_mfma_f32_32x32x16_bf16(PK(l0, h0), w0, od, 0, 0, 0);
  od = __builtin_amdgcn_mfma_f32_32x32x16_bf16(PK(l1, h1), w1, od, 0, 0, 0);
  od = __builtin_amdgcn_mfma_f32_32x32x16_bf16(PK(l2, h2), w2, od, 0, 0, 0);
  od = __builtin_amdgcn_mfma_f32_32x32x16_bf16(PK(l3, h3), w3, od, 0, 0, 0);
#undef PK
}
__device__ __forceinline__ float bf_lo(unsigned w) { return __uint_as_float(w << 16); }
__device__ __forceinline__ float bf_hi(unsigned w) { return __uint_as_float(w & 0xffff0000u); }
constexpr int SGU_S_OFF = 2 * (int)SHM_V, SGU_S_LD = 132;
struct SguRegs { bf16x8 t00, t01, t10, t11; u32x4 uu[4], zz[4]; };
__device__ __forceinline__ void sgu_load(SguRegs& R, const bf16* __restrict__ Pb, int item, int sr, int sc, int lat) {
  const int ci = item >> 3, g = item & 7; const int chunk = lat ? (ci >> 5) * 34 + 2 + (ci & 31) : ci;     const long R0 = (long)chunk * 128;
  const bf16* vsrc = Pb + R0 * LDQ + 1024 + g * 128 + sc;
  R.t00 = *reinterpret_cast<const bf16x8*>(vsrc + (long)(sr) * LDQ); R.t01 = *reinterpret_cast<const bf16x8*>(vsrc + (long)(32 + sr) * LDQ);
  R.t10 = *reinterpret_cast<const bf16x8*>(vsrc + (long)(64 + sr) * LDQ); R.t11 = *reinterpret_cast<const bf16x8*>(vsrc + (long)(96 + sr) * LDQ);
  const bf16* urow = Pb + (R0 + sr) * LDQ + g * 128 + sc;
#pragma unroll
  for (int k = 0; k < 4; ++k) { R.uu[k] = *reinterpret_cast<const u32x4*>(urow + (long)(32 * k) * LDQ); R.zz[k] = *reinterpret_cast<const u32x4*>(urow + (long)(32 * k) * LDQ + 2048); }
}
__device__ __forceinline__ void sgu_phase(const bf16* __restrict__ Pb, bf16* __restrict__ YC, const bf16* __restrict__ Wf  ,
                                          const float* __restrict__ bsgu  , int first, int stride, int nitems, char* lds, int lat) {
  int tid_ = threadIdx.x; asm volatile("" : "+v"(tid_));
  const int tid = tid_, wid = tid >> 6, lane = tid & 63, r32 = lane & 31, hi = lane >> 5;
  bf16* V_lds = (bf16*)lds; float* S_lds = (float*)(lds + SGU_S_OFF);
  const int sr = tid >> 4, sc = (tid & 15) * 8, vst0 = v_st(sr, sc), vst1 = v_st(32 + sr, sc);
  const int pb = wid & 3, P0 = 32 * pb, DB = 2 * (wid >> 2);
  const int vb = (int)(uintptr_t)V_lds + v_rd_base(lane) + DB * 512;
  if (first >= nitems) return;
  SguRegs C, N;
  sgu_load(C, Pb, first, sr, sc, lat);
  for (int item = first; item < nitems; item += stride) {
    const int ci = item >> 3, g = item & 7; const int chunk = lat ? (ci >> 5) * 34 + 2 + (ci & 31) : ci; const long R0 = (long)chunk * 128;
    *(bf16x8*)((char*)V_lds + vst0) = C.t00; *(bf16x8*)((char*)V_lds + vst1) = C.t01;
    *(bf16x8*)((char*)V_lds + SHM_V + vst0) = C.t10; *(bf16x8*)((char*)V_lds + SHM_V + vst1) = C.t11;
    const bf16x8* wfp = reinterpret_cast<const bf16x8*>(Wf) + ((long)(g * 4 + pb) * 8) * 64 + lane;
    bf16x8 wf[2][4];
#pragma unroll
    for (int T = 0; T < 2; ++T)
#pragma unroll
      for (int s = 0; s < 4; ++s) wf[T][s] = wfp[(T * 4 + s) * 64];
    const bool has_next = item + stride < nitems;
    if (has_next) sgu_load(N, Pb, item + stride, sr, sc, lat);
    __syncthreads();
    f32x16 o0 = {}, o1 = {};
    sgu_one<0>(o0, vb, wf[0][0], wf[0][1], wf[0][2], wf[0][3]); sgu_one<1>(o1, vb, wf[0][0], wf[0][1], wf[0][2], wf[0][3]);
    sgu_one<0>(o0, vb + (int)SHM_V, wf[1][0], wf[1][1], wf[1][2], wf[1][3]); sgu_one<1>(o1, vb + (int)SHM_V, wf[1][0], wf[1][1], wf[1][2], wf[1][3]);
#pragma unroll
    for (int dd = 0; dd < 2; ++dd)
#pragma unroll
      for (int g4 = 0; g4 < 4; ++g4) { const int d = 32 * (DB + dd) + 8 * g4 + 4 * hi; const f32x16& o = dd ? o1 : o0;
        *reinterpret_cast<f32x4v*>(S_lds + (P0 + r32) * SGU_S_LD + d) = (f32x4v){o[4 * g4 + 0], o[4 * g4 + 1], o[4 * g4 + 2], o[4 * g4 + 3]}; }
    __syncthreads();
#pragma unroll
    for (int k = 0; k < 4; ++k) { const int row = sr + 32 * k; const float bias = bsgu[g * 128 + row];
      const f32x4v s0 = *reinterpret_cast<const f32x4v*>(S_lds + row * SGU_S_LD + sc), s1 = *reinterpret_cast<const f32x4v*>(S_lds + row * SGU_S_LD + sc + 4);
      const u32x4 u = C.uu[k], z = C.zz[k]; u32x4 w;
      w.x = cvtpk(bf_lo(u.x) * (s0[0] + bias) * bf_lo(z.x), bf_hi(u.x) * (s0[1] + bias) * bf_hi(z.x));
      w.y = cvtpk(bf_lo(u.y) * (s0[2] + bias) * bf_lo(z.y), bf_hi(u.y) * (s0[3] + bias) * bf_hi(z.y));
      w.z = cvtpk(bf_lo(u.z) * (s1[0] + bias) * bf_lo(z.z), bf_hi(u.z) * (s1[1] + bias) * bf_hi(z.z));
      w.w = cvtpk(bf_lo(u.w) * (s1[2] + bias) * bf_lo(z.w), bf_hi(u.w) * (s1[3] + bias) * bf_hi(z.w));
      *reinterpret_cast<u32x4*>(YC + (R0 + row) * LDO + g * 128 + sc) = w; }
    if (has_next) C = N;
    __syncthreads();
  }
}
}
typedef float f32x4 __attribute__((ext_vector_type(4)));
typedef unsigned v4u __attribute__((ext_vector_type(4)));
typedef unsigned short bf16_t;
#define LDS_WAIT() asm volatile("s_waitcnt lgkmcnt(0)" ::: "memory")
__device__ __forceinline__ unsigned f2bf(float f) { unsigned u = __builtin_bit_cast(unsigned, f); return (u + 0x7fffu + ((u >> 16) & 1u)) >> 16; }
__device__ __forceinline__ unsigned pk2(float lo, float hi) { return f2bf(lo) | (f2bf(hi) << 16); }
__device__ __forceinline__ float wave_sum(float v) {
#pragma unroll
    for (int o = 1; o < 64; o <<= 1) v += __shfl_xor(v, o);
    return v;
}
__device__ __forceinline__ int physrow_in(int c) {
    if (c < C_Q || c >= C_VA) return c;
    const int d = c & 127; const int p = (d & 0x40) | ((d & 0x10) << 1) | ((d & 0xC) << 1) | ((d & 0x20) >> 3) | (d & 3);
    return (c & ~127) | p;
}
__device__ __forceinline__ void p0_transpose_item(const float* W, int K, int N, bf16_t* WT, bool perm, LAS float* scr, int item, int lane) {
    const int nblk = N / 32, kb = item / nblk, nb = item % nblk, k0 = 64 * kb, n0 = 32 * nb;
#pragma unroll 8
    for (int i = 0; i < 32; ++i) { const int kk = 2 * i + (lane >> 5); scr[kk * 33 + (lane & 31)] = W[(size_t)(k0 + kk) * N + n0 + (lane & 31)]; }
    LDS_WAIT(); asm volatile("" ::: "memory");
    const int c = lane & 7;
#pragma unroll
    for (int j = 0; j < 4; ++j) { const int n = (lane >> 3) + 8 * j; const LAS float* s = scr + (8 * c) * 33 + n;
        v4u o; o.x = pk2(s[0 * 33], s[1 * 33]); o.y = pk2(s[2 * 33], s[3 * 33]); o.z = pk2(s[4 * 33], s[5 * 33]); o.w = pk2(s[6 * 33], s[7 * 33]);
        const int rown = perm ? physrow_in(n0 + n) : (n0 + n);
        *(v4u*)(WT + (size_t)rown * K + k0 + 8 * c) = o; }
    LDS_WAIT(); asm volatile("" ::: "memory");
}
__device__ __forceinline__ void p0_prologue(const Args& a, LAS unsigned char* lds, int tid, int lane, int wave, int vcu, int G) {
    float* mod = (float*)(a.ws + WS_MOD);
#pragma nounroll
    for (int st = 0; st < 2; ++st) {
    if (((st ^ vcu) & 1) == 0) {
    {
        LAS float* sl = (LAS float*)lds; LAS float* red = (LAS float*)(lds + 40960);
        for (int i = tid; i < 5 * 2048; i += 512) { const float v = (i < 4 * 2048) ? a.in[1][i] : a.in[3][i - 4 * 2048]; sl[i] = v / (1.f + __expf(-v)); }
        __syncthreads();
        const int cgp = tid % 12, kl = tid / 12;
        for (int item = vcu; item < 256; item += G) {
            const int l = item >> 7, j0 = (item & 127) * 48;
            if (kl < 42) {
                f32x4 acc[5];
#pragma unroll
                for (int r = 0; r < 5; ++r) acc[r] = (f32x4){0.f, 0.f, 0.f, 0.f};
                const float* wp = a.in[5] + (size_t)l * 2048 * 6144 + j0 + cgp * 4;
#pragma unroll 4
                for (int k = kl; k < 2048; k += 42) { const f32x4 w = *(const f32x4*)(wp + (size_t)k * 6144);
#pragma unroll
                    for (int r = 0; r < 5; ++r) acc[r] += sl[r * 2048 + k] * w; }
#pragma unroll
                for (int r = 0; r < 5; ++r) *(LAS f32x4*)(red + (kl * 5 + r) * 48 + cgp * 4) = acc[r];
            }
            __syncthreads();
            if (tid < 240) { const int r = tid / 48, c = tid % 48; float s = 0.f;
                for (int q = 0; q < 42; ++q) s += red[(q * 5 + r) * 48 + c];
                mod[(l * 5 + r) * 6144 + j0 + c] = s + a.in[6][l * 6144 + j0 + c]; }
            __syncthreads();
        }
    }
    } else {
    {
        LAS float* scr = (LAS float*)(lds + wave * 16384);
        const int gw = vcu * 8 + wave, NGW = G * 8;
        bf16_t* WinT = (bf16_t*)(a.ws + WS_WIN); bf16_t* WoutT = (bf16_t*)(a.ws + WS_WOUT);
        constexpr int I_IN = 32 * (DIN / 32), I_OUT = 32 * (DM / 32), I_L = I_IN + I_OUT;
        for (int it = gw; it < 2 * I_L; it += NGW) { const int l = it / I_L; const int r = it - l * I_L;
            if (r < I_IN) p0_transpose_item(a.in[7] + (size_t)l * DM * DIN, DM, DIN, WinT + (size_t)l * DIN * DM, true, scr, r, lane);
            else p0_transpose_item(a.in[13] + (size_t)l * DM * DM, DM, DM, WoutT + (size_t)l * DM * DM, false, scr, r - I_IN, lane); }
    }
    }
    __syncthreads(); }
    if (vcu == G - 1) {
        float* rc = (float*)(a.ws + WS_ROPE); float* rs = rc + 2048;
        for (int idx = tid; idx < 2048; idx += 512) { const int pos = idx >> 5, i = idx & 31;
            const float inv = exp2f(-(float)(2 * i) * (1.f / 64.f) * 13.287712379549449f);
            const float ang = (float)pos * inv; rc[idx] = cosf(ang); rs[idx] = sinf(ang); }
    }
    {
        v4u* Wf = (v4u*)(a.ws + WS_WSGU);
        for (int idx = vcu * 512 + tid; idx < 2 * 8 * 4 * 8 * 64; idx += G * 512) { const int ln = idx & 63, ts = (idx >> 6) & 7, pbb = (idx >> 9) & 3, lg = idx >> 11;
            const float* q = a.in[8] + ((size_t)lg * 128 + 32 * pbb + (ln & 31)) * 128 + 16 * ts + 8 * (ln >> 5);
            const f32x4 lo = *(const f32x4*)q, hh = *(const f32x4*)(q + 4);
            v4u o; o.x = pk2(lo[0], lo[1]); o.y = pk2(lo[2], lo[3]); o.z = pk2(hh[0], hh[1]); o.w = pk2(hh[2], hh[3]); Wf[idx] = o; }
    }
}
__device__ __forceinline__ void pA_norm(const Args& a, int l, int gw, int NGW, int lane_) {
    int lane = lane_; asm volatile("" : "+v"(lane));
    const float* mod = (const float*)(a.ws + WS_MOD) + (size_t)l * 5 * 6144;
    const float* nw = a.in[4] + l * DM;
    const float* xc1 = (const float*)(a.ws + WS_XC1);
    bf16_t* H = (bf16_t*)(a.ws + WS_H);
    const int rpw = (MROWS + NGW - 1) / NGW;
    const int R0 = gw * rpw, R1 = (R0 + rpw < MROWS) ? R0 + rpw : MROWS;
    int cur = -1; f32x4 g[8], sh[8];
    for (int R = R0; R < R1; ++R) {
        const int b = R / RPB, rb = R - b * RPB; const bool isctx = rb < CTX; const int rm = isctx ? 4 : b;
        if (l == 1 && isctx && NGW == 2048) continue;
        const float* src = (l == 0) ? (isctx ? a.in[2] + (size_t)(b * CTX + rb) * DM : a.in[0] + (size_t)(b * SEQ + rb - CTX) * DM)
                                    : (isctx ? xc1 + (size_t)(b * CTX + rb) * DM : a.out + (size_t)(b * SEQ + rb - CTX) * DM);
        if (rm != cur) { cur = rm;
#pragma unroll
            for (int j = 0; j < 8; ++j) { const int c = 4 * lane + 256 * j; const f32x4 w = *(const f32x4*)(nw + c), sc = *(const f32x4*)(mod + rm * 6144 + 2048 + c);
                g[j] = w * (1.f + sc); sh[j] = *(const f32x4*)(mod + rm * 6144 + c); } }
        f32x4 v[8]; float s = 0.f;
#pragma unroll
        for (int j = 0; j < 8; ++j) { v[j] = *(const f32x4*)(src + 4 * lane + 256 * j); s += (v[j][0] * v[j][0] + v[j][1] * v[j][1]) + (v[j][2] * v[j][2] + v[j][3] * v[j][3]); }
        const float rstd = 1.f / sqrtf(wave_sum(s) * (1.f / DM) + EPS);
        unsigned long long* o8 = (unsigned long long*)(H + (size_t)R * DM) + lane;
#pragma unroll
        for (int j = 0; j < 8; ++j) { const f32x4 y = v[j] * rstd * g[j] + sh[j]; o8[64 * j] = (unsigned long long)pk2(y[0], y[1]) | ((unsigned long long)pk2(y[2], y[3]) << 32); }
    }
}

#define RLX_AGENT __ATOMIC_RELAXED, __HIP_MEMORY_SCOPE_AGENT
#define XB_TMO      128
#define XB_XCNT(j)  (256  + 64 * (j))
#define XB_XSUB(j)  (1280 + 64 * (j))
#define XB_XGEN(j)  (2304 + 64 * (j))
#define XB_TOP      3328
#define XB_TOPGEN   3392
#define XCD_BAR_WORDS 3456
#define XB_SPIN_CAP (1u << 18)

__device__ __forceinline__ unsigned xb_ld(unsigned* p)              { return __hip_atomic_load(p, __ATOMIC_RELAXED, __HIP_MEMORY_SCOPE_AGENT); }
__device__ __forceinline__ unsigned xb_add(unsigned* p, unsigned v) { return __hip_atomic_fetch_add(p, v, __ATOMIC_RELAXED, __HIP_MEMORY_SCOPE_AGENT); }
__device__ __forceinline__ unsigned xb_xcc_id() { return (unsigned)__builtin_amdgcn_s_getreg((3 << 11) | 20) & 0xFu; }
#define XB_SPIN(cond, bar) do { unsigned _sp = 0; while (cond) { __builtin_amdgcn_s_sleep(1); \
    if ((++_sp & 255u) == 0u) { if (xb_ld(&(bar)[XB_TMO])) break; if (_sp > XB_SPIN_CAP) { atomicAdd(&(bar)[XB_TMO], 1u); break; } } } } while (0)

struct XcdBarrier {
    unsigned* bar; unsigned x;
    volatile LAS unsigned* st;
};

__device__ __forceinline__ XcdBarrier xcd_barrier_post(unsigned* bar, volatile LAS unsigned* st) {
    XcdBarrier b; b.bar = bar; b.x = xb_xcc_id(); b.st = st;
    if (threadIdx.x == 0) (void)xb_add(&bar[XB_XCNT(b.x)], 1u);
    return b;
}
__device__ __forceinline__ void xcd_barrier_complete(unsigned* bar, unsigned x, unsigned& nloc, unsigned& nx) {
    const unsigned G = gridDim.x * gridDim.y * gridDim.z;
    unsigned sum, cnt, mine, sp = 0u;
    for (;;) {
        sum = 0u; cnt = 0u; mine = 0u;
#pragma unroll
        for (unsigned j = 0; j < 16; ++j) { const unsigned c = xb_ld(&bar[XB_XCNT(j)]); sum += c; cnt += (c > 0u) ? 1u : 0u; mine = (j == x) ? c : mine; }
        if (sum == G) break;
        __builtin_amdgcn_s_sleep(1);
        if ((++sp & 255u) == 0u) { if (xb_ld(&bar[XB_TMO])) break; if (sp > XB_SPIN_CAP) { atomicAdd(&bar[XB_TMO], 1u); break; } }
    }
    nloc = mine > 0u ? mine : 1u; nx = cnt > 0u ? cnt : 1u;
}

__device__ __forceinline__ void xcd_barrier(const XcdBarrier& b) {
    asm volatile("s_waitcnt vmcnt(0)" ::: "memory");
    __syncthreads();
    if (threadIdx.x == 0) {
        unsigned* bar = b.bar;
        __builtin_amdgcn_s_waitcnt(0);
        unsigned nloc = b.st[0], nx = b.st[1];
        if (nloc == 0u) { xcd_barrier_complete(bar, b.x, nloc, nx); b.st[0] = nloc; b.st[1] = nx; }
        const unsigned old = xb_add(&bar[XB_XSUB(b.x)], 1u);
        const unsigned gen = old / nloc;
        if (old + 1u == (gen + 1u) * nloc) {
            __builtin_amdgcn_fence(__ATOMIC_RELEASE, "agent");
            asm volatile("s_waitcnt vmcnt(0)" ::: "memory");
            const unsigned og = xb_add(&bar[XB_TOP], 1u);
            const unsigned tg = og / nx;
            if (og + 1u == (tg + 1u) * nx) xb_add(&bar[XB_TOPGEN], 1u);
            else XB_SPIN(xb_ld(&bar[XB_TOPGEN]) == tg, bar);
            __builtin_amdgcn_fence(__ATOMIC_ACQUIRE, "agent");
            xb_add(&bar[XB_XGEN(b.x)], 1u);
            asm volatile("s_waitcnt vmcnt(0)" ::: "memory");
        } else {
            XB_SPIN(xb_ld(&bar[XB_XGEN(b.x)]) == gen, bar);
            __builtin_amdgcn_fence(__ATOMIC_ACQUIRE, "agent");
            asm volatile("s_waitcnt vmcnt(0)" ::: "memory");
        }
    }
    __syncthreads();
}

__global__ void __launch_bounds__(512, 2) mk_fwd(Args a) {
    extern __shared__ __attribute__((aligned(16))) unsigned char lds[];
    cg::grid_group grid = cg::this_grid();
    LAS unsigned char* L = (LAS unsigned char*)lds;
    const int tid = threadIdx.x, lane = tid & 63, wave = __builtin_amdgcn_readfirstlane(tid >> 6);
    const int G = gridDim.x, bx = blockIdx.x; const int vcu = (G % 8 == 0) ? (bx % 8) * (G / 8) + bx / 8 : bx;
    const int lo = a.ph_lo, hi = a.ph_hi;
#define IN(k) (lo <= (k) && (k) < hi)
#define SEAM(k) do { if (IN(k) && IN((k) + 1)) { if (a.coop == 2) grid.sync(); else xcd_barrier(xbar); } } while (0)
    volatile LAS unsigned* xst = (volatile LAS unsigned*)(L + XCH_OFF + 8192);
    if (tid < 2) xst[tid] = 0u;
    __syncthreads();
    XcdBarrier xbar; xbar.bar = (unsigned*)(a.ws + WS_BAR); xbar.x = 0; xbar.st = xst;
    if (a.coop) xbar = xcd_barrier_post((unsigned*)(a.ws + WS_BAR), xst);

    bf16_t* Hb = (bf16_t*)(a.ws + WS_H); bf16_t* Pb = (bf16_t*)(a.ws + WS_P);
    if (IN(0)) { p0_prologue(a, L, tid, lane, wave, vcu, G); }
    SEAM(0);
#pragma nounroll
    for (int l = 0; l < 2; ++l) {
        const int pb = 1 + 4 * l;
        if (IN(pb)) { pA_norm(a, l, vcu * 8 + wave, G * 8, lane); }
        SEAM(pb);
        if (IN(pb + 1)) {
            const int m2 = (G == 256) ? 1 : 0;
            pg8::Gemm g{Hb, (const bf16_t*)(a.ws + WS_WIN) + (size_t)l * DIN * DM, MROWS, DIN, DM, Hb, (const bf16_t*)(a.ws + WS_WOUT)};
            pg8::SchedX S; if (l == 0) S.init(68, 22, G, bx, 0, 0); else S.init(64, 22, G, bx, 1, m2 ? 0 : 8, m2, (unsigned*)(a.ws + WS_BAR) + 3584);
            pg8::EpiIn E{Pb, a.in[10] + l * 1024, a.in[11] + l * 128, a.in[12] + l * 128, (const float*)(a.ws + WS_ROPE), (const float*)(a.ws + WS_ROPE) + 2048, (LAS float*)(L + XCH_OFF), (bf16_t*)(a.ws + WS_KC), (bf16_t*)(a.ws + WS_VC),
                         a.in[2], (const float*)(a.ws + WS_MOD) + 4 * 6144 + 4096, (float*)(a.ws + WS_XC1), a.in[4] + DM, (const float*)(a.ws + WS_MOD) + (5 + 4) * 6144, Hb, (unsigned*)(a.ws + WS_BAR) + 3584};
            pg8::gemm_phase<pg8::EpiIn, pg8::SchedX, true, true>(L, g, S, E);
        }
        SEAM(pb + 1);
        if (IN(pb + 2)) {
            const at::bf16* P = (const at::bf16*)Pb; at::bf16* YC = (at::bf16*)Hb;
#pragma nounroll
            for (int st = 0; st < 2; ++st) {
            const bool do_sgu = (((st ^ vcu) & 1) == 0);
            if (do_sgu) { if (a.sub & 1)
            at::sgu_phase(P, YC, (const at::bf16*)(a.ws + WS_WSGU) + (size_t)l * 8 * 128 * 128, a.in[9] + l * 8 * 128, vcu, G, l == 0 ? 136 * 8 : 128 * 8, (char*)lds, l); }
            else {
            const int ntot = (a.sub & 2) ? 512 + (l == 0 ? 32 : 0) : 0;
            for (int i = 0;; ++i) { int Li = i * G + vcu; if (Li >= 512) Li -= 64;
                if (Li >= ntot || (i >= 2 && Li < 512)) break;
                int b, h, qrow, seq;
                if (Li < 512) { const int qb = Li & 15; h = (Li >> 4) & 7; b = Li >> 7; qrow = b * RPB + CTX + qb * 256; seq = RPB; }
                else { const int c = Li - 512; b = c >> 3; h = c & 7; qrow = b * RPB; seq = CTX; }
                const long krow = (long)b * RPB; const int kvh = h >> 2;
                const long kvo = ((long)(b * 2 + kvh) * RPB) * 128;
                at::attn_dense_body(P + (long)qrow * DIN + C_Q + h * 128, (const at::bf16*)(a.ws + WS_KC) + kvo, (const at::bf16*)(a.ws + WS_VC) + kvo,
                                    P + (long)qrow * DIN + C_ZB + h * 128, YC + (long)qrow * DM + 1024 + h * 128, seq, (char*)lds);
                __syncthreads(); } }
            __syncthreads(); }
        }
        SEAM(pb + 2);
        if (IN(pb + 3)) {
            pg8::Gemm g{Hb, (const bf16_t*)(a.ws + WS_WOUT) + (size_t)l * DM * DM, MROWS, DM, DM};
            pg8::SchedX S; if (l == 0 && G != 256) S.init(68, 8, G, bx, 0, 0); else S.init(64, 8, G, bx, 1, 0);
            pg8::EpiOut E{l == 0 ? a.in[0] : a.out, a.in[2], a.out, (float*)(a.ws + WS_XC1), (const float*)(a.ws + WS_MOD) + (size_t)l * 5 * 6144 + 4096};
            pg8::gemm_phase<pg8::EpiOut, pg8::SchedX, false, true>(L, g, S, E);
        }
        SEAM(pb + 3);
    }
#undef IN
#undef SEAM
}

extern "C" void kernel_launch(void* const* d_in, const int* in_sizes, int n_in, void* d_out, int out_size, void* d_ws, size_t ws_size, hipStream_t stream) {
    static int grid = 0;
    if (grid == 0) {
        if (n_in != 14 || in_sizes[0] != NB * SEQ * DM || out_size != NB * SEQ * DM || ws_size < WS_END) {
            fprintf(stderr, "kernel_launch: shape mismatch (n_in %d, in0 %d, out %d, ws %zu; need ws >= %zu); nothing launched\n", n_in, n_in > 0 ? in_sizes[0] : -1, out_size, ws_size, (size_t)WS_END); grid = -1; return; }
        int dev = 0, cus = 0, per_cu = 0;
        if (hipGetDevice(&dev) != hipSuccess || hipDeviceGetAttribute(&cus, hipDeviceAttributeMultiprocessorCount, dev) != hipSuccess) { fprintf(stderr, "kernel_launch: device query failed\n"); grid = -1; return; }
        if (hipFuncSetAttribute((const void*)mk_fwd, hipFuncAttributeMaxDynamicSharedMemorySize, LDS_BYTES) != hipSuccess) { fprintf(stderr, "kernel_launch: hipFuncSetAttribute failed\n"); grid = -1; return; }
        if (hipOccupancyMaxActiveBlocksPerMultiprocessor(&per_cu, (const void*)mk_fwd, 512, LDS_BYTES) != hipSuccess || per_cu < 1) { fprintf(stderr, "kernel_launch: occupancy query says %d blocks per CU\n", per_cu); per_cu = 1; }
        (void)hipGetLastError();
        grid = cus * 1;
    }
    if (grid < 0) return;
    Args a{};
    for (int i = 0; i < 14; ++i) a.in[i] = (const float*)d_in[i];
    a.out = (float*)d_out; a.ws = (unsigned char*)d_ws; a.sub = 3;
#if MK_MULTI
    for (int ph = 0; ph < NPHASE; ++ph) { a.ph_lo = ph; a.ph_hi = ph + 1; a.coop = 0;
        hipLaunchKernelGGL(mk_fwd, dim3(grid), dim3(512), LDS_BYTES, stream, a);
        const hipError_t le = hipPeekAtLastError(); if (le != hipSuccess) { fprintf(stderr, "kernel_launch: launch %d failed: %s\n", ph, hipGetErrorName(le)); break; }
#ifdef PROBE_PH
        if ((PROBE_PH >> ph) & 1) { a.sub = PROBE_SUB; hipLaunchKernelGGL(mk_fwd, dim3(grid), dim3(512), LDS_BYTES, stream, a); a.sub = 3; }
#endif
    }
#else
    a.ph_lo = 0; a.ph_hi = NPHASE; a.coop = 1;
    if (hipMemsetAsync((char*)d_ws + WS_BAR, 0, 16384, stream) != hipSuccess) { fprintf(stderr, "kernel_launch: hipMemsetAsync of the barrier words failed\n"); return; }
    void* args[] = {&a};
    const hipError_t e = hipLaunchCooperativeKernel((const void*)mk_fwd, dim3(grid), dim3(512), args, LDS_BYTES, stream);
    if (e != hipSuccess) fprintf(stderr, "kernel_launch: cooperative launch failed: %s (grid %d)\n", hipGetErrorString(e), grid);
#endif
}
```
